# Optimizing an MI355X kernel written in HIP

```python
import math
import jax, jax.numpy as jnp
from jax import lax
import numpy as np


D_MODEL = 1024
BATCH = 8
SEQ = 4096
DEPTH = 1

HEAD_DIM = 64
N_HEADS_A = 8
N_KV_A = 2
N_HEADS_B = 8
N_KV_B = 2
N_HEADS = N_HEADS_A + N_HEADS_B
MIX_WIDTH = N_HEADS * HEAD_DIM
WINDOW_A = 128
CMP_LEN = 32
CMP_STRIDE = 16
CMP_HIDDEN = 128
SEL_LEN = 64
SEL_TOPK = 16
WINDOW_B = 512
FORCE_BONUS = 1000.0
BAND_BLOCK = 128
NSA_BLOCK = 32
NUM_BUCKETS = 32
MAX_DISTANCE = 128
D_FF = 2816
EPS = 1e-6
NEG = -1e9

QA = N_HEADS_A * HEAD_DIM
KVA = N_KV_A * HEAD_DIM
QB = N_HEADS_B * HEAD_DIM
KVB = N_KV_B * HEAD_DIM
N_GATES = 3 * N_HEADS_B
OFF_KA = QA
OFF_VA = OFF_KA + KVA
OFF_QB = OFF_VA + KVA
OFF_KVB = OFF_QB + QB
OFF_GB = OFF_KVB + 6 * KVB
D_IN = OFF_GB + N_GATES

kernel_name = 'hymba_swa_sink_nsa_macaron_block'


def rms_norm(x, g):
    x32 = x.astype(jnp.float32)
    y = x32 * lax.rsqrt(jnp.mean(x32 * x32, axis=-1, keepdims=True) + EPS) * g.astype(jnp.float32)
    return y.astype(x.dtype)


def swiglu(h, w_in, w_out):
    gate, up = jnp.split(h @ w_in, 2, axis=-1)
    return (jax.nn.silu(gate) * up) @ w_out


def rel_bucket(rel):
    n = jnp.maximum(rel, 0)
    max_exact = NUM_BUCKETS // 2
    nf = jnp.maximum(n, 1).astype(jnp.float32)
    large = max_exact + (jnp.log(nf / max_exact) / math.log(MAX_DISTANCE / max_exact)
                         * (NUM_BUCKETS - max_exact)).astype(jnp.int32)
    large = jnp.minimum(large, NUM_BUCKETS - 1)
    return jnp.where(n < max_exact, n, large)


def rel_bias(tbl, rel):
    return tbl[rel_bucket(rel)].astype(jnp.float32)


def banded_attention(q, k, v, tbl, window, sinks):
    B, S, G, R, Dh = q.shape
    kv_len = window + BAND_BLOCK
    k_pad = jnp.pad(k, ((0, 0), (window, 0), (0, 0), (0, 0)))
    v_pad = jnp.pad(v, ((0, 0), (window, 0), (0, 0), (0, 0)))

    def block(i):
        start = i * BAND_BLOCK
        qb = lax.dynamic_slice_in_dim(q, start, BAND_BLOCK, axis=1)
        kb = lax.dynamic_slice_in_dim(k_pad, start, kv_len, axis=1)
        vb = lax.dynamic_slice_in_dim(v_pad, start, kv_len, axis=1)
        q_pos = start + jnp.arange(BAND_BLOCK)
        k_pos = start - window + jnp.arange(kv_len)
        rel = q_pos[:, None] - k_pos[None, :]
        mask = (rel >= 0) & (rel < window) & (k_pos[None, :] >= 0)
        bias = rel_bias(tbl, rel).reshape(BAND_BLOCK, kv_len, G, R).transpose(2, 3, 0, 1)
        logits = jnp.einsum('bqgrd,bkgd->bgrqk', qb, kb).astype(jnp.float32) + bias
        logits = jnp.where(mask, logits, NEG)
        m = logits.max(axis=-1, keepdims=True)
        if sinks is None:
            p = jnp.exp(logits - m)
            denom = p.sum(axis=-1, keepdims=True)
        else:
            s = sinks.astype(jnp.float32).reshape(1, G, R, 1, 1)
            m = jnp.maximum(m, s)
            p = jnp.exp(logits - m)
            denom = p.sum(axis=-1, keepdims=True) + jnp.exp(s - m)
        p = p / denom
        return jnp.einsum('bgrqk,bkgd->bqgrd', p.astype(vb.dtype), vb)

    out = lax.map(block, jnp.arange(S // BAND_BLOCK))
    return out.transpose(1, 0, 2, 3, 4, 5).reshape(B, S, G, R, Dh)


def compress_kv(kv, pos, w1, b1, w2, b2):
    _, B, S, G, Dh = kv.shape
    r = CMP_LEN // CMP_STRIDE
    n_chunk = S // CMP_STRIDE
    n_cmp = n_chunk - r + 1
    chunks = kv.reshape(2, B, n_chunk, CMP_STRIDE, G, Dh)
    w1r = w1.reshape(2, r, CMP_STRIDE, Dh, CMP_HIDDEN)
    pre = b1[:, None, None, None, :]
    for j in range(r):
        pe = pos[:, None, None, j * CMP_STRIDE:(j + 1) * CMP_STRIDE, None, :]
        part = jnp.einsum('kbnpgd,kpdh->kbngh', chunks + pe, w1r[:, j])
        pre = pre + part[:, :, j:j + n_cmp]
    hid = jax.nn.silu(pre)
    return jnp.einsum('kbcgh,khd->kbcgd', hid, w2) + b2[:, None, None, None, :]


def nsa_cmp_sel(q, k_c, v_c, k_s, v_s, tbl):
    B, S, G, R, Dh = q.shape
    n_cmp = k_c.shape[1]
    n_slc = S // SEL_LEN
    n_top = min(SEL_TOPK, n_slc)
    cmp_start = jnp.arange(n_cmp) * CMP_STRIDE
    cmp_end = cmp_start + CMP_LEN - 1
    slc_start = jnp.arange(n_slc) * SEL_LEN
    overlap = ((cmp_start[:, None] < slc_start[None, :] + SEL_LEN)
               & (cmp_end[:, None] >= slc_start[None, :])).astype(jnp.float32)
    kb = k_s.reshape(B, n_slc, SEL_LEN, G, Dh).transpose(0, 3, 1, 2, 4)
    vb = v_s.reshape(B, n_slc, SEL_LEN, G, Dh).transpose(0, 3, 1, 2, 4)
    tbl3 = tbl.reshape(NUM_BUCKETS, G, R)
    b_idx = jnp.arange(B)[:, None, None, None]
    g_idx = jnp.arange(G)[None, :, None, None]
    blk = jnp.arange(n_slc)
    offs = jnp.arange(SEL_LEN)

    def block(i):
        start = i * NSA_BLOCK
        qb = lax.dynamic_slice_in_dim(q, start, NSA_BLOCK, axis=1)
        q_pos = start + jnp.arange(NSA_BLOCK)
        rel_c = q_pos[:, None] - cmp_end[None, :]
        mask_c = rel_c >= 0
        bias_c = rel_bias(tbl, rel_c).reshape(NSA_BLOCK, n_cmp, G, R).transpose(2, 3, 0, 1)
        lc = jnp.einsum('bqgrd,bcgd->bgrqc', qb, k_c).astype(jnp.float32) + bias_c
        lc = jnp.where(mask_c, lc, NEG)
        pc = jnp.where(mask_c, jnp.exp(lc - lc.max(axis=-1, keepdims=True)), 0.0)
        pc = pc / jnp.maximum(pc.sum(axis=-1, keepdims=True), jnp.finfo(jnp.float32).tiny)
        o_cmp = jnp.einsum('bgrqc,bcgd->bqgrd', pc.astype(v_c.dtype), v_c)
        imp = jnp.einsum('bgrqc,cn->bgqn', pc, overlap)
        cur = q_pos[:, None] // SEL_LEN
        valid = blk[None, :] <= cur
        forced = (blk[None, :] == 0) | (blk[None, :] == cur) | (blk[None, :] == cur - 1)
        score = jnp.where(valid, imp + jnp.where(forced, FORCE_BONUS, 0.0), NEG)
        top_val, top_idx = lax.top_k(score, n_top)
        sel_ok = top_val > 0.5 * NEG
        ks = kb[b_idx, g_idx, top_idx]
        vs = vb[b_idx, g_idx, top_idx]
        tok = top_idx[..., None] * SEL_LEN + offs
        rel_s = q_pos[None, None, :, None, None] - tok
        mask_s = (sel_ok[..., None] & (rel_s >= 0))[:, :, None]
        bias_s = jnp.moveaxis(tbl3[rel_bucket(rel_s), g_idx[..., None]], -1, 2).astype(jnp.float32)
        ls = jnp.einsum('bqgrd,bgqnld->bgrqnl', qb, ks).astype(jnp.float32) + bias_s
        ls = jnp.where(mask_s, ls, NEG)
        ps = jax.nn.softmax(ls.reshape(B, G, R, NSA_BLOCK, n_top * SEL_LEN), axis=-1).reshape(ls.shape)
        o_sel = jnp.einsum('bgrqnl,bgqnld->bqgrd', ps.astype(vs.dtype), vs)
        return o_cmp, o_sel

    o_cmp, o_sel = lax.map(block, jnp.arange(S // NSA_BLOCK))
    o_cmp = o_cmp.transpose(1, 0, 2, 3, 4, 5).reshape(B, S, G, R, Dh)
    o_sel = o_sel.transpose(1, 0, 2, 3, 4, 5).reshape(B, S, G, R, Dh)
    return o_cmp, o_sel


def hybrid_layer(x, tbl, ffn1_norm, ffn1_w_in, ffn1_w_out, mix_norm, w_mix_in, w_mix_out,
                 q_norm_a, k_norm_a, sinks_a, q_norm_b, k_norm_b,
                 cmp_pos, cmp_w1, cmp_b1, cmp_w2, cmp_b2,
                 ffn2_norm, ffn2_w_in, ffn2_w_out):
    B, S, _ = x.shape
    r_a = N_HEADS_A // N_KV_A
    r_b = N_HEADS_B // N_KV_B
    scale = HEAD_DIM ** -0.5
    x = x + 0.5 * swiglu(rms_norm(x, ffn1_norm), ffn1_w_in, ffn1_w_out)
    h = rms_norm(x, mix_norm)
    proj = h @ w_mix_in
    q_a = rms_norm(proj[..., :OFF_KA].reshape(B, S, N_KV_A, r_a, HEAD_DIM), q_norm_a) * scale
    k_a = rms_norm(proj[..., OFF_KA:OFF_VA].reshape(B, S, N_KV_A, HEAD_DIM), k_norm_a)
    v_a = proj[..., OFF_VA:OFF_QB].reshape(B, S, N_KV_A, HEAD_DIM)
    o_a = banded_attention(q_a, k_a, v_a, tbl[:, :N_HEADS_A], WINDOW_A, sinks_a)
    q_b = rms_norm(proj[..., OFF_QB:OFF_KVB].reshape(B, S, N_KV_B, r_b, HEAD_DIM), q_norm_b) * scale
    kv_b = proj[..., OFF_KVB:OFF_GB].reshape(B, S, 6, N_KV_B, HEAD_DIM)
    kv_c = compress_kv(jnp.moveaxis(kv_b[:, :, 0:2], 2, 0), cmp_pos, cmp_w1, cmp_b1, cmp_w2, cmp_b2)
    k_c = rms_norm(kv_c[0], k_norm_b)
    v_c = kv_c[1]
    k_s = rms_norm(kv_b[:, :, 2], k_norm_b)
    v_s = kv_b[:, :, 3]
    k_w = rms_norm(kv_b[:, :, 4], k_norm_b)
    v_w = kv_b[:, :, 5]
    tbl_b = tbl[:, N_HEADS_A:]
    o_cmp, o_sel = nsa_cmp_sel(q_b, k_c, v_c, k_s, v_s, tbl_b)
    o_win = banded_attention(q_b, k_w, v_w, tbl_b, WINDOW_B, None)
    gates = jax.nn.sigmoid(proj[..., OFF_GB:].astype(jnp.float32)).reshape(B, S, 3, N_KV_B, r_b, 1)
    o_b = gates[:, :, 0] * o_cmp + gates[:, :, 1] * o_sel + gates[:, :, 2] * o_win
    mix = jnp.concatenate([o_a.reshape(B, S, QA).astype(x.dtype),
                           o_b.reshape(B, S, QB).astype(x.dtype)], axis=-1)
    x = x + mix @ w_mix_out
    x = x + 0.5 * swiglu(rms_norm(x, ffn2_norm), ffn2_w_in, ffn2_w_out)
    return x


def setup_inputs(seed: int = 0) -> dict:
    key = jax.random.key(seed)
    ks = jax.random.split(key, 24)
    f32 = jnp.float32

    def nrm(k, shape, scale):
        return jax.random.normal(k, shape, f32) * scale

    def gain(k, shape):
        return 1.0 + 0.05 * jax.random.normal(k, shape, f32)

    L = DEPTH
    return {
        'x': nrm(ks[0], (BATCH, SEQ, D_MODEL), 1.0),
        'rel_bias_table': nrm(ks[1], (NUM_BUCKETS, N_HEADS), 0.5),
        'ffn1_norm': gain(ks[2], (L, D_MODEL)),
        'ffn1_w_in': nrm(ks[3], (L, D_MODEL, 2 * D_FF), D_MODEL ** -0.5),
        'ffn1_w_out': nrm(ks[4], (L, D_FF, D_MODEL), D_FF ** -0.5),
        'mix_norm': gain(ks[5], (L, D_MODEL)),
        'w_mix_in': nrm(ks[6], (L, D_MODEL, D_IN), D_MODEL ** -0.5),
        'w_mix_out': nrm(ks[7], (L, MIX_WIDTH, D_MODEL), MIX_WIDTH ** -0.5),
        'q_norm_a': gain(ks[8], (L, HEAD_DIM)),
        'k_norm_a': gain(ks[9], (L, HEAD_DIM)),
        'sinks_a': nrm(ks[10], (L, N_HEADS_A), 0.5),
        'q_norm_b': gain(ks[11], (L, HEAD_DIM)),
        'k_norm_b': gain(ks[12], (L, HEAD_DIM)),
        'cmp_pos': nrm(ks[13], (L, 2, CMP_LEN, HEAD_DIM), 0.5),
        'cmp_w1': nrm(ks[14], (L, 2, CMP_LEN * HEAD_DIM, CMP_HIDDEN), (CMP_LEN * HEAD_DIM) ** -0.5),
        'cmp_b1': nrm(ks[15], (L, 2, CMP_HIDDEN), 0.02),
        'cmp_w2': nrm(ks[16], (L, 2, CMP_HIDDEN, HEAD_DIM), CMP_HIDDEN ** -0.5),
        'cmp_b2': nrm(ks[17], (L, 2, HEAD_DIM), 0.02),
        'ffn2_norm': gain(ks[18], (L, D_MODEL)),
        'ffn2_w_in': nrm(ks[19], (L, D_MODEL, 2 * D_FF), D_MODEL ** -0.5),
        'ffn2_w_out': nrm(ks[20], (L, D_FF, D_MODEL), D_FF ** -0.5),
    }


def reference(x, rel_bias_table, ffn1_norm, ffn1_w_in, ffn1_w_out, mix_norm, w_mix_in, w_mix_out,
              q_norm_a, k_norm_a, sinks_a, q_norm_b, k_norm_b,
              cmp_pos, cmp_w1, cmp_b1, cmp_w2, cmp_b2,
              ffn2_norm, ffn2_w_in, ffn2_w_out):
    for l in range(DEPTH):
        x = hybrid_layer(x, rel_bias_table, ffn1_norm[l], ffn1_w_in[l], ffn1_w_out[l],
                         mix_norm[l], w_mix_in[l], w_mix_out[l],
                         q_norm_a[l], k_norm_a[l], sinks_a[l], q_norm_b[l], k_norm_b[l],
                         cmp_pos[l], cmp_w1[l], cmp_b1[l], cmp_w2[l], cmp_b2[l],
                         ffn2_norm[l], ffn2_w_in[l], ffn2_w_out[l])
    return x
```

```cpp
#include <hip/hip_runtime.h>
#include <cstdio>
#include <cstdint>
#ifndef KFLAGS
#define KFLAGS 0
#endif
namespace pg8 {
#define PG8_LAS __attribute__((address_space(3)))
typedef unsigned short bf16_t;
typedef short bf16x8 __attribute__((ext_vector_type(8)));
typedef float f32x4 __attribute__((ext_vector_type(4)));
typedef unsigned u32x4 __attribute__((ext_vector_type(4)));
constexpr int BM = 256, BK = 64, HALF = 128, HTB = HALF * BK * 2  , STAGE_BYTES = 8 * HTB, NXCD = 8, WGM = 8;

__host__ __device__ __forceinline__ int lds_byte(int r, int c) { const int st = (r >> 4) * 2 + (c >> 5), rr = r & 15, cc = c & 31, ob = rr * 64 + cc * 2; return st * 1024 + (ob ^ (((ob >> 9) & 1) << 5)); }
__host__ __device__ __forceinline__ void stage_rc(int b, int& R, int& C) { const int st = b / 1024, sb = b % 1024, swz = sb ^ (((sb >> 9) & 1) << 5); R = (st >> 1) * 16 + swz / 64; C = (st & 1) * 32 + (swz % 64) / 2; }
__host__ __device__ __forceinline__ int perm32(int rho) { const int n = rho >> 4, i = rho & 15; return 8 * (i >> 2) + 4 * n + (i & 3); }

struct Unit { int pm, pn; };
struct Gemm { const bf16_t* A; const bf16_t* Bt; int M, N, K; };

struct StaticOrder {
    int nM, nN, nwg, G, c;
    __host__ __device__ void init(int M, int N, int G_, int c_) { nM = M / BM; nN = N / BM; nwg = nM * nN; G = G_; c = c_; }
    __host__ __device__ bool next(int i, Unit& u) const {
        const long L = (long)i * G + c; if (L >= nwg) return false;
        int wgid = (int)L; { const int q = nwg / NXCD, r = nwg % NXCD, xcd = wgid % NXCD, off = wgid / NXCD; wgid = (xcd < r ? xcd * (q + 1) : r * (q + 1) + (xcd - r) * q) + off; }
        const int nig = WGM * nN, gid = wgid / nig, fm = gid * WGM, gsz = (nM - fm) < WGM ? (nM - fm) : WGM;
        u.pm = fm + ((wgid % nig) % gsz); u.pn = (wgid % nig) / gsz; return true;
    }
    __device__ __forceinline__ void a_ready(const Unit&) const {}
    __device__ __forceinline__ void done(const Unit&) const {}
};


__device__ __forceinline__ unsigned cvt_pk_bf16(float lo, float hi) { unsigned r; asm volatile("v_cvt_pk_bf16_f32 %0, %1, %2" : "=v"(r) : "v"(lo), "v"(hi)); return r; }
typedef unsigned u32x2 __attribute__((ext_vector_type(2)));
constexpr float kLog2e = 1.4426950408889634f;
__device__ __forceinline__ float silu_f(float x) { return x * __builtin_amdgcn_rcpf(1.0f + __builtin_amdgcn_exp2f(-x * kLog2e)); }
__device__ __forceinline__ float row_rstd(const float* ssq, int row, int fq) {
    const f32x4 p = *(const f32x4*)(ssq + (size_t)row * 16 + 4 * fq);
    float s = (p[0] + p[1]) + (p[2] + p[3]);
    s += __shfl_xor(s, 16); s += __shfl_xor(s, 32);
    return __builtin_amdgcn_rsqf(s * (1.0f / 1024.0f) + 1e-6f);
}

struct EpiPlain {
    static constexpr bool PERM = true, AFTER_DRAIN = false;
    bf16_t* O; int ldc;
    __device__ __forceinline__ void operator()(const f32x4 (&acc)[2][2][4][2], const Unit& u, int wr, int wc, int fr, int fq) const {
        const int row0 = u.pm * BM + wr * 64 + fr, col0 = u.pn * BM + wc * 32 + 8 * fq;
#pragma unroll
        for (int ai = 0; ai < 2; ++ai)
#pragma unroll
            for (int m = 0; m < 4; ++m) { bf16_t* rowp = O + (size_t)(row0 + ai * HALF + m * 16) * ldc + col0;
#pragma unroll
                for (int bj = 0; bj < 2; ++bj) { const f32x4 v0 = acc[ai][bj][m][0], v1 = acc[ai][bj][m][1]; u32x4 w;
                    w.x = cvt_pk_bf16(v0[0], v0[1]); w.y = cvt_pk_bf16(v0[2], v0[3]); w.z = cvt_pk_bf16(v1[0], v1[1]); w.w = cvt_pk_bf16(v1[2], v1[3]);
                    *(u32x4*)(rowp + bj * HALF) = w; } }
    }
};

struct EpiSwiglu {
    static constexpr bool PERM = true, AFTER_DRAIN = false;
    bf16_t* O; int ldo; const float* ssq;
    __device__ __forceinline__ void operator()(const f32x4 (&acc)[2][2][4][2], const Unit& u, int wr, int wc, int fr, int fq) const {
        const int row0 = u.pm * BM + wr * 64 + fr, col0 = u.pn * HALF + wc * 32 + 8 * fq;
#pragma unroll
        for (int ai = 0; ai < 2; ++ai)
#pragma unroll
            for (int m = 0; m < 4; ++m) { const int row = row0 + ai * HALF + m * 16;
                const float rs = ssq ? row_rstd(ssq, row, fq) : 1.0f;
                const f32x4 g0 = acc[ai][0][m][0] * rs, g1 = acc[ai][0][m][1] * rs, u0 = acc[ai][1][m][0] * rs, u1 = acc[ai][1][m][1] * rs;
                u32x4 w;
                w.x = cvt_pk_bf16(silu_f(g0[0]) * u0[0], silu_f(g0[1]) * u0[1]); w.y = cvt_pk_bf16(silu_f(g0[2]) * u0[2], silu_f(g0[3]) * u0[3]);
                w.z = cvt_pk_bf16(silu_f(g1[0]) * u1[0], silu_f(g1[1]) * u1[1]); w.w = cvt_pk_bf16(silu_f(g1[2]) * u1[2], silu_f(g1[3]) * u1[3]);
                *(u32x4*)(O + (size_t)row * ldo + col0) = w; }
    }
};

struct EpiResid {
    static constexpr bool PERM = false, AFTER_DRAIN = false;
    const float* base; float* out; float alpha; bf16_t* a_out; const float* g; float* ssq;
    __device__ __forceinline__ void operator()(const f32x4 (&acc)[2][2][4][2], const Unit& u, int wr, int wc, int fr, int fq) const {
        const int row0 = u.pm * BM + wr * 64 + fr, col0 = u.pn * BM + wc * 32 + 4 * fq;
        f32x4 gv[2][2];
#pragma unroll
        for (int bj = 0; bj < 2; ++bj)
#pragma unroll
            for (int n = 0; n < 2; ++n) gv[bj][n] = a_out ? *(const f32x4*)(g + col0 + bj * HALF + n * 16) : (f32x4){1.f, 1.f, 1.f, 1.f};
#pragma unroll
        for (int ai = 0; ai < 2; ++ai)
#pragma unroll
            for (int m = 0; m < 4; ++m) { const int row = row0 + ai * HALF + m * 16; const size_t off = (size_t)row * 1024 + col0; float ss = 0.f;
#pragma unroll
                for (int bj = 0; bj < 2; ++bj)
#pragma unroll
                    for (int n = 0; n < 2; ++n) { const f32x4 b = *(const f32x4*)(base + off + bj * HALF + n * 16); const f32x4 o = b + acc[ai][bj][m][n] * alpha;
                        *(f32x4*)(out + off + bj * HALF + n * 16) = o;
                        if (a_out) { const f32x4 y = o * gv[bj][n]; u32x2 w; w.x = cvt_pk_bf16(y[0], y[1]); w.y = cvt_pk_bf16(y[2], y[3]); *(u32x2*)(a_out + off + bj * HALF + n * 16) = w;
                            ss += (o[0] * o[0] + o[1] * o[1]) + (o[2] * o[2] + o[3] * o[3]); } }
                if (ssq) { ss += __shfl_xor(ss, 16); ss += __shfl_xor(ss, 32); if (fq == 0) ssq[(size_t)row * 16 + u.pn * 4 + wc] = ss; }
                asm volatile("" ::: "memory"); }
    }
};
template <class Epi, class Sched, bool ALIGN_EPI = false, bool SP2 = false>
__device__ __forceinline__ void gemm_phase(PG8_LAS unsigned char* lds, const Gemm g, const Sched& S, const Epi& E) {
    const int tid = threadIdx.x, wid = __builtin_amdgcn_readfirstlane(tid >> 6), lane = tid & 63, wr = wid >> 2, wc = wid & 3, fr = lane & 15, fq = lane >> 4;
    const int K = g.K, nt = K / BK;
    unsigned voffA[2], voffB[2];
#pragma unroll
    for (int i = 0; i < 2; ++i) { int R, C; stage_rc(tid * 16 + i * 8192, R, C); const int Rb = Epi::PERM ? ((R & ~31) + perm32(R & 31)) : R;
        voffA[i] = (unsigned)(R * K + C) * 2u; voffB[i] = (unsigned)(Rb * K + C) * 2u; }
    const size_t kstep = (size_t)(BK * 2);
    const size_t hstep = (size_t)HALF * K * 2;
    const size_t tstep = 2 * hstep;
    const unsigned ldsw = (unsigned)wid * 1024u;
    const int aoff = lds_byte(wr * 64 + fr, fq * 8), boff = lds_byte(wc * 32 + fr, fq * 8);
#define PG8_SA(b, h) (((b) * 2 + (h)) * HTB)
#define PG8_SB(b, h) ((4 + (b) * 2 + (h)) * HTB)
#define PG8_STAGE(bufoff, gbase, voff) do { _Pragma("unroll") for (int _i = 0; _i < 2; ++_i) \
        __builtin_amdgcn_global_load_lds((const unsigned*)((const char*)(gbase) + (voff)[_i]), (PG8_LAS unsigned*)(lds + (bufoff) + ldsw + _i * 8192), 16, 0, 0); } while (0)
#define PG8_LDA(dst, b, h) do { _Pragma("unroll") for (int m = 0; m < 4; ++m) _Pragma("unroll") for (int k = 0; k < 2; ++k) dst[m][k] = *(const PG8_LAS bf16x8*)(lds + PG8_SA(b, h) + aoff + m * 2048 + k * 1024); } while (0)
#define PG8_LDB(dst, b, h) do { _Pragma("unroll") for (int n = 0; n < 2; ++n) _Pragma("unroll") for (int k = 0; k < 2; ++k) dst[n][k] = *(const PG8_LAS bf16x8*)(lds + PG8_SB(b, h) + boff + n * 2048 + k * 1024); } while (0)
#define PG8_MMA(ai, bj, At, Bt) do { __builtin_amdgcn_s_setprio(1); _Pragma("unroll") for (int m = 0; m < 4; ++m) _Pragma("unroll") for (int n = 0; n < 2; ++n) _Pragma("unroll") for (int k = 0; k < 2; ++k) \
        acc[ai][bj][m][n] = __builtin_amdgcn_mfma_f32_16x16x32_bf16(Bt[n][k], At[m][k], acc[ai][bj][m][n], 0, 0, 0); __builtin_amdgcn_s_setprio(0); } while (0)
#define PG8_WAIT_V(n) asm volatile("s_waitcnt vmcnt(" #n ")" ::: "memory")
#define PG8_WAIT_L(n) asm volatile("s_waitcnt lgkmcnt(" #n ")" ::: "memory")
#define PG8_BAR __builtin_amdgcn_s_barrier()
#define PG8_SCHED __builtin_amdgcn_sched_barrier(0)
    Unit cur, nxt; int ui = 0;
    if (!S.next(0, cur)) return;
    f32x4 acc[2][2][4][2];
#pragma unroll
    for (int a = 0; a < 2; ++a)
#pragma unroll
        for (int b = 0; b < 2; ++b)
#pragma unroll
            for (int m = 0; m < 4; ++m)
#pragma unroll
                for (int n = 0; n < 2; ++n) acc[a][b][m][n] = (f32x4){0.f, 0.f, 0.f, 0.f};
    bf16x8 At[4][2], B0[2][2], B1[2][2];
    const char* cA = (const char*)g.A + (size_t)cur.pm * tstep; const char* cB = (const char*)g.Bt + (size_t)cur.pn * tstep;
    S.a_ready(cur);
    if constexpr (SP2) {
        PG8_STAGE(PG8_SB(0, 0), cB, voffB); PG8_STAGE(PG8_SB(0, 1), cB + hstep, voffB); PG8_STAGE(PG8_SA(0, 0), cA, voffA); PG8_STAGE(PG8_SA(0, 1), cA + hstep, voffA);
        if (wr == 1) PG8_BAR;
        PG8_WAIT_V(2); PG8_BAR;
        PG8_STAGE(PG8_SB(1, 0), cB + kstep, voffB); PG8_STAGE(PG8_SA(1, 0), cA + kstep, voffA); PG8_STAGE(PG8_SB(1, 1), cB + hstep + kstep, voffB);
        PG8_WAIT_V(6); PG8_BAR;
    } else {
        PG8_STAGE(PG8_SB(0, 0), cB, voffB); PG8_STAGE(PG8_SA(0, 0), cA, voffA); PG8_STAGE(PG8_SB(0, 1), cB + hstep, voffB); PG8_STAGE(PG8_SA(0, 1), cA + hstep, voffA);
        if (wr == 1) PG8_BAR;
        PG8_WAIT_V(4); PG8_BAR;
        PG8_STAGE(PG8_SB(1, 0), cB + kstep, voffB); PG8_STAGE(PG8_SA(1, 0), cA + kstep, voffA); PG8_STAGE(PG8_SB(1, 1), cB + hstep + kstep, voffB);
        PG8_WAIT_V(6); PG8_BAR;
    }
    for (;;) {
        const bool has_next = S.next(ui + 1, nxt);
        const char* nA = has_next ? (const char*)g.A + (size_t)nxt.pm * tstep : cA; const char* nB = has_next ? (const char*)g.Bt + (size_t)nxt.pn * tstep : cB;
        for (int t = 0; t < nt; t += 2) {
            const bool last = (t == nt - 2);
            const char* a1 = cA + (size_t)(t + 1) * kstep;
            const char* a2 = last ? nA : cA + (size_t)(t + 2) * kstep; const char* b2 = last ? nB : cB + (size_t)(t + 2) * kstep;
            const char* a3 = a2 + kstep; const char* b3 = b2 + kstep;
            if (last && has_next) S.a_ready(nxt);
            if constexpr (SP2) {
            PG8_LDB(B0, 0, 0); PG8_LDB(B1, 0, 1); PG8_SCHED; PG8_LDA(At, 0, 0); PG8_STAGE(PG8_SA(1, 1), a1 + hstep, voffA);
            PG8_WAIT_V(8); PG8_WAIT_L(0); PG8_BAR; PG8_MMA(0, 0, At, B0); PG8_MMA(0, 1, At, B1); PG8_BAR; PG8_SCHED;
            PG8_LDA(At, 0, 1); PG8_STAGE(PG8_SB(0, 0), b2, voffB); PG8_STAGE(PG8_SB(0, 1), b2 + hstep, voffB); PG8_STAGE(PG8_SA(0, 0), a2, voffA);
            PG8_WAIT_V(8); PG8_WAIT_L(0); PG8_BAR; PG8_MMA(1, 0, At, B0); PG8_MMA(1, 1, At, B1); PG8_BAR; PG8_SCHED;
            PG8_LDB(B0, 1, 0); PG8_LDB(B1, 1, 1); PG8_SCHED; PG8_LDA(At, 1, 0); PG8_STAGE(PG8_SA(0, 1), a2 + hstep, voffA);
            PG8_WAIT_V(8); PG8_WAIT_L(0); PG8_BAR; PG8_MMA(0, 0, At, B0); PG8_MMA(0, 1, At, B1); PG8_BAR; PG8_SCHED;
            PG8_LDA(At, 1, 1); PG8_STAGE(PG8_SB(1, 0), b3, voffB); PG8_STAGE(PG8_SB(1, 1), b3 + hstep, voffB); PG8_STAGE(PG8_SA(1, 0), a3, voffA);
            PG8_WAIT_V(8); PG8_WAIT_L(0); PG8_BAR; PG8_MMA(1, 0, At, B0); PG8_MMA(1, 1, At, B1); PG8_BAR; PG8_SCHED;
            } else {
            PG8_LDB(B0, 0, 0); PG8_SCHED; PG8_LDA(At, 0, 0); PG8_STAGE(PG8_SA(1, 1), a1 + hstep, voffA);
            PG8_WAIT_L(8); PG8_BAR; PG8_WAIT_L(0); PG8_MMA(0, 0, At, B0); PG8_BAR; PG8_SCHED;
            PG8_LDB(B1, 0, 1); PG8_STAGE(PG8_SB(0, 0), b2, voffB);
            PG8_BAR; PG8_WAIT_L(0); PG8_MMA(0, 1, At, B1); PG8_BAR;
            PG8_LDA(At, 0, 1); PG8_STAGE(PG8_SA(0, 0), a2, voffA);
            PG8_BAR; PG8_WAIT_L(0); PG8_MMA(1, 0, At, B0); PG8_BAR; PG8_SCHED;
            PG8_STAGE(PG8_SB(0, 1), b2 + hstep, voffB);
            PG8_WAIT_V(6); PG8_BAR; PG8_MMA(1, 1, At, B1); PG8_BAR;
            PG8_LDB(B0, 1, 0); PG8_SCHED; PG8_LDA(At, 1, 0); PG8_STAGE(PG8_SA(0, 1), a2 + hstep, voffA);
            PG8_WAIT_L(8); PG8_BAR; PG8_WAIT_L(0); PG8_MMA(0, 0, At, B0); PG8_BAR; PG8_SCHED;
            PG8_LDB(B1, 1, 1); PG8_STAGE(PG8_SB(1, 0), b3, voffB);
            PG8_BAR; PG8_WAIT_L(0); PG8_MMA(0, 1, At, B1); PG8_BAR;
            PG8_LDA(At, 1, 1); PG8_STAGE(PG8_SA(1, 0), a3, voffA);
            PG8_BAR; PG8_WAIT_L(0); PG8_MMA(1, 0, At, B0); PG8_BAR; PG8_SCHED;
            PG8_STAGE(PG8_SB(1, 1), b3 + hstep, voffB);
            PG8_WAIT_V(6); PG8_BAR; PG8_MMA(1, 1, At, B1); PG8_BAR;
            }
        }
        if constexpr (ALIGN_EPI) { if (wr == 0) PG8_BAR; }
        if constexpr (!Epi::AFTER_DRAIN) { E(acc, cur, wr, wc, fr, fq); S.done(cur); }
        if (!has_next) break;
#pragma unroll
        for (int a = 0; a < 2; ++a)
#pragma unroll
            for (int b = 0; b < 2; ++b)
#pragma unroll
                for (int m = 0; m < 4; ++m)
#pragma unroll
                    for (int n = 0; n < 2; ++n) acc[a][b][m][n] = (f32x4){0.f, 0.f, 0.f, 0.f};
        cur = nxt; cA = nA; cB = nB; ++ui;
        if constexpr (ALIGN_EPI) { if (wr == 1) PG8_BAR; }
    }
    PG8_WAIT_V(0);
    if constexpr (!ALIGN_EPI) { if (wr == 0) PG8_BAR; }
    PG8_BAR;
    if constexpr (Epi::AFTER_DRAIN) { E.fused(acc, cur, wr, wc, fr, fq, lds, wid, lane); S.done(cur); }
#undef PG8_SA
#undef PG8_SB
#undef PG8_STAGE
#undef PG8_LDA
#undef PG8_LDB
#undef PG8_MMA
#undef PG8_WAIT_V
#undef PG8_WAIT_L
#undef PG8_BAR
#undef PG8_SCHED
}
}
#define GAS __attribute__((address_space(1)))
#define LAS __attribute__((address_space(3)))
typedef unsigned short bf16;
typedef unsigned v4u __attribute__((ext_vector_type(4)));
typedef float f32x4 __attribute__((ext_vector_type(4)));
typedef short bf16x8 __attribute__((ext_vector_type(8)));
typedef GAS unsigned gu32;
typedef GAS unsigned long long gu64;
#define RLX_AGENT __ATOMIC_RELAXED, __HIP_MEMORY_SCOPE_AGENT
#define LDS_WAIT() asm volatile("s_waitcnt lgkmcnt(0)" ::: "memory")
#define VM_WAIT() asm volatile("s_waitcnt vmcnt(0)" ::: "memory")
__device__ __forceinline__ unsigned long long rt() { return __builtin_amdgcn_s_memrealtime(); }
__device__ __forceinline__ unsigned f2bf(float f) { unsigned u = __builtin_bit_cast(unsigned, f); return (u + 0x7fffu + ((u >> 16) & 1u)) >> 16; }
__device__ __forceinline__ unsigned pk2(float lo, float hi) { return f2bf(lo) | (f2bf(hi) << 16); }

#define XB_TMO      128
#define XB_XCNT(j)  (256  + 64 * (j))
#define XB_XSUB(j)  (1280 + 64 * (j))
#define XB_XGEN(j)  (2304 + 64 * (j))
#define XB_TOP      3328
#define XB_TOPGEN   3392
#define XCD_BAR_WORDS 3456
#define XB_SPIN_CAP (1u << 18)

__device__ __forceinline__ unsigned xb_ld(unsigned* p)              { return __hip_atomic_load(p, __ATOMIC_RELAXED, __HIP_MEMORY_SCOPE_AGENT); }
__device__ __forceinline__ unsigned xb_add(unsigned* p, unsigned v) { return __hip_atomic_fetch_add(p, v, __ATOMIC_RELAXED, __HIP_MEMORY_SCOPE_AGENT); }
__device__ __forceinline__ unsigned xb_xcc_id() { return (unsigned)__builtin_amdgcn_s_getreg((3 << 11) | 20) & 0xFu; }
#define XB_SPIN(cond, bar) do { unsigned _sp = 0; while (cond) { __builtin_amdgcn_s_sleep(1); \
    if ((++_sp & 255u) == 0u) { if (xb_ld(&(bar)[XB_TMO])) break; if (_sp > XB_SPIN_CAP) { atomicAdd(&(bar)[XB_TMO], 1u); break; } } } } while (0)

struct XcdBarrier {
    unsigned* bar; unsigned x;
    volatile LAS unsigned* st;
};

__device__ __forceinline__ XcdBarrier xcd_barrier_post(unsigned* bar, volatile LAS unsigned* st) {
    XcdBarrier b; b.bar = bar; b.x = xb_xcc_id(); b.st = st;
    if (threadIdx.x == 0) (void)xb_add(&bar[XB_XCNT(b.x)], 1u);
    return b;
}
__device__ __forceinline__ void xcd_barrier_complete(unsigned* bar, unsigned x, unsigned& nloc, unsigned& nx) {
    const unsigned G = gridDim.x * gridDim.y * gridDim.z;
    unsigned sum, cnt, mine, sp = 0u;
    for (;;) {
        sum = 0u; cnt = 0u; mine = 0u;
#pragma unroll
        for (unsigned j = 0; j < 16; ++j) { const unsigned c = xb_ld(&bar[XB_XCNT(j)]); sum += c; cnt += (c > 0u) ? 1u : 0u; mine = (j == x) ? c : mine; }
        if (sum == G) break;
        __builtin_amdgcn_s_sleep(1);
        if ((++sp & 255u) == 0u) { if (xb_ld(&bar[XB_TMO])) break; if (sp > XB_SPIN_CAP) { atomicAdd(&bar[XB_TMO], 1u); break; } }
    }
    nloc = mine > 0u ? mine : 1u; nx = cnt > 0u ? cnt : 1u;
}

__device__ __forceinline__ void xcd_barrier(const XcdBarrier& b) {
    asm volatile("s_waitcnt vmcnt(0)" ::: "memory");
    __syncthreads();
    if (threadIdx.x == 0) {
        unsigned* bar = b.bar;
        __builtin_amdgcn_s_waitcnt(0);
        unsigned nloc = b.st[0], nx = b.st[1];
        if (nloc == 0u) { xcd_barrier_complete(bar, b.x, nloc, nx); b.st[0] = nloc; b.st[1] = nx; }
        const unsigned old = xb_add(&bar[XB_XSUB(b.x)], 1u);
        const unsigned gen = old / nloc;
        if (old + 1u == (gen + 1u) * nloc) {
            __builtin_amdgcn_fence(__ATOMIC_RELEASE, "agent");
            asm volatile("s_waitcnt vmcnt(0)" ::: "memory");
            const unsigned og = xb_add(&bar[XB_TOP], 1u);
            const unsigned tg = og / nx;
            if (og + 1u == (tg + 1u) * nx) xb_add(&bar[XB_TOPGEN], 1u);
            else XB_SPIN(xb_ld(&bar[XB_TOPGEN]) == tg, bar);
            __builtin_amdgcn_fence(__ATOMIC_ACQUIRE, "agent");
            xb_add(&bar[XB_XGEN(b.x)], 1u);
            asm volatile("s_waitcnt vmcnt(0)" ::: "memory");
        } else {
            XB_SPIN(xb_ld(&bar[XB_XGEN(b.x)]) == gen, bar);
            __builtin_amdgcn_fence(__ATOMIC_ACQUIRE, "agent");
            asm volatile("s_waitcnt vmcnt(0)" ::: "memory");
        }
    }
    __syncthreads();
}

constexpr int NWAVES = 8;
constexpr int BATCH = 8, SEQ = 4096, DM = 1024, FF = 2816, T = BATCH * SEQ;
constexpr float EPS = 1e-6f;
constexpr float LOG2E = 1.4426950408889634f;
constexpr float QSCALE = 0.125f * LOG2E;
constexpr float NEGL = -1.0e9f * LOG2E;
constexpr int NMAIN = 1792;
constexpr int NPLAIN = 2304;

constexpr size_t MiB = 1u << 20, KiB = 1u << 10;
constexpr size_t WS_CTL = 0, CTL_ZERO_BYTES = 1 * MiB;
constexpr size_t WS_WIN1 = 2 * MiB, WS_WOUT1 = 13 * MiB, WS_WIN2 = 19 * MiB, WS_WOUT2 = 30 * MiB, WS_WMAIN = 36 * MiB, WS_WVT = 41 * MiB, WS_WMO = 42 * MiB;
constexpr size_t WS_W1T = 44 * MiB, WS_W2T = 45 * MiB, WS_POSB = 45 * MiB + 64 * KiB, WS_SSQ1 = 46 * MiB, WS_SSQ2 = 48 * MiB, WS_GT = 50 * MiB, WS_KC = 53 * MiB, WS_VCT = 53 * MiB + 512 * KiB;
constexpr size_t WS_A = 56 * MiB;
constexpr size_t WS_ACT = 120 * MiB;
constexpr size_t WS_QA = 120 * MiB, WS_QB = 152 * MiB, WS_KA = 184 * MiB, WS_VAT = 192 * MiB, WS_KCR = 200 * MiB, WS_VCR = 208 * MiB, WS_KS = 216 * MiB, WS_VST = 224 * MiB, WS_KW = 232 * MiB, WS_VWT = 240 * MiB;
constexpr size_t WS_MIX = 296 * MiB;
constexpr size_t WS_PROJ = 360 * MiB;
constexpr size_t WS_END = 504 * MiB;
constexpr int CW_BAR = 4096;

constexpr int RING_OFF = 0, RING_BYTES = 131072;
constexpr int LDSCTL_OFF = RING_BYTES, MISC_OFF = LDSCTL_OFF + 320;
constexpr int LDS_BYTES = 147456;

typedef unsigned short bf16;
__device__ __forceinline__ float bf2f(bf16 v) { return __uint_as_float(((unsigned)v) << 16); }
__device__ __forceinline__ float wave_sum(float v) {
#pragma unroll
    for (int o = 1; o < 64; o <<= 1) v += __shfl_xor(v, o);
    return v;
}
__device__ __forceinline__ float wave_max(float v) {
#pragma unroll
    for (int o = 1; o < 64; o <<= 1) v = fmaxf(v, __shfl_xor(v, o));
    return v;
}
__device__ __forceinline__ int t5_bucket(int n) {
    if (n < 16) return n < 0 ? 0 : n;
    const int b = 16 + (int)(__log2f((float)n * 0.0625f) * (16.0f / 3.0f));
    return b > 31 ? 31 : b;
}

__global__ void __launch_bounds__(256) nv_rmsnorm(const float* x, const float* g, bf16* out) {
    const int lane = threadIdx.x & 63, row = blockIdx.x * 4 + (threadIdx.x >> 6);
    const f32x4* xr = (const f32x4*)(x + (size_t)row * DM) + lane; const f32x4* gr = (const f32x4*)g + lane;
    f32x4 v[4]; float s = 0.f;
#pragma unroll
    for (int j = 0; j < 4; ++j) { v[j] = xr[64 * j]; s += (v[j].x * v[j].x + v[j].y * v[j].y) + (v[j].z * v[j].z + v[j].w * v[j].w); }
    const float rstd = 1.0f / sqrtf(wave_sum(s) * (1.f / DM) + EPS);
    unsigned long long* o8 = (unsigned long long*)(out + (size_t)row * DM) + lane;
#pragma unroll
    for (int j = 0; j < 4; ++j) { const f32x4 gg = gr[64 * j]; o8[64 * j] = (unsigned long long)pk2(v[j].x * rstd * gg.x, v[j].y * rstd * gg.y) | ((unsigned long long)pk2(v[j].z * rstd * gg.z, v[j].w * rstd * gg.w) << 32); }
}

struct HeadPrep {
    const bf16* proj; const float* ssq;
    const float *qna, *kna, *qnb, *knb;
    bf16 *QA, *QB, *KA, *VAT, *KCR, *VCR, *KS, *VST, *KW, *VWT; float* GT;
};
__global__ void __launch_bounds__(256) nv_headprep(HeadPrep p) {
    const int lane = threadIdx.x & 63, t = blockIdx.x * 4 + (threadIdx.x >> 6), b = t / SEQ, s = t % SEQ;
    float rs = 1.0f;
    if (p.ssq) { float q = p.ssq[(size_t)t * 16 + (lane & 15)]; q += __shfl_xor(q, 1); q += __shfl_xor(q, 2); q += __shfl_xor(q, 4); q += __shfl_xor(q, 8); rs = 1.0f / sqrtf(q * (1.f / DM) + EPS); }
    const bf16* pr = p.proj + (size_t)t * NPLAIN;
    for (int H = 0; H < 32; ++H) {
        const float v = bf2f(pr[H * 64 + lane]) * rs;
        const float* gain = nullptr; float sc = 1.0f; bf16* dst; bool tr = false; int hh, nh;
        if (H < 8) { gain = p.qna; sc = QSCALE; dst = p.QA; hh = H; nh = 8; }
        else if (H < 10) { gain = p.kna; dst = p.KA; hh = H - 8; nh = 2; }
        else if (H < 12) { dst = p.VAT; hh = H - 10; nh = 2; tr = true; }
        else if (H < 20) { gain = p.qnb; sc = QSCALE; dst = p.QB; hh = H - 12; nh = 8; }
        else { const int slot = (H - 20) >> 1; hh = (H - 20) & 1; nh = 2;
            if (slot == 0) dst = p.KCR; else if (slot == 1) dst = p.VCR; else if (slot == 2) { dst = p.KS; gain = p.knb; } else if (slot == 3) { dst = p.VST; tr = true; } else if (slot == 4) { dst = p.KW; gain = p.knb; } else { dst = p.VWT; tr = true; } }
        float y = v;
        if (gain) { const float ss = wave_sum(v * v); y = v * (1.0f / sqrtf(ss * (1.f / 64.f) + EPS)) * gain[lane] * sc; }
        if (!tr) dst[((size_t)(b * nh + hh) * SEQ + s) * 64 + lane] = (bf16)f2bf(y);
        else dst[(((size_t)(b * nh + hh) * (SEQ / 32) + (s >> 5)) * 64 + lane) * 32 + (s & 31)] = (bf16)f2bf(y);
    }
    if (lane < 24) { const float v = bf2f(pr[2048 + lane]) * rs; p.GT[(size_t)lane * T + t] = 1.0f / (1.0f + __expf(-v)); }
}

__global__ void __launch_bounds__(128) nv_compress(const bf16* KCR, const bf16* VCR, const float* pos, const float* w1, const float* b1, const float* w2, const float* b2, const float* knb, bf16* KC, bf16* VCT) {
    __shared__ float sh[128];
    const int tid = threadIdx.x; int idx = blockIdx.x; const int c = idx & 255; idx >>= 8; const int g = idx & 1, b = (idx >> 1) & 7, kv = idx >> 4;
    if (c == 255) { if (tid < 64) { if (kv == 0) KC[((size_t)(b * 2 + g) * 256 + c) * 64 + tid] = 0; else VCT[(((size_t)(b * 2 + g) * 8 + (c >> 5)) * 64 + tid) * 32 + (c & 31)] = 0; } return; }
    const bf16* raw = (kv == 0 ? KCR : VCR) + ((size_t)(b * 2 + g) * SEQ + 16 * c) * 64;
    float acc = b1[kv * 128 + tid];
    for (int k = 0; k < 2048; ++k) acc += (bf2f(raw[k]) + pos[kv * 2048 + k]) * w1[((size_t)kv * 2048 + k) * 128 + tid];
    sh[tid] = acc / (1.0f + __expf(-acc));
    __syncthreads();
    if (tid < 64) {
        float o = b2[kv * 64 + tid];
        for (int h = 0; h < 128; ++h) o += sh[h] * w2[((size_t)kv * 128 + h) * 64 + tid];
        if (kv == 0) { const float ss = wave_sum(o * o); const float y = o * (1.0f / sqrtf(ss * (1.f / 64.f) + EPS)) * knb[tid]; KC[((size_t)(b * 2 + g) * 256 + c) * 64 + tid] = (bf16)f2bf(y); }
        else VCT[(((size_t)(b * 2 + g) * 8 + (c >> 5)) * 64 + tid) * 32 + (c & 31)] = (bf16)f2bf(o);
    }
}

__device__ __forceinline__ float vt_at(const bf16* VT, int bg, int nblk, int key, int d) { return bf2f(VT[(((size_t)bg * nblk + (key >> 5)) * 64 + d) * 32 + (key & 31)]); }

__global__ void __launch_bounds__(256) nv_band_a(const bf16* QA, const bf16* KA, const bf16* VAT, const float* tbl, const float* sinks, bf16* mix) {
    __shared__ float sq[4][64], sl[4][128];
    const int lane = threadIdx.x & 63, w = threadIdx.x >> 6; const int s = blockIdx.x % SEQ, bg = blockIdx.x / SEQ, g = bg & 1, b = bg >> 1, head = g * 4 + w;
    sq[w][lane] = bf2f(QA[((size_t)(b * 8 + head) * SEQ + s) * 64 + lane]);
    __syncthreads();
    float lg[2];
#pragma unroll
    for (int j = 0; j < 2; ++j) { const int rel = 64 * j + lane, key = s - rel; float v = NEGL;
        if (key >= 0) { const bf16* kr = KA + ((size_t)bg * SEQ + key) * 64; float dot = 0.f; for (int d = 0; d < 64; ++d) dot += sq[w][d] * bf2f(kr[d]); v = dot + tbl[t5_bucket(rel) * 16 + head] * LOG2E; }
        lg[j] = v; }
    const float sk = sinks[head] * LOG2E;
    const float m = fmaxf(wave_max(fmaxf(lg[0], lg[1])), sk);
    const float p0 = exp2f(lg[0] - m), p1 = exp2f(lg[1] - m);
    const float sum = wave_sum(p0 + p1) + exp2f(sk - m);
    sl[w][lane] = p0; sl[w][64 + lane] = p1;
    __syncthreads();
    float o = 0.f;
    for (int rel = 0; rel < 128; ++rel) { const int key = s - rel; if (key >= 0) o += sl[w][rel] * vt_at(VAT, bg, SEQ / 32, key, lane); }
    mix[(size_t)(b * SEQ + s) * 1024 + head * 64 + lane] = (bf16)f2bf(o / sum);
}

__global__ void __launch_bounds__(256) nv_nsa(const bf16* QB, const bf16* KC, const bf16* VCT, const bf16* KS, const bf16* VST, const bf16* KW, const bf16* VWT, const float* GT, const float* tbl, bf16* mix) {
    __shared__ float sq[4][64], sP[4][256], sL[4][1024]; __shared__ unsigned long long smask;
    const int lane = threadIdx.x & 63, w = threadIdx.x >> 6; const int s = blockIdx.x % SEQ, bg = blockIdx.x / SEQ, g = bg & 1, b = bg >> 1, head = g * 4 + w, tc = 8 + head;
    const int t = b * SEQ + s;
    sq[w][lane] = bf2f(QB[((size_t)(b * 8 + head) * SEQ + s) * 64 + lane]);
    __syncthreads();
    const int ncv = s >= 31 ? ((s - 31) / 16 + 1 > 255 ? 255 : (s - 31) / 16 + 1) : 0;
    float lc[4];
#pragma unroll
    for (int j = 0; j < 4; ++j) { const int c = lane + 64 * j; float v = NEGL;
        if (c < ncv) { const bf16* kr = KC + ((size_t)bg * 256 + c) * 64; float dot = 0.f; for (int d = 0; d < 64; ++d) dot += sq[w][d] * bf2f(kr[d]); v = dot + tbl[t5_bucket(s - (16 * c + 31)) * 16 + tc] * LOG2E; }
        lc[j] = v; }
    {
        const float m = wave_max(fmaxf(fmaxf(lc[0], lc[1]), fmaxf(lc[2], lc[3])));
        float p[4]; float ps = 0.f;
#pragma unroll
        for (int j = 0; j < 4; ++j) { p[j] = (lane + 64 * j < ncv) ? exp2f(lc[j] - m) : 0.f; ps += p[j]; }
        const float inv = 1.0f / fmaxf(wave_sum(ps), 1.1754944e-38f);
#pragma unroll
        for (int j = 0; j < 4; ++j) sP[w][lane + 64 * j] = p[j] * inv;
    }
    __syncthreads();
    float o_cmp = 0.f;
    for (int c = 0; c < ncv; ++c) o_cmp += sP[w][c] * vt_at(VCT, bg, 8, c, lane);
    if (w == 0) {
        const int n = lane, cur = s >> 6; float imp = 0.f;
        for (int c = 4 * n - 1; c <= 4 * n + 3; ++c) if (c >= 0 && c < 255) imp += (sP[0][c] + sP[1][c]) + (sP[2][c] + sP[3][c]);
        const bool valid = n <= cur, forced = (n == 0) || (n == cur) || (n == cur - 1);
        const float score = valid ? imp + (forced ? 1000.0f : 0.0f) : -1.0e9f;
        int rank = 0;
        for (int mm = 0; mm < 64; ++mm) { const float sm = __shfl(score, mm); rank += (sm > score || (sm == score && mm < n)) ? 1 : 0; }
        const unsigned long long mk = __ballot(valid && rank < 16);
        if (lane == 0) smask = mk;
    }
    __syncthreads();
    const unsigned long long mask = smask;
    float o_sel = 0.f;
    {
        int cnt = 0; float mx = NEGL;
        for (int n = 0; n < 64; ++n) if ((mask >> n) & 1ull) { const int key = 64 * n + lane, rel = s - key; float v = NEGL;
            if (rel >= 0) { const bf16* kr = KS + ((size_t)bg * SEQ + key) * 64; float dot = 0.f; for (int d = 0; d < 64; ++d) dot += sq[w][d] * bf2f(kr[d]); v = dot + tbl[t5_bucket(rel) * 16 + tc] * LOG2E; }
            sL[w][cnt * 64 + lane] = v; mx = fmaxf(mx, v); ++cnt; }
        mx = wave_max(mx); float ps = 0.f;
        for (int i = 0; i < cnt; ++i) { const float p = exp2f(sL[w][i * 64 + lane] - mx); sL[w][i * 64 + lane] = p; ps += p; }
        ps = wave_sum(ps);
        __syncthreads();
        int i = 0;
        for (int n = 0; n < 64; ++n) if ((mask >> n) & 1ull) { for (int k = 0; k < 64; ++k) { const int key = 64 * n + k; if (key <= s) o_sel += sL[w][i * 64 + k] * vt_at(VST, bg, SEQ / 32, key, lane); } ++i; }
        o_sel /= ps;
        __syncthreads();
    }
    float o_win = 0.f;
    {
        float mx = NEGL;
        for (int j = 0; j < 8; ++j) { const int rel = 64 * j + lane, key = s - rel; float v = NEGL;
            if (key >= 0) { const bf16* kr = KW + ((size_t)bg * SEQ + key) * 64; float dot = 0.f; for (int d = 0; d < 64; ++d) dot += sq[w][d] * bf2f(kr[d]); v = dot + tbl[t5_bucket(rel) * 16 + tc] * LOG2E; }
            sL[w][rel] = v; mx = fmaxf(mx, v); }
        mx = wave_max(mx); float ps = 0.f;
        for (int j = 0; j < 8; ++j) { const float p = exp2f(sL[w][64 * j + lane] - mx); sL[w][64 * j + lane] = p; ps += p; }
        ps = wave_sum(ps);
        __syncthreads();
        for (int rel = 0; rel < 512; ++rel) { const int key = s - rel; if (key >= 0) o_win += sL[w][rel] * vt_at(VWT, bg, SEQ / 32, key, lane); }
        o_win /= ps;
    }
    const float g0 = GT[(size_t)(0 * 8 + head) * T + t], g1 = GT[(size_t)(1 * 8 + head) * T + t], g2 = GT[(size_t)(2 * 8 + head) * T + t];
    mix[(size_t)t * 1024 + 512 + head * 64 + lane] = (bf16)f2bf(g0 * o_cmp + g1 * o_sel + g2 * o_win);
}

enum { F_NORM = 1, F_PROJ = 2, F_CMP = 4, F_ATT = 8 };
struct Args { const float* in[21]; float* out; unsigned char* ws; int ph_lo, ph_hi, flags, pad; };
struct Frame {
    LAS unsigned char* lds; volatile LAS unsigned* MISC; gu32* ctl;
    int tid, lane, wave, vcu, G;
};

__device__ __forceinline__ void p0_item(const float* W, int ldw, int k0, int c0, int nvalid, bf16* WT, int Kd, int drow0, LAS float* scr, int lane) {
#pragma unroll 8
    for (int i = 0; i < 32; ++i) { const int kk = 2 * i + (lane >> 5), n = lane & 31; scr[kk * 33 + n] = (n < nvalid) ? W[(size_t)(k0 + kk) * ldw + c0 + n] : 0.f; }
    LDS_WAIT(); asm volatile("" ::: "memory");
    const int c = lane & 7;
#pragma unroll
    for (int j = 0; j < 4; ++j) { const int n = (lane >> 3) + 8 * j; const LAS float* s = scr + (8 * c) * 33 + n;
        v4u o; o.x = pk2(s[0 * 33], s[1 * 33]); o.y = pk2(s[2 * 33], s[3 * 33]); o.z = pk2(s[4 * 33], s[5 * 33]); o.w = pk2(s[6 * 33], s[7 * 33]);
        *(GAS v4u*)(WT + (size_t)(drow0 + n) * Kd + k0 + 8 * c) = o; }
    LDS_WAIT(); asm volatile("" ::: "memory");
}
__host__ __device__ __forceinline__ int main_colbase(int H) {
    if (H < 8) return 64 * H;
    if (H < 16) return 768 + 64 * (H - 8);
    if (H < 18) return 512 + 64 * (H - 16);
    if (H < 20) return 1280 + 2 * 128 + 64 * (H - 18);
    if (H < 22) return 1280 + 4 * 128 + 64 * (H - 20);
    if (H < 24) return 1280 + 0 * 128 + 64 * (H - 22);
    if (H < 26) return 1280 + 1 * 128 + 64 * (H - 24);
    if (H == 26) return 2048;
    return -1;
}
__host__ __device__ __forceinline__ int vt_colbase(int vh) {
    if (vh < 2) return 640 + 64 * vh;
    if (vh < 4) return 1280 + 3 * 128 + 64 * (vh - 2);
    if (vh < 6) return 1280 + 5 * 128 + 64 * (vh - 4);
    return -1;
}
__device__ __forceinline__ void p0_prologue(Frame& F, const Args& a) {
    LAS float* scr = (LAS float*)(F.lds + RING_OFF + F.wave * 16384);
    const int gw = F.vcu * NWAVES + F.wave, NGW = F.G * NWAVES;
    unsigned char* ws = a.ws;
    constexpr int I_IN = 16 * 176, I_OUT = 44 * 32, I_MAIN = 16 * 56, I_PLAIN = 16 * 72, I_VT = 16 * 16, I_MO = 16 * 32, I_W1 = 2 * 32 * 4, I_W2 = 2 * 2 * 2;
    const bool fproj = (a.flags & F_PROJ) != 0;
    const int i_proj = fproj ? I_MAIN + I_VT : I_PLAIN;
    const int NITEMS = 2 * I_IN + 2 * I_OUT + i_proj + I_MO + I_W1 + I_W2;
    for (int it = gw; it < NITEMS; it += NGW) {
        int r = it;
        if (r < 2 * I_IN) { const int l = r / I_IN; r %= I_IN; const int kb = r / 176, nb = r % 176;
            const int pn = nb >> 3, bj = (nb >> 2) & 1, c = 32 * (nb & 3);
            p0_item(a.in[l ? 19 : 3], 2 * FF, 64 * kb, (bj ? FF : 0) + 128 * pn + c, 32, (bf16*)(ws + (l ? WS_WIN2 : WS_WIN1)), DM, 32 * nb, scr, F.lane); continue; }
        r -= 2 * I_IN;
        if (r < 2 * I_OUT) { const int l = r / I_OUT; r %= I_OUT; const int kb = r / 32, nb = r % 32;
            p0_item(a.in[l ? 20 : 4], DM, 64 * kb, 32 * nb, 32, (bf16*)(ws + (l ? WS_WOUT2 : WS_WOUT1)), FF, 32 * nb, scr, F.lane); continue; }
        r -= 2 * I_OUT;
        if (r < i_proj) {
            if (!fproj) { const int kb = r / 72, nb = r % 72; const int nv = 2072 - 32 * nb; p0_item(a.in[6], 2072, 64 * kb, nv > 0 ? 32 * nb : 0, nv > 32 ? 32 : (nv > 0 ? nv : 0), (bf16*)(ws + WS_WMAIN), DM, 32 * nb, scr, F.lane); continue; }
            if (r < I_MAIN) { const int kb = r / 56, nb = r % 56;
                const int pn = nb >> 3, bj = (nb >> 2) & 1, wc = nb & 3, H = 4 * pn + wc, cb = main_colbase(H);
                const int nv = cb < 0 ? 0 : (H == 26 ? (bj ? 0 : 24) : 32);
                p0_item(a.in[6], 2072, 64 * kb, cb < 0 ? 0 : cb + 32 * bj, nv, (bf16*)(ws + WS_WMAIN), DM, 32 * nb, scr, F.lane); continue; }
            r -= I_MAIN; { const int kb = r / 16, nb = r % 16, vh = nb >> 1, cb = vt_colbase(vh);
                p0_item(a.in[6], 2072, 64 * kb, cb < 0 ? 0 : cb + 32 * (nb & 1), cb < 0 ? 0 : 32, (bf16*)(ws + WS_WVT), DM, 32 * nb, scr, F.lane); continue; }
        }
        r -= i_proj;
        if (r < I_MO) { const int kb = r / 32, nb = r % 32; p0_item(a.in[7], DM, 64 * kb, 32 * nb, 32, (bf16*)(ws + WS_WMO), DM, 32 * nb, scr, F.lane); continue; }
        r -= I_MO;
        if (r < I_W1) { const int kv = r / 128; r %= 128; const int kb = r / 4, nb = r % 4; p0_item(a.in[14] + (size_t)kv * 2048 * 128, 128, 64 * kb, 32 * nb, 32, (bf16*)(ws + WS_W1T) + (size_t)kv * 128 * 2048, 2048, 32 * nb, scr, F.lane); continue; }
        r -= I_W1;
        { const int kv = r / 4; r %= 4; const int kb = r / 2, nb = r % 2; p0_item(a.in[16] + (size_t)kv * 128 * 64, 64, 64 * kb, 32 * nb, 32, (bf16*)(ws + WS_W2T) + (size_t)kv * 64 * 128, 128, 32 * nb, scr, F.lane); }
    }
    if (gw < 256) { const int kv = gw >> 7, hid = gw & 127; float s = 0.f;
        for (int j = 0; j < 32; ++j) { const int k = F.lane + 64 * j; s += a.in[13][kv * 2048 + k] * a.in[14][((size_t)kv * 2048 + k) * 128 + hid]; }
        s = wave_sum(s); if (F.lane == 0) ((float*)(ws + WS_POSB))[gw] = s + a.in[15][gw]; }
    const float* g1 = a.in[2];
    for (int m = gw; m < T; m += NGW) {
        const GAS f32x4* xr = (const GAS f32x4*)(a.in[0] + (size_t)m * DM) + F.lane; const f32x4* gr = (const f32x4*)g1 + F.lane;
        f32x4 v[4]; float s = 0.f;
#pragma unroll
        for (int j = 0; j < 4; ++j) { v[j] = xr[64 * j]; s += (v[j].x * v[j].x + v[j].y * v[j].y) + (v[j].z * v[j].z + v[j].w * v[j].w); }
        const float rstd = 1.0f / sqrtf(wave_sum(s) * (1.f / DM) + EPS);
        GAS unsigned long long* o8 = (GAS unsigned long long*)((bf16*)(ws + WS_A) + (size_t)m * DM) + F.lane;
#pragma unroll
        for (int j = 0; j < 4; ++j) { const f32x4 gg = gr[64 * j]; o8[64 * j] = (unsigned long long)pk2(v[j].x * rstd * gg.x, v[j].y * rstd * gg.y) | ((unsigned long long)pk2(v[j].z * rstd * gg.z, v[j].w * rstd * gg.w) << 32); }
    }
}

__global__ void __launch_bounds__(NWAVES * 64, 2) mk(Args args) {
    extern __shared__ __attribute__((aligned(16))) unsigned char lds[];
    Frame F;
    F.lds = (LAS unsigned char*)lds; F.MISC = (volatile LAS unsigned*)(F.lds + MISC_OFF);
    F.tid = threadIdx.x; F.lane = F.tid & 63; F.wave = __builtin_amdgcn_readfirstlane(F.tid >> 6);
    F.G = gridDim.x; { const int bx = blockIdx.x; F.vcu = (F.G % 8 == 0) ? (bx % 8) * (F.G / 8) + bx / 8 : bx; }
    unsigned char* ws = args.ws; F.ctl = (gu32*)(ws + WS_CTL);
    for (int u = F.tid; u < (LDS_BYTES - LDSCTL_OFF) / 4; u += NWAVES * 64) ((LAS unsigned*)(F.lds + LDSCTL_OFF))[u] = 0u;
    __syncthreads();
    const int lo = args.ph_lo, hi = args.ph_hi, flags = args.flags;
    const bool one = (hi - lo) > 1;
    XcdBarrier bar; bar.bar = (unsigned*)(F.ctl + CW_BAR); bar.x = 0; bar.st = nullptr;
    if (one) bar = xcd_barrier_post((unsigned*)(F.ctl + CW_BAR), F.MISC + 8);
#define IN(k) (lo <= (k) && (k) < hi)
#define SEAM(k) do { if (IN(k) && IN((k) + 1)) xcd_barrier(bar); } while (0)
    bf16* const A = (bf16*)(ws + WS_A); bf16* const ACT = (bf16*)(ws + WS_ACT); bf16* const MIX = (bf16*)(ws + WS_MIX);
    float* const SSQ1 = (float*)(ws + WS_SSQ1); float* const SSQ2 = (float*)(ws + WS_SSQ2);
    const bool fnorm = (flags & F_NORM) != 0;

    if (IN(0)) { p0_prologue(F, args); } SEAM(0);
    if (IN(1)) {
        pg8::Gemm g{A, (const bf16*)(ws + WS_WIN1), T, 2 * FF, DM}; pg8::StaticOrder S; S.init(T, 2 * FF, F.G, (int)blockIdx.x);
        pg8::EpiSwiglu E{ACT, FF, nullptr};
        pg8::gemm_phase<pg8::EpiSwiglu, pg8::StaticOrder, true, true>(F.lds + RING_OFF, g, S, E);
    } SEAM(1);
    if (IN(2)) {
        pg8::Gemm g{ACT, (const bf16*)(ws + WS_WOUT1), T, DM, FF}; pg8::StaticOrder S; S.init(T, DM, F.G, (int)blockIdx.x);
        pg8::EpiResid E{args.in[0], args.out, 0.5f, fnorm ? A : nullptr, args.in[5], fnorm ? SSQ1 : nullptr};
        pg8::gemm_phase<pg8::EpiResid, pg8::StaticOrder, true, true>(F.lds + RING_OFF, g, S, E);
    } SEAM(2);
    if (IN(3)) {
        if (!(flags & F_PROJ)) {
            pg8::Gemm g{A, (const bf16*)(ws + WS_WMAIN), T, NPLAIN, DM}; pg8::StaticOrder S; S.init(T, NPLAIN, F.G, (int)blockIdx.x);
            pg8::EpiPlain E{(bf16*)(ws + WS_PROJ), NPLAIN};
            pg8::gemm_phase<pg8::EpiPlain, pg8::StaticOrder, true, true>(F.lds + RING_OFF, g, S, E);
        }
    } SEAM(3);
    SEAM(4);
    SEAM(5);
    if (IN(6)) {
        pg8::Gemm g{MIX, (const bf16*)(ws + WS_WMO), T, DM, DM}; pg8::StaticOrder S; S.init(T, DM, F.G, (int)blockIdx.x);
        pg8::EpiResid E{args.out, args.out, 1.0f, fnorm ? A : nullptr, args.in[18], fnorm ? SSQ2 : nullptr};
        pg8::gemm_phase<pg8::EpiResid, pg8::StaticOrder, true, true>(F.lds + RING_OFF, g, S, E);
    } SEAM(6);
    if (IN(7)) {
        pg8::Gemm g{A, (const bf16*)(ws + WS_WIN2), T, 2 * FF, DM}; pg8::StaticOrder S; S.init(T, 2 * FF, F.G, (int)blockIdx.x);
        pg8::EpiSwiglu E{ACT, FF, fnorm ? SSQ2 : nullptr};
        pg8::gemm_phase<pg8::EpiSwiglu, pg8::StaticOrder, true, true>(F.lds + RING_OFF, g, S, E);
    } SEAM(7);
    if (IN(8)) {
        pg8::Gemm g{ACT, (const bf16*)(ws + WS_WOUT2), T, DM, FF}; pg8::StaticOrder S; S.init(T, DM, F.G, (int)blockIdx.x);
        pg8::EpiResid E{args.out, args.out, 0.5f, nullptr, nullptr, nullptr};
        pg8::gemm_phase<pg8::EpiResid, pg8::StaticOrder, true, true>(F.lds + RING_OFF, g, S, E);
    }
#undef IN
#undef SEAM
}

static void launch_mk(const Args& base, int lo, int hi, int grid, hipStream_t stream) {
    Args a = base; a.ph_lo = lo; a.ph_hi = hi;
    hipLaunchKernelGGL(mk, dim3(grid), dim3(NWAVES * 64), LDS_BYTES, stream, a);
}
extern "C" void kernel_launch(void* const* d_in, const int* in_sizes, int n_in, void* d_out, int out_size, void* d_ws, size_t ws_size, hipStream_t stream) {
    static int grid = 0;
    if (grid == 0) {
        if (n_in != 21 || in_sizes[0] != T * DM || out_size != T * DM || ws_size < WS_END) { fprintf(stderr, "kernel_launch: unexpected shapes / workspace (%d inputs, ws %zu)\n", n_in, ws_size); grid = -1; return; }
        int dev = 0, cus = 0;
        if (hipGetDevice(&dev) != hipSuccess || hipDeviceGetAttribute(&cus, hipDeviceAttributeMultiprocessorCount, dev) != hipSuccess) { grid = -1; return; }
        if (hipFuncSetAttribute((const void*)mk, hipFuncAttributeMaxDynamicSharedMemorySize, LDS_BYTES) != hipSuccess) { grid = -1; return; }
        (void)hipGetLastError();
        grid = cus;
    }
    if (grid < 0) return;
    (void)hipMemsetAsync((char*)d_ws + WS_CTL, 0, CTL_ZERO_BYTES, stream);
    Args a{};
    for (int i = 0; i < 21; ++i) a.in[i] = (const float*)d_in[i];
    a.out = (float*)d_out; a.ws = (unsigned char*)d_ws; a.flags = KFLAGS;
    unsigned char* ws = (unsigned char*)d_ws;
    const bool fnorm = (KFLAGS & F_NORM) != 0;
    launch_mk(a, 0, 1, grid, stream);
    launch_mk(a, 1, 2, grid, stream);
    launch_mk(a, 2, 3, grid, stream);
    if (!fnorm) hipLaunchKernelGGL(nv_rmsnorm, dim3(T / 4), dim3(256), 0, stream, (const float*)d_out, a.in[5], (bf16*)(ws + WS_A));
    launch_mk(a, 3, 4, grid, stream);
    if (!(KFLAGS & F_PROJ)) {
        HeadPrep hp{(const bf16*)(ws + WS_PROJ), fnorm ? (const float*)(ws + WS_SSQ1) : nullptr, a.in[8], a.in[9], a.in[11], a.in[12],
                    (bf16*)(ws + WS_QA), (bf16*)(ws + WS_QB), (bf16*)(ws + WS_KA), (bf16*)(ws + WS_VAT), (bf16*)(ws + WS_KCR), (bf16*)(ws + WS_VCR), (bf16*)(ws + WS_KS), (bf16*)(ws + WS_VST), (bf16*)(ws + WS_KW), (bf16*)(ws + WS_VWT), (float*)(ws + WS_GT)};
        hipLaunchKernelGGL(nv_headprep, dim3(T / 4), dim3(256), 0, stream, hp);
    }
    if (!(KFLAGS & F_CMP)) hipLaunchKernelGGL(nv_compress, dim3(2 * 8 * 2 * 256), dim3(128), 0, stream, (const bf16*)(ws + WS_KCR), (const bf16*)(ws + WS_VCR), a.in[13], a.in[14], a.in[15], a.in[16], a.in[17], a.in[12], (bf16*)(ws + WS_KC), (bf16*)(ws + WS_VCT));
    else launch_mk(a, 4, 5, grid, stream);
    if (!(KFLAGS & F_ATT)) {
        hipLaunchKernelGGL(nv_band_a, dim3(T * 2), dim3(256), 0, stream, (const bf16*)(ws + WS_QA), (const bf16*)(ws + WS_KA), (const bf16*)(ws + WS_VAT), a.in[1], a.in[10], (bf16*)(ws + WS_MIX));
        hipLaunchKernelGGL(nv_nsa, dim3(T * 2), dim3(256), 0, stream, (const bf16*)(ws + WS_QB), (const bf16*)(ws + WS_KC), (const bf16*)(ws + WS_VCT), (const bf16*)(ws + WS_KS), (const bf16*)(ws + WS_VST), (const bf16*)(ws + WS_KW), (const bf16*)(ws + WS_VWT), (const float*)(ws + WS_GT), a.in[1], (bf16*)(ws + WS_MIX));
    } else launch_mk(a, 5, 6, grid, stream);
    launch_mk(a, 6, 7, grid, stream);
    if (!fnorm) hipLaunchKernelGGL(nv_rmsnorm, dim3(T / 4), dim3(256), 0, stream, (const float*)d_out, a.in[18], (bf16*)(ws + WS_A));
    launch_mk(a, 7, 8, grid, stream);
    launch_mk(a, 8, 9, grid, stream);
}
```

```cpp
#include <hip/hip_runtime.h>
#include <hip/hip_cooperative_groups.h>
#include <cstdio>
#include <cstdint>
#ifndef KFLAGS
#define KFLAGS 15
#endif
#ifndef KREP
#define KREP -1
#endif
__device__ __forceinline__ int hw_lane_id() { int l; asm volatile("v_mbcnt_lo_u32_b32 %0, -1, 0\n\tv_mbcnt_hi_u32_b32 %0, -1, %0" : "=v"(l)); return l; }
namespace pg8 {
#define PG8_LAS __attribute__((address_space(3)))
typedef unsigned short bf16_t;
typedef short bf16x8 __attribute__((ext_vector_type(8)));
typedef float f32x4 __attribute__((ext_vector_type(4)));
typedef unsigned u32x4 __attribute__((ext_vector_type(4)));
constexpr int BM = 256, BK = 64, HALF = 128, HTB = HALF * BK * 2  , STAGE_BYTES = 8 * HTB, NXCD = 8, WGM = 8;

__host__ __device__ __forceinline__ int lds_byte(int r, int c) { const int st = (r >> 4) * 2 + (c >> 5), rr = r & 15, cc = c & 31, ob = rr * 64 + cc * 2; return st * 1024 + (ob ^ (((ob >> 9) & 1) << 5)); }
__host__ __device__ __forceinline__ void stage_rc(int b, int& R, int& C) { const int st = b / 1024, sb = b % 1024, swz = sb ^ (((sb >> 9) & 1) << 5); R = (st >> 1) * 16 + swz / 64; C = (st & 1) * 32 + (swz % 64) / 2; }
__host__ __device__ __forceinline__ int perm32(int rho) { const int n = rho >> 4, i = rho & 15; return 8 * (i >> 2) + 4 * n + (i & 3); }

struct Unit { int pm, pn; };
struct Gemm { const bf16_t* A; const bf16_t* Bt; int M, N, K; };

struct StaticOrder {
    int nM, nN, nwg, G, c;
    __host__ __device__ void init(int M, int N, int G_, int c_) { nM = M / BM; nN = N / BM; nwg = nM * nN; G = G_; c = c_; }
    __host__ __device__ bool next(int i, Unit& u) const {
        const long L = (long)i * G + c; if (L >= nwg) return false;
        int wgid = (int)L; { const int q = nwg / NXCD, r = nwg % NXCD, xcd = wgid % NXCD, off = wgid / NXCD; wgid = (xcd < r ? xcd * (q + 1) : r * (q + 1) + (xcd - r) * q) + off; }
        const int nig = WGM * nN, gid = wgid / nig, fm = gid * WGM, gsz = (nM - fm) < WGM ? (nM - fm) : WGM;
        u.pm = fm + ((wgid % nig) % gsz); u.pn = (wgid % nig) / gsz; return true;
    }
    __device__ __forceinline__ void a_ready(const Unit&) const {}
    __device__ __forceinline__ void done(const Unit&) const {}
};


__device__ __forceinline__ unsigned cvt_pk_bf16(float lo, float hi) { unsigned r; asm volatile("v_cvt_pk_bf16_f32 %0, %1, %2" : "=v"(r) : "v"(lo), "v"(hi)); return r; }
typedef unsigned u32x2 __attribute__((ext_vector_type(2)));
constexpr float kLog2e = 1.4426950408889634f;
__device__ __forceinline__ float silu_f(float x) { return x * __builtin_amdgcn_rcpf(1.0f + __builtin_amdgcn_exp2f(-x * kLog2e)); }
typedef float f32x2 __attribute__((ext_vector_type(2)));
__device__ __forceinline__ f32x2 silu_mul_pk(f32x2 g, f32x2 u) {
    f32x2 e; e.x = __builtin_amdgcn_exp2f(-g.x); e.y = __builtin_amdgcn_exp2f(-g.y);
    const f32x2 d = e + 1.0f; f32x2 r; r.x = __builtin_amdgcn_rcpf(d.x); r.y = __builtin_amdgcn_rcpf(d.y);
    return (g * r) * u;
}
__device__ __forceinline__ float row_rstd(const float* ssq, int row, int fq) {
    const f32x4 p = *(const f32x4*)(ssq + (size_t)row * 16 + 4 * fq);
    float s = (p[0] + p[1]) + (p[2] + p[3]);
    s += __shfl_xor(s, 16); s += __shfl_xor(s, 32);
    return __builtin_amdgcn_rsqf(s * (1.0f / 1024.0f) + 1e-6f);
}

__device__ __forceinline__ void rows_rstd(float (&rs)[2][4], const float* ssq, int row0, int fq) {
    f32x4 p[2][4];
#pragma unroll
    for (int ai = 0; ai < 2; ++ai)
#pragma unroll
        for (int m = 0; m < 4; ++m) p[ai][m] = *(const f32x4*)(ssq + (size_t)(row0 + ai * HALF + m * 16) * 16 + 4 * fq);
#pragma unroll
    for (int ai = 0; ai < 2; ++ai)
#pragma unroll
        for (int m = 0; m < 4; ++m) { float s = (p[ai][m][0] + p[ai][m][1]) + (p[ai][m][2] + p[ai][m][3]); s += __shfl_xor(s, 16); s += __shfl_xor(s, 32); rs[ai][m] = __builtin_amdgcn_rsqf(s * (1.0f / 1024.0f) + 1e-6f); }
    asm volatile("" ::: "memory");
}

struct EpiPlain {
    static constexpr bool PERM = true, AFTER_DRAIN = false;
    bf16_t* O; int ldc;
    __device__ __forceinline__ void operator()(const f32x4 (&acc)[2][2][4][2], const Unit& u, int wr, int wc, int fr, int fq) const {
        const int row0 = u.pm * BM + wr * 64 + fr, col0 = u.pn * BM + wc * 32 + 8 * fq;
#pragma unroll
        for (int ai = 0; ai < 2; ++ai)
#pragma unroll
            for (int m = 0; m < 4; ++m) { bf16_t* rowp = O + (size_t)(row0 + ai * HALF + m * 16) * ldc + col0;
#pragma unroll
                for (int bj = 0; bj < 2; ++bj) { const f32x4 v0 = acc[ai][bj][m][0], v1 = acc[ai][bj][m][1]; u32x4 w;
                    w.x = cvt_pk_bf16(v0[0], v0[1]); w.y = cvt_pk_bf16(v0[2], v0[3]); w.z = cvt_pk_bf16(v1[0], v1[1]); w.w = cvt_pk_bf16(v1[2], v1[3]);
                    *(u32x4*)(rowp + bj * HALF) = w; } }
    }
};

struct EpiSwiglu {
    static constexpr bool PERM = true, AFTER_DRAIN = false;
    bf16_t* O; int ldo; const float* ssq;
    __device__ __forceinline__ void operator()(const f32x4 (&acc)[2][2][4][2], const Unit& u, int wr, int wc, int fr, int fq) const {
        const int row0 = u.pm * BM + wr * 64 + fr, col0 = u.pn * HALF + wc * 32 + 8 * fq;
        const __amdgpu_buffer_rsrc_t orsrc = __builtin_amdgcn_make_buffer_rsrc((void*)O, 0, 0x7FFFFFFF, 0x00020000);
        const unsigned ovoff = (unsigned)(row0 * ldo + col0) * 2u;
        float rsv[2][4];
        if (ssq) rows_rstd(rsv, ssq, row0, fq);
#pragma unroll
        for (int ai = 0; ai < 2; ++ai)
#pragma unroll
            for (int m = 0; m < 4; ++m) { const int row = row0 + ai * HALF + m * 16;
                const float rs = ssq ? rsv[ai][m] : 1.0f;
                const f32x4 g0 = acc[ai][0][m][0] * rs, g1 = acc[ai][0][m][1] * rs, u0 = acc[ai][1][m][0] * rs, u1 = acc[ai][1][m][1] * rs;
                u32x4 w;
                const f32x2 a0 = silu_mul_pk((f32x2){g0[0], g0[1]}, (f32x2){u0[0], u0[1]}), a1 = silu_mul_pk((f32x2){g0[2], g0[3]}, (f32x2){u0[2], u0[3]});
                const f32x2 a2 = silu_mul_pk((f32x2){g1[0], g1[1]}, (f32x2){u1[0], u1[1]}), a3 = silu_mul_pk((f32x2){g1[2], g1[3]}, (f32x2){u1[2], u1[3]});
                w.x = cvt_pk_bf16(a0.x, a0.y); w.y = cvt_pk_bf16(a1.x, a1.y); w.z = cvt_pk_bf16(a2.x, a2.y); w.w = cvt_pk_bf16(a3.x, a3.y);
                __builtin_amdgcn_raw_buffer_store_b128(w, orsrc, ovoff, (ai * HALF + m * 16) * ldo * 2, 0); }
    }
};

struct EpiResid {
    static constexpr bool PERM = true, AFTER_DRAIN = false;
    const float* bf; const bf16_t* bb; float alpha; float* of; bf16_t* ob; float* ssq;
    __device__ __forceinline__ void operator()(const f32x4 (&acc)[2][2][4][2], const Unit& u, int wr, int wc, int fr, int fq) const {
        const int row0 = u.pm * BM + wr * 64 + fr, col0 = u.pn * BM + wc * 32 + 8 * fq;
#pragma unroll
        for (int ai = 0; ai < 2; ++ai) {
            u32x4 pb[4][2];
            if (!bf) {
#pragma unroll
                for (int m = 0; m < 4; ++m)
#pragma unroll
                    for (int bj = 0; bj < 2; ++bj) pb[m][bj] = *(const u32x4*)(bb + (size_t)(row0 + ai * HALF + m * 16) * 1024 + col0 + bj * HALF);
            }
#pragma unroll
            for (int mp = 0; mp < 2; ++mp) {
                f32x4 pf[2][2][2];
                if (bf) {
#pragma unroll
                    for (int mm = 0; mm < 2; ++mm)
#pragma unroll
                        for (int bj = 0; bj < 2; ++bj)
#pragma unroll
                            for (int n = 0; n < 2; ++n) pf[mm][bj][n] = __builtin_nontemporal_load((const f32x4*)(bf + (size_t)(row0 + ai * HALF + (2 * mp + mm) * 16) * 1024 + col0 + bj * HALF + n * 4));
                }
#pragma unroll
                for (int mm = 0; mm < 2; ++mm) { const int m = 2 * mp + mm; const int row = row0 + ai * HALF + m * 16; const size_t off = (size_t)row * 1024 + col0; float ss = 0.f;
#pragma unroll
                    for (int bj = 0; bj < 2; ++bj) { const size_t o2 = off + bj * HALF; f32x4 o[2];
#pragma unroll
                        for (int n = 0; n < 2; ++n) { f32x4 bse;
                            if (bf) bse = pf[mm][bj][n];
                            else { const unsigned w0 = n ? pb[m][bj].z : pb[m][bj].x, w1 = n ? pb[m][bj].w : pb[m][bj].y;
                                bse[0] = __uint_as_float(w0 << 16); bse[1] = __uint_as_float(w0 & 0xffff0000u); bse[2] = __uint_as_float(w1 << 16); bse[3] = __uint_as_float(w1 & 0xffff0000u); }
                            o[n] = bse + acc[ai][bj][m][n] * alpha;
                            ss += (o[n][0] * o[n][0] + o[n][1] * o[n][1]) + (o[n][2] * o[n][2] + o[n][3] * o[n][3]); }
                        if (of) { __builtin_nontemporal_store(o[0], (f32x4*)(of + o2)); __builtin_nontemporal_store(o[1], (f32x4*)(of + o2 + 4)); }
                        if (ob) { u32x4 w; w.x = cvt_pk_bf16(o[0][0], o[0][1]); w.y = cvt_pk_bf16(o[0][2], o[0][3]); w.z = cvt_pk_bf16(o[1][0], o[1][1]); w.w = cvt_pk_bf16(o[1][2], o[1][3]); *(u32x4*)(ob + o2) = w; } }
                    if (ssq) { ss += __shfl_xor(ss, 16); ss += __shfl_xor(ss, 32); if (fq == 0) ssq[(size_t)row * 16 + u.pn * 4 + wc] = ss; } }
                asm volatile("" ::: "memory");
            }
        }
    }
};

struct EpiResidB {
    static constexpr bool PERM = true, AFTER_DRAIN = false;
    const bf16_t* bb; float alpha; float* of; bf16_t* ob; float* ssq;
    __device__ __forceinline__ void operator()(const f32x4 (&acc)[2][2][4][2], const Unit& u, int wr, int wc, int fr, int fq) const {
        const int row0 = u.pm * BM + wr * 64 + fr, col0 = u.pn * BM + wc * 32 + 8 * fq;
        u32x4 pb[2][4][2];
#pragma unroll
        for (int ai = 0; ai < 2; ++ai)
#pragma unroll
            for (int m = 0; m < 4; ++m)
#pragma unroll
                for (int bj = 0; bj < 2; ++bj) pb[ai][m][bj] = *(const u32x4*)(bb + (size_t)(row0 + ai * HALF + m * 16) * 1024 + col0 + bj * HALF);
#pragma unroll
        for (int ai = 0; ai < 2; ++ai) {
#pragma unroll
            for (int m = 0; m < 4; ++m) { const int row = row0 + ai * HALF + m * 16; const size_t off = (size_t)row * 1024 + col0; float ss = 0.f;
#pragma unroll
                for (int bj = 0; bj < 2; ++bj) { const size_t o2 = off + bj * HALF; f32x4 o[2];
#pragma unroll
                    for (int n = 0; n < 2; ++n) { f32x4 bse; const unsigned w0 = n ? pb[ai][m][bj].z : pb[ai][m][bj].x, w1 = n ? pb[ai][m][bj].w : pb[ai][m][bj].y;
                        bse[0] = __uint_as_float(w0 << 16); bse[1] = __uint_as_float(w0 & 0xffff0000u); bse[2] = __uint_as_float(w1 << 16); bse[3] = __uint_as_float(w1 & 0xffff0000u);
                        o[n] = bse + acc[ai][bj][m][n] * alpha;
                        ss += (o[n][0] * o[n][0] + o[n][1] * o[n][1]) + (o[n][2] * o[n][2] + o[n][3] * o[n][3]); }
                    if (of) { __builtin_nontemporal_store(o[0], (f32x4*)(of + o2)); __builtin_nontemporal_store(o[1], (f32x4*)(of + o2 + 4)); }
                    if (ob) { u32x4 w; w.x = cvt_pk_bf16(o[0][0], o[0][1]); w.y = cvt_pk_bf16(o[0][2], o[0][3]); w.z = cvt_pk_bf16(o[1][0], o[1][1]); w.w = cvt_pk_bf16(o[1][2], o[1][3]); *(u32x4*)(ob + o2) = w; } }
                if (ssq) { ss += __shfl_xor(ss, 16); ss += __shfl_xor(ss, 32); if (fq == 0) ssq[(size_t)row * 16 + u.pn * 4 + wc] = ss; } }
            asm volatile("" ::: "memory");
        }
    }
};

struct EpiProjMain {
    static constexpr bool PERM = true, AFTER_DRAIN = false;
    const float* ssq; float* rstd_out; const float *qna, *kna, *qnb, *knb;
    bf16_t *QA, *QB, *KA, *KS, *KW, *KCR, *VCR; float* GT; float qscale; int seq, ntok;
    __device__ __forceinline__ void operator()(const f32x4 (&acc)[2][2][4][2], const Unit& u, int wr, int wc, int fr, int fq) const {
        const int H = 4 * u.pn + wc, row0 = u.pm * BM + wr * 64 + fr;
        const float* gain = nullptr; bf16_t* dst = nullptr; float sc = 1.0f; int nh = 2, hh = H & 1;
        if (H < 8) { gain = qna; dst = QA; sc = qscale; nh = 8; hh = H; }
        else if (H < 16) { gain = qnb; dst = QB; sc = qscale; nh = 8; hh = H - 8; }
        else if (H < 18) { gain = kna; dst = KA; }
        else if (H < 20) { gain = knb; dst = KS; }
        else if (H < 22) { gain = knb; dst = KW; }
        else if (H < 24) { dst = KCR; }
        else if (H < 26) { dst = VCR; }
        f32x4 gv[2][2];
#pragma unroll
        for (int bj = 0; bj < 2; ++bj)
#pragma unroll
            for (int n = 0; n < 2; ++n) gv[bj][n] = gain ? *(const f32x4*)(gain + 32 * bj + 8 * fq + 4 * n) * sc : (f32x4){1.f, 1.f, 1.f, 1.f};
        float rsv[2][4]; rows_rstd(rsv, ssq, row0, fq);
#pragma unroll
        for (int ai = 0; ai < 2; ++ai)
#pragma unroll
            for (int m = 0; m < 4; ++m) { const int row = row0 + ai * HALF + m * 16;
                const float rs = rsv[ai][m];
                if (H == 27) continue;
                if (H == 26) {
                    if (fq < 3) {
#pragma unroll
                        for (int n = 0; n < 2; ++n) { f32x4 gv4; const float nrs = -rs * kLog2e;
#pragma unroll
                            for (int i = 0; i < 4; ++i) gv4[i] = __builtin_amdgcn_rcpf(1.0f + __builtin_amdgcn_exp2f(acc[ai][0][m][n][i] * nrs));
                            *(f32x4*)(GT + (size_t)row * 32 + 8 * fq + 4 * n) = gv4; }
                    }
                    continue;
                }
                float f = rs;
                if (gain) { float ss = 0.f;
#pragma unroll
                    for (int bj = 0; bj < 2; ++bj)
#pragma unroll
                        for (int n = 0; n < 2; ++n) { const f32x4 q = acc[ai][bj][m][n]; ss += (q[0] * q[0] + q[1] * q[1]) + (q[2] * q[2] + q[3] * q[3]); }
                    ss += __shfl_xor(ss, 16); ss += __shfl_xor(ss, 32); f = rs * __builtin_amdgcn_rsqf(ss * (rs * rs) * (1.0f / 64.0f) + 1e-6f); }
                const int b = row / seq, s = row % seq;
                bf16_t* rowp = dst + ((size_t)(b * nh + hh) * seq + s) * 64 + 8 * fq;
#pragma unroll
                for (int bj = 0; bj < 2; ++bj) { const f32x4 v0 = acc[ai][bj][m][0] * gv[bj][0] * f, v1 = acc[ai][bj][m][1] * gv[bj][1] * f; u32x4 w;
                    w.x = cvt_pk_bf16(v0[0], v0[1]); w.y = cvt_pk_bf16(v0[2], v0[3]); w.z = cvt_pk_bf16(v1[0], v1[1]); w.w = cvt_pk_bf16(v1[2], v1[3]);
                    *(u32x4*)(rowp + 32 * bj) = w; } }
    }
};
struct EpiProjT {
    static constexpr bool PERM = true, AFTER_DRAIN = false;
    const float* ssq; bf16_t* VT0; size_t vstride; int seq;
    __device__ __forceinline__ void operator()(const f32x4 (&acc)[2][2][4][2], const Unit& u, int wr, int wc, int fr, int fq) const {
#pragma unroll
        for (int bj = 0; bj < 2; ++bj) { const int t0 = u.pn * BM + bj * HALF + wc * 32 + 8 * fq;
            float q8[8];
#pragma unroll
            for (int i = 0; i < 8; ++i) q8[i] = ssq[(size_t)(t0 + i) * 16 + fr];
#pragma unroll
            for (int i = 0; i < 8; ++i) { float q = q8[i]; q += __shfl_xor(q, 1); q += __shfl_xor(q, 2); q += __shfl_xor(q, 4); q += __shfl_xor(q, 8); q8[i] = __builtin_amdgcn_rsqf(q * (1.0f / 1024.0f) + 1e-6f); }
            const f32x4 r0 = {q8[0], q8[1], q8[2], q8[3]}, r1 = {q8[4], q8[5], q8[6], q8[7]};
            const int b = t0 / seq, s = t0 % seq;
#pragma unroll
            for (int ai = 0; ai < 2; ++ai) { const int vh = 4 * u.pm + 2 * ai + wr; if (vh >= 6) continue;
                bf16_t* dst = VT0 + (size_t)(vh >> 1) * vstride; const int g = vh & 1;
                bf16_t* blk = dst + ((size_t)(b * 2 + g) * (seq / 32) + (s >> 5)) * 2048 + (s & 31);
#pragma unroll
                for (int m = 0; m < 4; ++m) { const int d = 16 * m + fr; const f32x4 v0 = acc[ai][bj][m][0] * r0, v1 = acc[ai][bj][m][1] * r1; u32x4 w;
                    w.x = cvt_pk_bf16(v0[0], v0[1]); w.y = cvt_pk_bf16(v0[2], v0[3]); w.z = cvt_pk_bf16(v1[0], v1[1]); w.w = cvt_pk_bf16(v1[2], v1[3]);
                    *(u32x4*)(blk + d * 32) = w; } } }
    }
};
struct OneUnit {
    int pm, pn;
    __device__ __forceinline__ bool next(int i, Unit& u) const { if (i) return false; u.pm = pm; u.pn = pn; return true; }
    __device__ __forceinline__ void a_ready(const Unit&) const {}
    __device__ __forceinline__ void done(const Unit&) const {}
};
template <class Epi, class Sched, bool ALIGN_EPI = false, bool SP2 = false, bool AHALF = false>
__device__ __forceinline__ void gemm_phase(PG8_LAS unsigned char* lds, const Gemm g, const Sched& S, const Epi& E, int wv  ) {
    static_assert(!AHALF || SP2, "AHALF is written for the SP2 loop");
    const int wid = wv, lane = hw_lane_id(), tid = wid * 64 + lane, wr = wid >> 2, wc = wid & 3, fr = lane & 15, fq = lane >> 4;
    const int K = g.K, nt = K / BK;
    unsigned voffA[2], voffB[2];
#pragma unroll
    for (int i = 0; i < 2; ++i) { int R, C; stage_rc(tid * 16 + i * 8192, R, C); const int Rb = Epi::PERM ? ((R & ~31) + perm32(R & 31)) : R;
        voffA[i] = (unsigned)(R * K + C) * 2u; voffB[i] = (unsigned)(Rb * K + C) * 2u; }
    const size_t kstep = (size_t)(BK * 2);
    const size_t hstep = (size_t)HALF * K * 2;
    const size_t tstep = 2 * hstep;
    const unsigned ldsw = (unsigned)wid * 1024u;
    const int aoff = lds_byte(wr * 64 + fr, fq * 8), boff = lds_byte(wc * 32 + fr, fq * 8);
#define PG8_SA(b, h) (((b) * 2 + (h)) * HTB)
#define PG8_SB(b, h) ((4 + (b) * 2 + (h)) * HTB)
#define PG8_STAGE(bufoff, gbase, voff) do { _Pragma("unroll") for (int _i = 0; _i < 2; ++_i) \
        __builtin_amdgcn_global_load_lds((const unsigned*)((const char*)(gbase) + (voff)[_i]), (PG8_LAS unsigned*)(lds + (bufoff) + ldsw + _i * 8192), 16, 0, 0); } while (0)
#define PG8_LDA(dst, b, h) do { _Pragma("unroll") for (int m = 0; m < 4; ++m) _Pragma("unroll") for (int k = 0; k < 2; ++k) dst[m][k] = *(const PG8_LAS bf16x8*)(lds + PG8_SA(b, h) + aoff + m * 2048 + k * 1024); } while (0)
#define PG8_LDB(dst, b, h) do { _Pragma("unroll") for (int n = 0; n < 2; ++n) _Pragma("unroll") for (int k = 0; k < 2; ++k) dst[n][k] = *(const PG8_LAS bf16x8*)(lds + PG8_SB(b, h) + boff + n * 2048 + k * 1024); } while (0)
#define PG8_MMA(ai, bj, At, Bt) do { __builtin_amdgcn_s_setprio(1); _Pragma("unroll") for (int m = 0; m < 4; ++m) _Pragma("unroll") for (int n = 0; n < 2; ++n) _Pragma("unroll") for (int k = 0; k < 2; ++k) \
        acc[ai][bj][m][n] = __builtin_amdgcn_mfma_f32_16x16x32_bf16(Bt[n][k], At[m][k], acc[ai][bj][m][n], 0, 0, 0); __builtin_amdgcn_s_setprio(0); } while (0)
#define PG8_WAIT_V(n) asm volatile("s_waitcnt vmcnt(" #n ")" ::: "memory")
#define PG8_WAIT_L(n) asm volatile("s_waitcnt lgkmcnt(" #n ")" ::: "memory")
#define PG8_BAR __builtin_amdgcn_s_barrier()
#define PG8_SCHED __builtin_amdgcn_sched_barrier(0)
    Unit cur, nxt; int ui = 0;
    if (!S.next(0, cur)) return;
    f32x4 acc[2][2][4][2];
#pragma unroll
    for (int a = 0; a < 2; ++a)
#pragma unroll
        for (int b = 0; b < 2; ++b)
#pragma unroll
            for (int m = 0; m < 4; ++m)
#pragma unroll
                for (int n = 0; n < 2; ++n) acc[a][b][m][n] = (f32x4){0.f, 0.f, 0.f, 0.f};
    bf16x8 At[4][2], B0[2][2], B1[2][2];
    const char* cA = (const char*)g.A + (size_t)cur.pm * tstep; const char* cB = (const char*)g.Bt + (size_t)cur.pn * tstep;
    S.a_ready(cur);
    if constexpr (SP2) {
        PG8_STAGE(PG8_SB(0, 0), cB, voffB); PG8_STAGE(PG8_SB(0, 1), cB + hstep, voffB); PG8_STAGE(PG8_SA(0, 0), cA, voffA); PG8_STAGE(PG8_SA(0, 1), cA + hstep, voffA);
        if (wr == 1) PG8_BAR;
        PG8_WAIT_V(2); PG8_BAR;
        PG8_STAGE(PG8_SB(1, 0), cB + kstep, voffB); PG8_STAGE(PG8_SA(1, 0), cA + kstep, voffA); PG8_STAGE(PG8_SB(1, 1), cB + hstep + kstep, voffB);
        PG8_WAIT_V(6); PG8_BAR;
    } else {
        PG8_STAGE(PG8_SB(0, 0), cB, voffB); PG8_STAGE(PG8_SA(0, 0), cA, voffA); PG8_STAGE(PG8_SB(0, 1), cB + hstep, voffB); PG8_STAGE(PG8_SA(0, 1), cA + hstep, voffA);
        if (wr == 1) PG8_BAR;
        PG8_WAIT_V(4); PG8_BAR;
        PG8_STAGE(PG8_SB(1, 0), cB + kstep, voffB); PG8_STAGE(PG8_SA(1, 0), cA + kstep, voffA); PG8_STAGE(PG8_SB(1, 1), cB + hstep + kstep, voffB);
        PG8_WAIT_V(6); PG8_BAR;
    }
    for (;;) {
        const bool has_next = S.next(ui + 1, nxt);
        const char* nA = has_next ? (const char*)g.A + (size_t)nxt.pm * tstep : cA; const char* nB = has_next ? (const char*)g.Bt + (size_t)nxt.pn * tstep : cB;
        for (int t = 0; t < nt; t += 2) {
            const bool last = (t == nt - 2);
            const char* a1 = cA + (size_t)(t + 1) * kstep;
            const char* a2 = last ? nA : cA + (size_t)(t + 2) * kstep; const char* b2 = last ? nB : cB + (size_t)(t + 2) * kstep;
            const char* a3 = a2 + kstep; const char* b3 = b2 + kstep;
            if (last && has_next) S.a_ready(nxt);
            if constexpr (SP2) {
            PG8_LDB(B0, 0, 0); PG8_LDB(B1, 0, 1); PG8_SCHED; PG8_LDA(At, 0, 0); PG8_STAGE(PG8_SA(1, 1), a1 + hstep, voffA);
            PG8_WAIT_V(8); PG8_WAIT_L(0); PG8_BAR; PG8_MMA(0, 0, At, B0); PG8_MMA(0, 1, At, B1); PG8_BAR; PG8_SCHED;
            if constexpr (!AHALF) PG8_LDA(At, 0, 1);
            PG8_STAGE(PG8_SB(0, 0), b2, voffB); PG8_STAGE(PG8_SB(0, 1), b2 + hstep, voffB); PG8_STAGE(PG8_SA(0, 0), a2, voffA);
            PG8_WAIT_V(8); PG8_WAIT_L(0); PG8_BAR; if constexpr (!AHALF) { PG8_MMA(1, 0, At, B0); PG8_MMA(1, 1, At, B1); } PG8_BAR; PG8_SCHED;
            PG8_LDB(B0, 1, 0); PG8_LDB(B1, 1, 1); PG8_SCHED; PG8_LDA(At, 1, 0); PG8_STAGE(PG8_SA(0, 1), a2 + hstep, voffA);
            PG8_WAIT_V(8); PG8_WAIT_L(0); PG8_BAR; PG8_MMA(0, 0, At, B0); PG8_MMA(0, 1, At, B1); PG8_BAR; PG8_SCHED;
            if constexpr (!AHALF) PG8_LDA(At, 1, 1);
            PG8_STAGE(PG8_SB(1, 0), b3, voffB); PG8_STAGE(PG8_SB(1, 1), b3 + hstep, voffB); PG8_STAGE(PG8_SA(1, 0), a3, voffA);
            PG8_WAIT_V(8); PG8_WAIT_L(0); PG8_BAR; if constexpr (!AHALF) { PG8_MMA(1, 0, At, B0); PG8_MMA(1, 1, At, B1); } PG8_BAR; PG8_SCHED;
            } else {
            PG8_LDB(B0, 0, 0); PG8_SCHED; PG8_LDA(At, 0, 0); PG8_STAGE(PG8_SA(1, 1), a1 + hstep, voffA);
            PG8_WAIT_L(8); PG8_BAR; PG8_WAIT_L(0); PG8_MMA(0, 0, At, B0); PG8_BAR; PG8_SCHED;
            PG8_LDB(B1, 0, 1); PG8_STAGE(PG8_SB(0, 0), b2, voffB);
            PG8_BAR; PG8_WAIT_L(0); PG8_MMA(0, 1, At, B1); PG8_BAR;
            PG8_LDA(At, 0, 1); PG8_STAGE(PG8_SA(0, 0), a2, voffA);
            PG8_BAR; PG8_WAIT_L(0); PG8_MMA(1, 0, At, B0); PG8_BAR; PG8_SCHED;
            PG8_STAGE(PG8_SB(0, 1), b2 + hstep, voffB);
            PG8_WAIT_V(6); PG8_BAR; PG8_MMA(1, 1, At, B1); PG8_BAR;
            PG8_LDB(B0, 1, 0); PG8_SCHED; PG8_LDA(At, 1, 0); PG8_STAGE(PG8_SA(0, 1), a2 + hstep, voffA);
            PG8_WAIT_L(8); PG8_BAR; PG8_WAIT_L(0); PG8_MMA(0, 0, At, B0); PG8_BAR; PG8_SCHED;
            PG8_LDB(B1, 1, 1); PG8_STAGE(PG8_SB(1, 0), b3, voffB);
            PG8_BAR; PG8_WAIT_L(0); PG8_MMA(0, 1, At, B1); PG8_BAR;
            PG8_LDA(At, 1, 1); PG8_STAGE(PG8_SA(1, 0), a3, voffA);
            PG8_BAR; PG8_WAIT_L(0); PG8_MMA(1, 0, At, B0); PG8_BAR; PG8_SCHED;
            PG8_STAGE(PG8_SB(1, 1), b3 + hstep, voffB);
            PG8_WAIT_V(6); PG8_BAR; PG8_MMA(1, 1, At, B1); PG8_BAR;
            }
        }
        if constexpr (ALIGN_EPI) { if (wr == 0) PG8_BAR; }
        if constexpr (!Epi::AFTER_DRAIN) { E(acc, cur, wr, wc, fr, fq); S.done(cur); }
        if (!has_next) break;
#pragma unroll
        for (int a = 0; a < 2; ++a)
#pragma unroll
            for (int b = 0; b < 2; ++b)
#pragma unroll
                for (int m = 0; m < 4; ++m)
#pragma unroll
                    for (int n = 0; n < 2; ++n) acc[a][b][m][n] = (f32x4){0.f, 0.f, 0.f, 0.f};
        cur = nxt; cA = nA; cB = nB; ++ui;
        if constexpr (ALIGN_EPI) { if (wr == 1) PG8_BAR; }
    }
    PG8_WAIT_V(0);
    if constexpr (!ALIGN_EPI) { if (wr == 0) PG8_BAR; }
    PG8_BAR;
    if constexpr (Epi::AFTER_DRAIN) { E.fused(acc, cur, wr, wc, fr, fq, lds, wid, lane); S.done(cur); }
#undef PG8_SA
#undef PG8_SB
#undef PG8_STAGE
#undef PG8_LDA
#undef PG8_LDB
#undef PG8_MMA
#undef PG8_WAIT_V
#undef PG8_WAIT_L
#undef PG8_BAR
#undef PG8_SCHED
}
}
#define GAS __attribute__((address_space(1)))
#define LAS __attribute__((address_space(3)))
typedef unsigned short bf16;
typedef unsigned v4u __attribute__((ext_vector_type(4)));
typedef float f32x4 __attribute__((ext_vector_type(4)));
typedef short bf16x8 __attribute__((ext_vector_type(8)));
typedef GAS unsigned gu32;
typedef GAS unsigned long long gu64;
#define RLX_AGENT __ATOMIC_RELAXED, __HIP_MEMORY_SCOPE_AGENT
#define LDS_WAIT() asm volatile("s_waitcnt lgkmcnt(0)" ::: "memory")
#define VM_WAIT() asm volatile("s_waitcnt vmcnt(0)" ::: "memory")
__device__ __forceinline__ unsigned long long rt() { return __builtin_amdgcn_s_memrealtime(); }
__device__ __forceinline__ unsigned f2bf(float f) { unsigned u = __builtin_bit_cast(unsigned, f); return (u + 0x7fffu + ((u >> 16) & 1u)) >> 16; }
__device__ __forceinline__ unsigned pk2(float lo, float hi) { return f2bf(lo) | (f2bf(hi) << 16); }

#define XB_TMO      128
#define XB_XCNT(j)  (256  + 64 * (j))
#define XB_XSUB(j)  (1280 + 64 * (j))
#define XB_XGEN(j)  (2304 + 64 * (j))
#define XB_TOP      3328
#define XB_TOPGEN   3392
#define XCD_BAR_WORDS 3456
#define XB_SPIN_CAP (1u << 18)

__device__ __forceinline__ unsigned xb_ld(unsigned* p)              { return __hip_atomic_load(p, __ATOMIC_RELAXED, __HIP_MEMORY_SCOPE_AGENT); }
__device__ __forceinline__ unsigned xb_add(unsigned* p, unsigned v) { return __hip_atomic_fetch_add(p, v, __ATOMIC_RELAXED, __HIP_MEMORY_SCOPE_AGENT); }
__device__ __forceinline__ unsigned xb_xcc_id() { return (unsigned)__builtin_amdgcn_s_getreg((3 << 11) | 20) & 0xFu; }
#define XB_SPIN(cond, bar) do { unsigned _sp = 0; while (cond) { __builtin_amdgcn_s_sleep(1); \
    if ((++_sp & 255u) == 0u) { if (xb_ld(&(bar)[XB_TMO])) break; if (_sp > XB_SPIN_CAP) { atomicAdd(&(bar)[XB_TMO], 1u); break; } } } } while (0)

struct XcdBarrier {
    unsigned* bar; unsigned x;
    volatile LAS unsigned* st;
};

__device__ __forceinline__ XcdBarrier xcd_barrier_post(unsigned* bar, volatile LAS unsigned* st, bool leader  ) {
    XcdBarrier b; b.bar = bar; b.x = xb_xcc_id(); b.st = st;
    if (leader) (void)xb_add(&bar[XB_XCNT(b.x)], 1u);
    return b;
}
__device__ __forceinline__ void xcd_barrier_complete(unsigned* bar, unsigned x, unsigned& nloc, unsigned& nx) {
    const unsigned G = gridDim.x * gridDim.y * gridDim.z;
    unsigned sum, cnt, mine, sp = 0u;
    for (;;) {
        sum = 0u; cnt = 0u; mine = 0u;
#pragma unroll
        for (unsigned j = 0; j < 16; ++j) { const unsigned c = xb_ld(&bar[XB_XCNT(j)]); sum += c; cnt += (c > 0u) ? 1u : 0u; mine = (j == x) ? c : mine; }
        if (sum == G) break;
        __builtin_amdgcn_s_sleep(1);
        if ((++sp & 255u) == 0u) { if (xb_ld(&bar[XB_TMO])) break; if (sp > XB_SPIN_CAP) { atomicAdd(&bar[XB_TMO], 1u); break; } }
    }
    nloc = mine > 0u ? mine : 1u; nx = cnt > 0u ? cnt : 1u;
}

__device__ __forceinline__ void xcd_barrier(const XcdBarrier& b, bool leader  ) {
    asm volatile("s_waitcnt vmcnt(0)" ::: "memory");
    __syncthreads();
    if (leader) {
        unsigned* bar = b.bar;
        __builtin_amdgcn_s_waitcnt(0);
        unsigned nloc = b.st[0], nx = b.st[1];
        if (nloc == 0u) { xcd_barrier_complete(bar, b.x, nloc, nx); b.st[0] = nloc; b.st[1] = nx; }
        const unsigned old = xb_add(&bar[XB_XSUB(b.x)], 1u);
        const unsigned gen = old / nloc;
        if (old + 1u == (gen + 1u) * nloc) {
            __builtin_amdgcn_fence(__ATOMIC_RELEASE, "agent");
            asm volatile("s_waitcnt vmcnt(0)" ::: "memory");
            const unsigned og = xb_add(&bar[XB_TOP], 1u);
            const unsigned tg = og / nx;
            if (og + 1u == (tg + 1u) * nx) xb_add(&bar[XB_TOPGEN], 1u);
            else XB_SPIN(xb_ld(&bar[XB_TOPGEN]) == tg, bar);
            __builtin_amdgcn_fence(__ATOMIC_ACQUIRE, "agent");
            xb_add(&bar[XB_XGEN(b.x)], 1u);
            asm volatile("s_waitcnt vmcnt(0)" ::: "memory");
        } else {
            XB_SPIN(xb_ld(&bar[XB_XGEN(b.x)]) == gen, bar);
            __builtin_amdgcn_fence(__ATOMIC_ACQUIRE, "agent");
            asm volatile("s_waitcnt vmcnt(0)" ::: "memory");
        }
    }
    __syncthreads();
}

constexpr int NWAVES = 8;
constexpr int BATCH = 8, SEQ = 4096, DM = 1024, FF = 2816, T = BATCH * SEQ;
constexpr float EPS = 1e-6f;
constexpr float LOG2E = 1.4426950408889634f;
constexpr float QSCALE = 0.125f * LOG2E;
constexpr float NEGL = -1.0e9f * LOG2E;
constexpr int NMAIN = 1792;
constexpr int NPLAIN = 2304;

constexpr size_t MiB = 1u << 20, KiB = 1u << 10;
constexpr size_t WS_CTL = 0, CTL_ZERO_BYTES = 64 * KiB;
constexpr size_t WS_WIN1 = 2 * MiB, WS_WOUT1 = 13 * MiB, WS_WIN2 = 19 * MiB, WS_WOUT2 = 30 * MiB, WS_WMAIN = 36 * MiB, WS_WVT = 41 * MiB, WS_WMO = 42 * MiB;
constexpr size_t WS_W1T = 44 * MiB, WS_W2T = 45 * MiB, WS_POSB = 45 * MiB + 64 * KiB, WS_RSTD = 45 * MiB + 128 * KiB, WS_SSQ1 = 46 * MiB, WS_SSQ2 = 48 * MiB, WS_GT = 50 * MiB  , WS_KC = 54 * MiB, WS_VCT = 54 * MiB + 512 * KiB;
constexpr size_t WS_A = 56 * MiB;
constexpr size_t WS_ACT = 120 * MiB;
constexpr size_t WS_QA = 120 * MiB, WS_QB = 152 * MiB, WS_KA = 184 * MiB, WS_KCR = 192 * MiB, WS_VCR = 200 * MiB, WS_KS = 208 * MiB, WS_KW = 216 * MiB, WS_VAT = 224 * MiB, WS_VST = 232 * MiB, WS_VWT = 240 * MiB;
constexpr size_t WS_MIX = 296 * MiB;
constexpr size_t WS_PROJ = 360 * MiB;
constexpr size_t WS_END = 504 * MiB;
constexpr int CW_BAR = 4096;

constexpr int RING_OFF = 0, RING_BYTES = 131072;
constexpr int LDSCTL_OFF = RING_BYTES, MISC_OFF = LDSCTL_OFF + 320;
constexpr int LDS_BYTES = 147456;

typedef unsigned short bf16;
__device__ __forceinline__ float bf2f(bf16 v) { return __uint_as_float(((unsigned)v) << 16); }
__device__ __forceinline__ float wave_sum(float v) {
#pragma unroll
    for (int o = 1; o < 64; o <<= 1) v += __shfl_xor(v, o);
    return v;
}
__device__ __forceinline__ float wave_max(float v) {
#pragma unroll
    for (int o = 1; o < 64; o <<= 1) v = fmaxf(v, __shfl_xor(v, o));
    return v;
}
__device__ __forceinline__ int t5_bucket(int n) {
    if (n < 16) return n < 0 ? 0 : n;
    const int b = 16 + (int)(__log2f((float)n * 0.0625f) * (16.0f / 3.0f));
    return b > 31 ? 31 : b;
}
struct Frame {
    LAS unsigned char* lds; volatile LAS unsigned* MISC; gu32* ctl;
    int tid, lane, wave, vcu, G;
};

__global__ void __launch_bounds__(256) nv_rmsnorm(const float* x, const float* g, bf16* out) {
    const int lane = threadIdx.x & 63, row = blockIdx.x * 4 + (threadIdx.x >> 6);
    const f32x4* xr = (const f32x4*)(x + (size_t)row * DM) + lane; const f32x4* gr = (const f32x4*)g + lane;
    f32x4 v[4]; float s = 0.f;
#pragma unroll
    for (int j = 0; j < 4; ++j) { v[j] = xr[64 * j]; s += (v[j].x * v[j].x + v[j].y * v[j].y) + (v[j].z * v[j].z + v[j].w * v[j].w); }
    const float rstd = 1.0f / sqrtf(wave_sum(s) * (1.f / DM) + EPS);
    unsigned long long* o8 = (unsigned long long*)(out + (size_t)row * DM) + lane;
#pragma unroll
    for (int j = 0; j < 4; ++j) { const f32x4 gg = gr[64 * j]; o8[64 * j] = (unsigned long long)pk2(v[j].x * rstd * gg.x, v[j].y * rstd * gg.y) | ((unsigned long long)pk2(v[j].z * rstd * gg.z, v[j].w * rstd * gg.w) << 32); }
}

struct HeadPrep {
    const bf16* proj; const float* ssq;
    const float *qna, *kna, *qnb, *knb;
    bf16 *QA, *QB, *KA, *VAT, *KCR, *VCR, *KS, *VST, *KW, *VWT; float* GT;
};
__global__ void __launch_bounds__(256) nv_headprep(HeadPrep p) {
    const int lane = threadIdx.x & 63, t = blockIdx.x * 4 + (threadIdx.x >> 6), b = t / SEQ, s = t % SEQ;
    float rs = 1.0f;
    if (p.ssq) { float q = p.ssq[(size_t)t * 16 + (lane & 15)]; q += __shfl_xor(q, 1); q += __shfl_xor(q, 2); q += __shfl_xor(q, 4); q += __shfl_xor(q, 8); rs = 1.0f / sqrtf(q * (1.f / DM) + EPS); }
    const bf16* pr = p.proj + (size_t)t * NPLAIN;
    for (int H = 0; H < 32; ++H) {
        const float v = bf2f(pr[H * 64 + lane]) * rs;
        const float* gain = nullptr; float sc = 1.0f; bf16* dst; bool tr = false; int hh, nh;
        if (H < 8) { gain = p.qna; sc = QSCALE; dst = p.QA; hh = H; nh = 8; }
        else if (H < 10) { gain = p.kna; dst = p.KA; hh = H - 8; nh = 2; }
        else if (H < 12) { dst = p.VAT; hh = H - 10; nh = 2; tr = true; }
        else if (H < 20) { gain = p.qnb; sc = QSCALE; dst = p.QB; hh = H - 12; nh = 8; }
        else { const int slot = (H - 20) >> 1; hh = (H - 20) & 1; nh = 2;
            if (slot == 0) dst = p.KCR; else if (slot == 1) dst = p.VCR; else if (slot == 2) { dst = p.KS; gain = p.knb; } else if (slot == 3) { dst = p.VST; tr = true; } else if (slot == 4) { dst = p.KW; gain = p.knb; } else { dst = p.VWT; tr = true; } }
        float y = v;
        if (gain) { const float ss = wave_sum(v * v); y = v * (1.0f / sqrtf(ss * (1.f / 64.f) + EPS)) * gain[lane] * sc; }
        if (!tr) dst[((size_t)(b * nh + hh) * SEQ + s) * 64 + lane] = (bf16)f2bf(y);
        else dst[(((size_t)(b * nh + hh) * (SEQ / 32) + (s >> 5)) * 64 + lane) * 32 + (s & 31)] = (bf16)f2bf(y);
    }
    if (lane < 24) { const float v = bf2f(pr[2048 + lane]) * rs; p.GT[(size_t)t * 32 + lane] = 1.0f / (1.0f + __expf(-v)); }
}

__global__ void __launch_bounds__(128) nv_compress(const bf16* KCR, const bf16* VCR, const float* pos, const float* w1, const float* b1, const float* w2, const float* b2, const float* knb, bf16* KC, bf16* VCT) {
    __shared__ float sh[128];
    const int tid = threadIdx.x; int idx = blockIdx.x; const int c = idx & 255; idx >>= 8; const int g = idx & 1, b = (idx >> 1) & 7, kv = idx >> 4;
    if (c == 255) { if (tid < 64) { if (kv == 0) KC[((size_t)(b * 2 + g) * 256 + c) * 64 + tid] = 0; else VCT[(((size_t)(b * 2 + g) * 8 + (c >> 5)) * 64 + tid) * 32 + (c & 31)] = 0; } return; }
    const bf16* raw = (kv == 0 ? KCR : VCR) + ((size_t)(b * 2 + g) * SEQ + 16 * c) * 64;
    float acc = b1[kv * 128 + tid];
    for (int k = 0; k < 2048; ++k) acc += (bf2f(raw[k]) + pos[kv * 2048 + k]) * w1[((size_t)kv * 2048 + k) * 128 + tid];
    sh[tid] = acc / (1.0f + __expf(-acc));
    __syncthreads();
    if (tid < 64) {
        float o = b2[kv * 64 + tid];
        for (int h = 0; h < 128; ++h) o += sh[h] * w2[((size_t)kv * 128 + h) * 64 + tid];
        if (kv == 0) { const float ss = wave_sum(o * o); const float y = o * (1.0f / sqrtf(ss * (1.f / 64.f) + EPS)) * knb[tid]; KC[((size_t)(b * 2 + g) * 256 + c) * 64 + tid] = (bf16)f2bf(y); }
        else VCT[(((size_t)(b * 2 + g) * 8 + (c >> 5)) * 64 + tid) * 32 + (c & 31)] = (bf16)f2bf(o);
    }
}

__device__ __forceinline__ float vt_at(const bf16* VT, int bg, int nblk, int key, int d) { return bf2f(VT[(((size_t)bg * nblk + (key >> 5)) * 64 + d) * 32 + (key & 31)]); }

__global__ void __launch_bounds__(256) nv_band_a(const bf16* QA, const bf16* KA, const bf16* VAT, const float* tbl, const float* sinks, bf16* mix) {
    __shared__ float sq[4][64], sl[4][128];
    const int lane = threadIdx.x & 63, w = threadIdx.x >> 6; const int s = blockIdx.x % SEQ, bg = blockIdx.x / SEQ, g = bg & 1, b = bg >> 1, head = g * 4 + w;
    sq[w][lane] = bf2f(QA[((size_t)(b * 8 + head) * SEQ + s) * 64 + lane]);
    __syncthreads();
    float lg[2];
#pragma unroll
    for (int j = 0; j < 2; ++j) { const int rel = 64 * j + lane, key = s - rel; float v = NEGL;
        if (key >= 0) { const bf16* kr = KA + ((size_t)bg * SEQ + key) * 64; float dot = 0.f; for (int d = 0; d < 64; ++d) dot += sq[w][d] * bf2f(kr[d]); v = dot + tbl[t5_bucket(rel) * 16 + head] * LOG2E; }
        lg[j] = v; }
    const float sk = sinks[head] * LOG2E;
    const float m = fmaxf(wave_max(fmaxf(lg[0], lg[1])), sk);
    const float p0 = exp2f(lg[0] - m), p1 = exp2f(lg[1] - m);
    const float sum = wave_sum(p0 + p1) + exp2f(sk - m);
    sl[w][lane] = p0; sl[w][64 + lane] = p1;
    __syncthreads();
    float o = 0.f;
    for (int rel = 0; rel < 128; ++rel) { const int key = s - rel; if (key >= 0) o += sl[w][rel] * vt_at(VAT, bg, SEQ / 32, key, lane); }
    mix[(size_t)(b * SEQ + s) * 1024 + head * 64 + lane] = (bf16)f2bf(o / sum);
}

__global__ void __launch_bounds__(256) nv_nsa(const bf16* QB, const bf16* KC, const bf16* VCT, const bf16* KS, const bf16* VST, const bf16* KW, const bf16* VWT, const float* GT, const float* tbl, bf16* mix) {
    __shared__ float sq[4][64], sP[4][256], sL[4][1024]; __shared__ unsigned long long smask;
    const int lane = threadIdx.x & 63, w = threadIdx.x >> 6; const int s = blockIdx.x % SEQ, bg = blockIdx.x / SEQ, g = bg & 1, b = bg >> 1, head = g * 4 + w, tc = 8 + head;
    const int t = b * SEQ + s;
    sq[w][lane] = bf2f(QB[((size_t)(b * 8 + head) * SEQ + s) * 64 + lane]);
    __syncthreads();
    const int ncv = s >= 31 ? ((s - 31) / 16 + 1 > 255 ? 255 : (s - 31) / 16 + 1) : 0;
    float lc[4];
#pragma unroll
    for (int j = 0; j < 4; ++j) { const int c = lane + 64 * j; float v = NEGL;
        if (c < ncv) { const bf16* kr = KC + ((size_t)bg * 256 + c) * 64; float dot = 0.f; for (int d = 0; d < 64; ++d) dot += sq[w][d] * bf2f(kr[d]); v = dot + tbl[t5_bucket(s - (16 * c + 31)) * 16 + tc] * LOG2E; }
        lc[j] = v; }
    {
        const float m = wave_max(fmaxf(fmaxf(lc[0], lc[1]), fmaxf(lc[2], lc[3])));
        float p[4]; float ps = 0.f;
#pragma unroll
        for (int j = 0; j < 4; ++j) { p[j] = (lane + 64 * j < ncv) ? exp2f(lc[j] - m) : 0.f; ps += p[j]; }
        const float inv = 1.0f / fmaxf(wave_sum(ps), 1.1754944e-38f);
#pragma unroll
        for (int j = 0; j < 4; ++j) sP[w][lane + 64 * j] = p[j] * inv;
    }
    __syncthreads();
    float o_cmp = 0.f;
    for (int c = 0; c < ncv; ++c) o_cmp += sP[w][c] * vt_at(VCT, bg, 8, c, lane);
    if (w == 0) {
        const int n = lane, cur = s >> 6; float imp = 0.f;
        for (int c = 4 * n - 1; c <= 4 * n + 3; ++c) if (c >= 0 && c < 255) imp += (sP[0][c] + sP[1][c]) + (sP[2][c] + sP[3][c]);
        const bool valid = n <= cur, forced = (n == 0) || (n == cur) || (n == cur - 1);
        const float score = valid ? imp + (forced ? 1000.0f : 0.0f) : -1.0e9f;
        int rank = 0;
        for (int mm = 0; mm < 64; ++mm) { const float sm = __shfl(score, mm); rank += (sm > score || (sm == score && mm < n)) ? 1 : 0; }
        const unsigned long long mk = __ballot(valid && rank < 16);
        if (lane == 0) smask = mk;
    }
    __syncthreads();
    const unsigned long long mask = smask;
    float o_sel = 0.f;
    {
        int cnt = 0; float mx = NEGL;
        for (int n = 0; n < 64; ++n) if ((mask >> n) & 1ull) { const int key = 64 * n + lane, rel = s - key; float v = NEGL;
            if (rel >= 0) { const bf16* kr = KS + ((size_t)bg * SEQ + key) * 64; float dot = 0.f; for (int d = 0; d < 64; ++d) dot += sq[w][d] * bf2f(kr[d]); v = dot + tbl[t5_bucket(rel) * 16 + tc] * LOG2E; }
            sL[w][cnt * 64 + lane] = v; mx = fmaxf(mx, v); ++cnt; }
        mx = wave_max(mx); float ps = 0.f;
        for (int i = 0; i < cnt; ++i) { const float p = exp2f(sL[w][i * 64 + lane] - mx); sL[w][i * 64 + lane] = p; ps += p; }
        ps = wave_sum(ps);
        __syncthreads();
        int i = 0;
        for (int n = 0; n < 64; ++n) if ((mask >> n) & 1ull) { for (int k = 0; k < 64; ++k) { const int key = 64 * n + k; if (key <= s) o_sel += sL[w][i * 64 + k] * vt_at(VST, bg, SEQ / 32, key, lane); } ++i; }
        o_sel /= ps;
        __syncthreads();
    }
    float o_win = 0.f;
    {
        float mx = NEGL;
        for (int j = 0; j < 8; ++j) { const int rel = 64 * j + lane, key = s - rel; float v = NEGL;
            if (key >= 0) { const bf16* kr = KW + ((size_t)bg * SEQ + key) * 64; float dot = 0.f; for (int d = 0; d < 64; ++d) dot += sq[w][d] * bf2f(kr[d]); v = dot + tbl[t5_bucket(rel) * 16 + tc] * LOG2E; }
            sL[w][rel] = v; mx = fmaxf(mx, v); }
        mx = wave_max(mx); float ps = 0.f;
        for (int j = 0; j < 8; ++j) { const float p = exp2f(sL[w][64 * j + lane] - mx); sL[w][64 * j + lane] = p; ps += p; }
        ps = wave_sum(ps);
        __syncthreads();
        for (int rel = 0; rel < 512; ++rel) { const int key = s - rel; if (key >= 0) o_win += sL[w][rel] * vt_at(VWT, bg, SEQ / 32, key, lane); }
        o_win /= ps;
    }
    const float g0 = GT[(size_t)t * 32 + 0 * 8 + head], g1 = GT[(size_t)t * 32 + 1 * 8 + head], g2 = GT[(size_t)t * 32 + 2 * 8 + head];
    mix[(size_t)t * 1024 + 512 + head * 64 + lane] = (bf16)f2bf(g0 * o_cmp + g1 * o_sel + g2 * o_win);
}

typedef float f32x16 __attribute__((ext_vector_type(16)));
typedef short s16x4 __attribute__((ext_vector_type(4)));
typedef unsigned u32x4v __attribute__((ext_vector_type(4)));
typedef unsigned u32x2v __attribute__((ext_vector_type(2)));
constexpr int LA = 296, OFFA = 231;
constexpr int LB = 680, OFFB = 615;
constexpr int ATT_LUTA_OFF = 0, ATT_LUTB_OFF = 8 * LA * 4, ATT_WSCR_OFF = ATT_LUTB_OFF + 8 * LB * 4, ATT_WSCR_BYTES = 4096;
static_assert(ATT_WSCR_OFF % 16 == 0 && ATT_WSCR_OFF + 8 * ATT_WSCR_BYTES <= RING_BYTES, "attention LDS map");

struct AttP { const bf16 *QA, *QB, *KA, *VAT, *KC, *VCT, *KS, *VST, *KW, *VWT; const float* GT; bf16* mix; };

__device__ __forceinline__ float xhalf_max(float v) { auto rr = __builtin_amdgcn_permlane32_swap(__float_as_uint(v), __float_as_uint(v), false, false); return fmaxf(__uint_as_float(rr[0]), __uint_as_float(rr[1])); }
__device__ __forceinline__ float xhalf_sum(float v) { auto rr = __builtin_amdgcn_permlane32_swap(__float_as_uint(v), __float_as_uint(v), false, false); return __uint_as_float(rr[0]) + __uint_as_float(rr[1]); }
__device__ __forceinline__ float quad_sum(float v) {
    v += __int_as_float(__builtin_amdgcn_mov_dpp(__float_as_int(v), 0xB1, 0xF, 0xF, true));
    v += __int_as_float(__builtin_amdgcn_mov_dpp(__float_as_int(v), 0x4E, 0xF, 0xF, true));
    return v;
}
__device__ __forceinline__ unsigned pkbf(float lo, float hi) { typedef float f2 __attribute__((ext_vector_type(2))); typedef __bf16 b2 __attribute__((ext_vector_type(2))); f2 v = {lo, hi}; b2 b = __builtin_convertvector(v, b2); return __builtin_bit_cast(unsigned, b); }

struct KFrag { bf16x8 k[4]; };
struct VFrag { bf16x8 v[2][2]; };
__device__ __forceinline__ f32x16 qk_tile(const KFrag& kf, const bf16x8 (&qf)[4], f32x16 c) {
#pragma unroll
    for (int s4 = 0; s4 < 4; ++s4) c = __builtin_amdgcn_mfma_f32_32x32x16_bf16(kf.k[s4], qf[s4], c, 0, 0, 0);
    return c;
}
#define ROFF(r) (((r) & 3) + 8 * ((r) >> 2))
__device__ __forceinline__ void store_o(bf16* rowp, const f32x16& r0, const f32x16& r1, int half) {
#pragma unroll
    for (int i = 0; i < 4; ++i) {
        u32x2v w; w.x = pkbf(r0[4 * i], r0[4 * i + 1]); w.y = pkbf(r0[4 * i + 2], r0[4 * i + 3]); *(u32x2v*)(rowp + 8 * i + 4 * half) = w;
        u32x2v z; z.x = pkbf(r1[4 * i], r1[4 * i + 1]); z.y = pkbf(r1[4 * i + 2], r1[4 * i + 3]); *(u32x2v*)(rowp + 32 + 8 * i + 4 * half) = z; }
}

__device__ __forceinline__ void store_o_rows(LAS unsigned char* scr, bf16* base  , const f32x16& r0, const f32x16& r1, int lane) {
    const int col = lane & 31, half = lane >> 5, ql = col >> 2, hd = col & 3, sx = (ql + 4 * (hd >> 1)) & 7;
    LAS unsigned char* wp = scr + ql * 512 + hd * 128 + half * 8;
#pragma unroll
    for (int i = 0; i < 4; ++i) {
        u32x2v w; w.x = pkbf(r0[4 * i], r0[4 * i + 1]); w.y = pkbf(r0[4 * i + 2], r0[4 * i + 3]); *(LAS u32x2v*)(wp + ((i ^ sx) << 4)) = w;
        u32x2v z; z.x = pkbf(r1[4 * i], r1[4 * i + 1]); z.y = pkbf(r1[4 * i + 2], r1[4 * i + 3]); *(LAS u32x2v*)(wp + (((4 + i) ^ sx) << 4)) = z; }
    const int c = lane & 31;
#pragma unroll
    for (int j = 0; j < 4; ++j) { const int row = 2 * j + (lane >> 5), pc = (c & 24) | ((c & 7) ^ ((row + 4 * (c >> 4)) & 7));
        const u32x4v v = *(const LAS u32x4v*)(scr + row * 512 + pc * 16);
        *(u32x4v*)(base + (size_t)row * 1024 + c * 8) = v; }
}

__device__ __forceinline__ void cmp_unit(Frame& F, int u, const bf16* KCR, const bf16* VCR, const bf16* W1T, const bf16* W2T, const float* posb, const float* b2, const float* knb, bf16* KC, bf16* VCT) {
    const int kv = u >> 7, bg = (u >> 3) & 15, strip = u & 7, lane = F.lane, w = F.wave, col = lane & 31, half = lane >> 5;
    const bf16* raw = (kv ? VCR : KCR) + ((size_t)bg * SEQ + 16 * (32 * strip + col)) * 64;
    const bf16* w1 = W1T + (size_t)kv * 128 * 2048;
    f32x16 acc[4];
#pragma unroll
    for (int nt = 0; nt < 4; ++nt)
#pragma unroll
        for (int r = 0; r < 16; ++r) acc[nt][r] = 0.f;
    const int kb = 256 * w;
#pragma unroll 8
    for (int s = 0; s < 16; ++s) { const int k = kb + 16 * s + 8 * half;
        const bf16x8 a = *(const bf16x8*)(raw + k);
#pragma unroll
        for (int nt = 0; nt < 4; ++nt) { const bf16x8 bb = *(const bf16x8*)(w1 + ((size_t)((16 * w + s) * 4 + nt) * 64 + lane) * 8); acc[nt] = __builtin_amdgcn_mfma_f32_32x32x16_bf16(a, bb, acc[nt], 0, 0, 0); } }
    LAS float* part = (LAS float*)(F.lds + RING_OFF);
#pragma unroll
    for (int nt = 0; nt < 4; ++nt)
#pragma unroll
        for (int r = 0; r < 16; ++r) part[w * 4096 + (ROFF(r) + 4 * half) * 128 + 32 * nt + col] = acc[nt][r];
    __syncthreads();
    float hv[8];
#pragma unroll
    for (int j = 0; j < 8; ++j) { const int e = F.tid + 512 * j; float sacc = posb[kv * 128 + (e & 127)];
#pragma unroll
        for (int ww = 0; ww < 8; ++ww) sacc += part[ww * 4096 + e];
        hv[j] = sacc * __builtin_amdgcn_rcpf(1.0f + __builtin_amdgcn_exp2f(-sacc * LOG2E)); }
    __syncthreads();
    LAS bf16* hid = (LAS bf16*)(F.lds + RING_OFF);
#pragma unroll
    for (int j = 0; j < 8; ++j) hid[F.tid + 512 * j] = (bf16)f2bf(hv[j]);
    __syncthreads();
    if (w == 0) {
        f32x16 o[2];
#pragma unroll
        for (int nt = 0; nt < 2; ++nt)
#pragma unroll
            for (int r = 0; r < 16; ++r) o[nt][r] = 0.f;
        const bf16* w2 = W2T + (size_t)kv * 64 * 128;
#pragma unroll
        for (int s = 0; s < 8; ++s) { const bf16x8 a = *(const LAS bf16x8*)(hid + col * 128 + 16 * s + 8 * half);
#pragma unroll
            for (int nt = 0; nt < 2; ++nt) { const bf16x8 bb = *(const bf16x8*)(w2 + (32 * nt + col) * 128 + 16 * s + 8 * half); o[nt] = __builtin_amdgcn_mfma_f32_32x32x16_bf16(a, bb, o[nt], 0, 0, 0); } }
        const float bi0 = b2[kv * 64 + col], bi1 = b2[kv * 64 + 32 + col];
        if (kv == 0) {
            const float k0 = knb[col], k1 = knb[32 + col];
#pragma unroll
            for (int r = 0; r < 16; ++r) { const float v0 = o[0][r] + bi0, v1 = o[1][r] + bi1; float ss = v0 * v0 + v1 * v1;
                ss += __shfl_xor(ss, 1); ss += __shfl_xor(ss, 2); ss += __shfl_xor(ss, 4); ss += __shfl_xor(ss, 8); ss += __shfl_xor(ss, 16);
                const float f = __builtin_amdgcn_rsqf(ss * (1.0f / 64.0f) + EPS); const int c = 32 * strip + ROFF(r) + 4 * half; const bool z = (c == 255);
                bf16* kp = KC + ((size_t)bg * 256 + c) * 64;
                kp[col] = z ? (bf16)0 : (bf16)f2bf(v0 * f * k0); kp[32 + col] = z ? (bf16)0 : (bf16)f2bf(v1 * f * k1); }
        } else {
#pragma unroll
            for (int nt = 0; nt < 2; ++nt) { const float bi = nt ? bi1 : bi0;
#pragma unroll
                for (int i = 0; i < 4; ++i) { const int cl = 8 * i + 4 * half; const bool zl = (32 * strip + cl + 3 == 255);
                    u32x2v wv; wv.x = pkbf(o[nt][4 * i] + bi, o[nt][4 * i + 1] + bi); wv.y = pkbf(o[nt][4 * i + 2] + bi, zl ? 0.f : o[nt][4 * i + 3] + bi);
                    *(u32x2v*)(VCT + (((size_t)bg * 8 + strip) * 64 + 32 * nt + col) * 32 + cl) = wv; } }
        }
    }
    __syncthreads();
}

__device__ __forceinline__ void cmp_unit2(Frame& F, int u, const bf16* KCR, const bf16* VCR, const bf16* W1T, const bf16* W2T, const float* posb, const float* b2, const float* knb, bf16* KC, bf16* VCT) {
    const int kv = u >> 7, bg = (u >> 3) & 15, strip0 = u & 7, lane = F.lane, w = F.wave, col = lane & 31, half = lane >> 5;
    const bf16* raw = (kv ? VCR : KCR) + ((size_t)bg * SEQ + 16 * (32 * strip0 + col)) * 64;
    const bf16* w1 = W1T + (size_t)kv * 128 * 2048;
    f32x16 acc2[2][4];
#pragma unroll
    for (int hh = 0; hh < 2; ++hh)
#pragma unroll
    for (int nt = 0; nt < 4; ++nt)
#pragma unroll
        for (int r = 0; r < 16; ++r) acc2[hh][nt][r] = 0.f;
    const int kb = 256 * w;
#pragma unroll 4
    for (int s = 0; s < 16; ++s) { const int k = kb + 16 * s + 8 * half;
        const bf16x8 a0 = *(const bf16x8*)(raw + k), a1 = *(const bf16x8*)(raw + 32 * 16 * 64 + k);
#pragma unroll
        for (int nt = 0; nt < 4; ++nt) { const bf16x8 bb = *(const bf16x8*)(w1 + ((size_t)((16 * w + s) * 4 + nt) * 64 + lane) * 8);
            acc2[0][nt] = __builtin_amdgcn_mfma_f32_32x32x16_bf16(a0, bb, acc2[0][nt], 0, 0, 0); acc2[1][nt] = __builtin_amdgcn_mfma_f32_32x32x16_bf16(a1, bb, acc2[1][nt], 0, 0, 0); } }
#pragma unroll
    for (int hh = 0; hh < 2; ++hh) { const int strip = strip0 + hh; f32x16 (&acc)[4] = acc2[hh];
    LAS float* part = (LAS float*)(F.lds + RING_OFF);
#pragma unroll
    for (int nt = 0; nt < 4; ++nt)
#pragma unroll
        for (int r = 0; r < 16; ++r) part[w * 4096 + (ROFF(r) + 4 * half) * 128 + 32 * nt + col] = acc[nt][r];
    __syncthreads();
    float hv[8];
#pragma unroll
    for (int j = 0; j < 8; ++j) { const int e = F.tid + 512 * j; float sacc = posb[kv * 128 + (e & 127)];
#pragma unroll
        for (int ww = 0; ww < 8; ++ww) sacc += part[ww * 4096 + e];
        hv[j] = sacc * __builtin_amdgcn_rcpf(1.0f + __builtin_amdgcn_exp2f(-sacc * LOG2E)); }
    __syncthreads();
    LAS bf16* hid = (LAS bf16*)(F.lds + RING_OFF);
#pragma unroll
    for (int j = 0; j < 8; ++j) hid[F.tid + 512 * j] = (bf16)f2bf(hv[j]);
    __syncthreads();
    if (w == 0) {
        f32x16 o[2];
#pragma unroll
        for (int nt = 0; nt < 2; ++nt)
#pragma unroll
            for (int r = 0; r < 16; ++r) o[nt][r] = 0.f;
        const bf16* w2 = W2T + (size_t)kv * 64 * 128;
#pragma unroll
        for (int s = 0; s < 8; ++s) { const bf16x8 a = *(const LAS bf16x8*)(hid + col * 128 + 16 * s + 8 * half);
#pragma unroll
            for (int nt = 0; nt < 2; ++nt) { const bf16x8 bb = *(const bf16x8*)(w2 + (32 * nt + col) * 128 + 16 * s + 8 * half); o[nt] = __builtin_amdgcn_mfma_f32_32x32x16_bf16(a, bb, o[nt], 0, 0, 0); } }
        const float bi0 = b2[kv * 64 + col], bi1 = b2[kv * 64 + 32 + col];
        if (kv == 0) {
            const float k0 = knb[col], k1 = knb[32 + col];
#pragma unroll
            for (int r = 0; r < 16; ++r) { const float v0 = o[0][r] + bi0, v1 = o[1][r] + bi1; float ss = v0 * v0 + v1 * v1;
                ss += __shfl_xor(ss, 1); ss += __shfl_xor(ss, 2); ss += __shfl_xor(ss, 4); ss += __shfl_xor(ss, 8); ss += __shfl_xor(ss, 16);
                const float f = __builtin_amdgcn_rsqf(ss * (1.0f / 64.0f) + EPS); const int c = 32 * strip + ROFF(r) + 4 * half; const bool z = (c == 255);
                bf16* kp = KC + ((size_t)bg * 256 + c) * 64;
                kp[col] = z ? (bf16)0 : (bf16)f2bf(v0 * f * k0); kp[32 + col] = z ? (bf16)0 : (bf16)f2bf(v1 * f * k1); }
        } else {
#pragma unroll
            for (int nt = 0; nt < 2; ++nt) { const float bi = nt ? bi1 : bi0;
#pragma unroll
                for (int i = 0; i < 4; ++i) { const int cl = 8 * i + 4 * half; const bool zl = (32 * strip + cl + 3 == 255);
                    u32x2v wv; wv.x = pkbf(o[nt][4 * i] + bi, o[nt][4 * i + 1] + bi); wv.y = pkbf(o[nt][4 * i + 2] + bi, zl ? 0.f : o[nt][4 * i + 3] + bi);
                    *(u32x2v*)(VCT + (((size_t)bg * 8 + strip) * 64 + 32 * nt + col) * 32 + cl) = wv; } }
        }
    }
    __syncthreads();
    }
}

constexpr int ATT2_KV_OFF = 65536;
static_assert(ATT_WSCR_OFF + 8 * ATT_WSCR_BYTES <= ATT2_KV_OFF && ATT2_KV_OFF + 65536 <= RING_BYTES, "attention-2 LDS map");
constexpr float ATT_THR = 6.0f;

__device__ __forceinline__ unsigned stage_goff(int tid) {
    const int t = tid & 255, key = 8 * (t >> 6) + ((t & 15) >> 1), c = 2 * ((t >> 4) & 3) + (t & 1);
    return __builtin_amdgcn_readfirstlane(tid) < 256 ? (unsigned)(key * 128 + c * 16) : (unsigned)t * 16u;
}
__device__ __forceinline__ u32x4v tile_load(const bf16* Kt, const bf16* Vt, int tid) {
    const bool isk = __builtin_amdgcn_readfirstlane(tid) < 256;
    const char* sbase = (const char*)(isk ? Kt : Vt);
    return *(const u32x4v*)(sbase + stage_goff(tid));
}
__device__ __forceinline__ u32x2v stage_loff(int tid) {
    const int t = tid & 255; u32x2v o;
    if (__builtin_amdgcn_readfirstlane(tid) < 256) { const int key = 8 * (t >> 6) + ((t & 15) >> 1), c = 2 * ((t >> 4) & 3) + (t & 1);
        o.x = (unsigned)((c >> 1) * 1024 + key * 32 + (((c & 1) ^ ((key >> 3) & 1)) << 4)); o.y = o.x + 8u; }
    else { const int row = t >> 2, p = t & 3, rb = (row >> 3) & 1; const unsigned base = (unsigned)(4096 + (p >> 1) * 2048 + row * 32 + 8 * (p & 1));
        o.x = base + (unsigned)(rb << 4); o.y = base + (unsigned)((rb ^ 1) << 4); }
    return o;
}
__device__ __forceinline__ void tile_store(LAS unsigned char* buf, u32x4v v, u32x2v so) {
    u32x2v a; a.x = v.x; a.y = v.y; u32x2v b; b.x = v.z; b.y = v.w;
    *(LAS u32x2v*)(buf + so.x) = a; *(LAS u32x2v*)(buf + so.y) = b;
}
__device__ __forceinline__ __amdgpu_buffer_rsrc_t stage_rsrc(const bf16* Kb, const bf16* Vb, int tid) {
    const bool isk = __builtin_amdgcn_readfirstlane(tid) < 256;
    return __builtin_amdgcn_make_buffer_rsrc((void*)(isk ? Kb : Vb), 0, 0x7FFFFFFF, 0x00020000);
}
__device__ __forceinline__ void pair_load(__amdgpu_buffer_rsrc_t rs, int kt, unsigned loff, u32x4v& a, u32x4v& b) {
    a = __builtin_amdgcn_raw_buffer_load_b128(rs, loff, kt * 4096, 0); b = __builtin_amdgcn_raw_buffer_load_b128(rs, loff, kt * 4096 + 4096, 0);
}
__device__ __forceinline__ void pair_store(LAS unsigned char* buf, const u32x4v& a, const u32x4v& b, u32x2v so) { tile_store(buf, a, so); tile_store(buf + 8192, b, so); }
__device__ __forceinline__ int frag_off(int r, int half) { return r * 32 + ((half ^ ((r >> 3) & 1)) << 4); }
__device__ __forceinline__ void lds_k(KFrag& f, const LAS unsigned char* buf, int r, int half) {
    const LAS unsigned char* p = buf + frag_off(r, half);
#pragma unroll
    for (int s4 = 0; s4 < 4; ++s4) f.k[s4] = *(const LAS bf16x8*)(p + s4 * 1024);
}
__device__ __forceinline__ void lds_v(VFrag& f, const LAS unsigned char* buf, int r, int half) {
    const LAS unsigned char* p = buf + 4096 + frag_off(r, half);
#pragma unroll
    for (int dt = 0; dt < 2; ++dt)
#pragma unroll
        for (int s2 = 0; s2 < 2; ++s2) f.v[dt][s2] = *(const LAS bf16x8*)(p + s2 * 2048 + dt * 1024);
}
typedef float f32x2s __attribute__((ext_vector_type(2)));
struct Soft2 { f32x16 o0, o1, lv; float m; f32x2s lf; };
__device__ __forceinline__ void soft2_init(Soft2& st, float m0, float l0) {
#pragma unroll
    for (int r = 0; r < 16; ++r) { st.o0[r] = 0.f; st.o1[r] = 0.f; st.lv[r] = l0; }
    st.m = m0; st.lf = (f32x2s){0.f, 0.f};
}
__device__ __forceinline__ void soft2_acc(f32x16& r0, f32x16& r1, const Soft2& st, float scale) {
    const float f = scale * __builtin_amdgcn_rcpf(fmaxf(st.lv[0], 1.1754944e-38f));
#pragma unroll
    for (int r = 0; r < 16; ++r) { r0[r] += st.o0[r] * f; r1[r] += st.o1[r] * f; }
}
__device__ __forceinline__ void soft_part(Soft2& st, f32x16 s, float cadd, bf16x8& p0, bf16x8& p1) {
    const float nm = cadd - st.m;
#pragma unroll
    for (int r = 0; r < 16; ++r) s[r] += nm;
    float mx = fmaxf(fmaxf(s[0], s[1]), fmaxf(s[2], s[3]));
#pragma unroll
    for (int r = 4; r < 16; r += 4) mx = fmaxf(mx, fmaxf(fmaxf(s[r], s[r + 1]), fmaxf(s[r + 2], s[r + 3])));
    mx = xhalf_max(mx);
    if (__any(mx > ATT_THR)) {
        const float d = fmaxf(mx, 0.f), alpha = __builtin_amdgcn_exp2f(-d);
        st.m += d;
#pragma unroll
        for (int r = 0; r < 16; ++r) { st.o0[r] *= alpha; st.o1[r] *= alpha; st.lv[r] *= alpha; s[r] -= d; }
    }
#pragma unroll
    for (int r = 0; r < 16; ++r) s[r] = __builtin_amdgcn_exp2f(s[r]);
    u32x4v pw0, pw1;
    pw0.x = pkbf(s[0], s[1]); pw0.y = pkbf(s[2], s[3]); pw0.z = pkbf(s[4], s[5]); pw0.w = pkbf(s[6], s[7]);
    pw1.x = pkbf(s[8], s[9]); pw1.y = pkbf(s[10], s[11]); pw1.z = pkbf(s[12], s[13]); pw1.w = pkbf(s[14], s[15]);
    p0 = __builtin_bit_cast(bf16x8, pw0); p1 = __builtin_bit_cast(bf16x8, pw1);
}
__device__ __forceinline__ f32x16 splat16(float v);
template <bool SUMS = true>
__device__ __forceinline__ void pv_part(Soft2& st, const VFrag& vf, const bf16x8 ones, const bf16x8 p0, const bf16x8 p1) {
    st.o0 = __builtin_amdgcn_mfma_f32_32x32x16_bf16(vf.v[0][0], p0, st.o0, 0, 0, 0);
    st.o1 = __builtin_amdgcn_mfma_f32_32x32x16_bf16(vf.v[1][0], p0, st.o1, 0, 0, 0);
    if (SUMS) st.lv = __builtin_amdgcn_mfma_f32_32x32x16_bf16(ones, p0, st.lv, 0, 0, 0);
    st.o0 = __builtin_amdgcn_mfma_f32_32x32x16_bf16(vf.v[0][1], p1, st.o0, 0, 0, 0);
    st.o1 = __builtin_amdgcn_mfma_f32_32x32x16_bf16(vf.v[1][1], p1, st.o1, 0, 0, 0);
    if (SUMS) st.lv = __builtin_amdgcn_mfma_f32_32x32x16_bf16(ones, p1, st.lv, 0, 0, 0);
}
__device__ __forceinline__ void soft_pv2(Soft2& st, f32x16 s, const VFrag& vf, const bf16x8 ones, float cadd = 0.f) {
    bf16x8 p0, p1; soft_part(st, s, cadd, p0, p1); pv_part(st, vf, ones, p0, p1);
}
template <bool MASKED>
__device__ __forceinline__ void soft_fast_pv(Soft2& st, f32x16 s, const VFrag& vf, const bf16x8 ones, unsigned sel) {
#pragma unroll
    for (int r = 0; r < 16; ++r) s[r] = __builtin_amdgcn_exp2f(s[r]);
    {
        f32x2s a0 = (f32x2s){s[0], s[1]} + (f32x2s){s[2], s[3]}, a1 = (f32x2s){s[4], s[5]} + (f32x2s){s[6], s[7]}, a2 = (f32x2s){s[8], s[9]} + (f32x2s){s[10], s[11]}, a3 = (f32x2s){s[12], s[13]} + (f32x2s){s[14], s[15]};
        a0 += a1; a2 += a3; a0 += a2;
        if (MASKED) { const float bf_ = (sel == 0x07060302u) ? 1.0f : 0.0f; st.lf = a0 * (f32x2s){bf_, bf_} + st.lf; } else st.lf += a0;
    }
    u32x4v pw0, pw1;
    if (MASKED) {
        pw0.x = __builtin_amdgcn_perm(__float_as_uint(s[1]), __float_as_uint(s[0]), sel); pw0.y = __builtin_amdgcn_perm(__float_as_uint(s[3]), __float_as_uint(s[2]), sel);
        pw0.z = __builtin_amdgcn_perm(__float_as_uint(s[5]), __float_as_uint(s[4]), sel); pw0.w = __builtin_amdgcn_perm(__float_as_uint(s[7]), __float_as_uint(s[6]), sel);
        pw1.x = __builtin_amdgcn_perm(__float_as_uint(s[9]), __float_as_uint(s[8]), sel); pw1.y = __builtin_amdgcn_perm(__float_as_uint(s[11]), __float_as_uint(s[10]), sel);
        pw1.z = __builtin_amdgcn_perm(__float_as_uint(s[13]), __float_as_uint(s[12]), sel); pw1.w = __builtin_amdgcn_perm(__float_as_uint(s[15]), __float_as_uint(s[14]), sel);
    } else {
        pw0.x = pkbf(s[0], s[1]); pw0.y = pkbf(s[2], s[3]); pw0.z = pkbf(s[4], s[5]); pw0.w = pkbf(s[6], s[7]);
        pw1.x = pkbf(s[8], s[9]); pw1.y = pkbf(s[10], s[11]); pw1.z = pkbf(s[12], s[13]); pw1.w = pkbf(s[14], s[15]);
    }
    pv_part<false>(st, vf, ones, __builtin_bit_cast(bf16x8, pw0), __builtin_bit_cast(bf16x8, pw1));
}
__device__ __forceinline__ f32x16 splat16(float v) { f32x16 s;
#pragma unroll
    for (int r = 0; r < 16; ++r) s[r] = v;
    return s; }

__device__ __forceinline__ f32x16 lut16(const LAS float* lutp) { f32x16 v;
#pragma unroll
    for (int r = 0; r < 16; ++r) v[r] = lutp[ROFF(r)];
    return v; }
template <int MODE, bool FAST>
__device__ __forceinline__ void attn_stream(Soft2& st, const bf16x8 (&qf)[4], const bf16* Kb, const bf16* Vb, int kt0, int np, const LAS float* lut, int q, int s0, unsigned mlo, unsigned mhi, float c31,
                                            LAS unsigned char* kvbuf, int tid, int col, int half, const bf16x8 ones) {
    u32x4v ra, rb;
    const __amdgpu_buffer_rsrc_t rs = stage_rsrc(Kb, Vb, tid); const unsigned loff = stage_goff(tid);
    const u32x2v so = stage_loff(tid);
    pair_load(rs, kt0, loff, ra, rb); pair_store(kvbuf, ra, rb, so);
    if (np > 1) { pair_load(rs, kt0 + 2, loff, ra, rb); pair_store(kvbuf + 16384, ra, rb, so); }
    if (np > 2) pair_load(rs, kt0 + 4, loff, ra, rb);
    __syncthreads();
#define ATT_LUTP(KT_) (MODE == 0 ? true : (MODE == 1 ? ((s0 - 32 * (KT_) - 31) < 128) : !((s0 - 32 * (KT_) - 31) >= 128 && (s0 + 7 - 32 * (KT_)) < 512)))
#define ATT_QK(DST_, KT_) do { if (ATT_LUTP(KT_)) DST_ = qk_tile(kf, qf, lut16(lut - (q - 32 * (KT_) - 4 * half))); else DST_ = qk_tile(kf, qf, splat16(0.f)); } while (0)
#define ATT_PROCESS(S_, KT_, VF_) do { const int kt_ = (KT_); float cadd_ = 0.f; bool bit_ = true; \
        if (MODE == 1) { const int i_ = kt_ >> 1; bit_ = (((((unsigned long long)mhi << 32) | mlo) >> i_) & 1ull) != 0ull; cadd_ = bit_ ? 0.f : NEGL; } \
        if (FAST) soft_fast_pv<MODE == 1>(st, S_, VF_, ones, bit_ ? 0x07060302u : 0x0C0C0C0Cu); else soft_pv2(st, S_, VF_, ones, cadd_); } while (0)
    const bool lead = __builtin_amdgcn_readfirstlane(tid) < 256;
    KFrag kf; lds_k(kf, kvbuf, col, half);
    f32x16 sA, sB; ATT_QK(sA, kt0);
    int bo0 = 0, bo1 = 16384, bo2 = 32768;
#define ATT_PAIR(FAR_) do { \
        const LAS unsigned char* pb = kvbuf + bo0; const LAS unsigned char* pbn = kvbuf + bo1; \
        if ((FAR_) || p + 2 < np) pair_store(kvbuf + bo2, ra, rb, so); \
        if ((FAR_) || p + 3 < np) pair_load(rs, kt0 + 2 * p + 6, loff, ra, rb); \
        {     \
            VFrag vf; lds_v(vf, pb, col, half); lds_k(kf, pb + 8192, col, half); \
            if (FAR_) sB = qk_tile(kf, qf, splat16(0.f)); else ATT_QK(sB, kt0 + 2 * p + 1); \
            __builtin_amdgcn_sched_barrier(0); \
            ATT_PROCESS(sA, kt0 + 2 * p, vf); \
        } \
        {     \
            VFrag vf; lds_v(vf, pb + 8192, col, half); \
            if (FAR_) { lds_k(kf, pbn, col, half); sA = qk_tile(kf, qf, splat16(0.f)); } \
            else if (p + 1 < np) { lds_k(kf, pbn, col, half); ATT_QK(sA, kt0 + 2 * p + 2); } \
            __builtin_amdgcn_sched_barrier(0); \
            ATT_PROCESS(sB, kt0 + 2 * p + 1, vf); \
        } \
        __syncthreads(); \
        { const int tb = bo0; bo0 = bo1; bo1 = bo2; bo2 = tb; } } while (0)
    int p = 0;
    if (FAST && MODE != 0) {
        const int ktmax = (s0 - 159) >> 5;
        int pl = 0, ph = ((ktmax - kt0 - 2) >> 1) + 1;
        if (MODE == 2) { const int ktmin = ((s0 - 505) >> 5) + 1; pl = (ktmin - kt0) >> 1; pl = pl < 0 ? 0 : pl; }
        ph = ph > np - 3 ? np - 3 : ph;
#pragma unroll 1
        for (; p < pl && p < np; ++p) ATT_PAIR(false);
#pragma unroll 1
        for (; p < ph; ++p) ATT_PAIR(true);
    }
#pragma unroll 1
    for (; p < np; ++p) ATT_PAIR(false);
#undef ATT_PAIR
    if (FAST) st.lv[0] += xhalf_sum(st.lf.x + st.lf.y);
#undef ATT_LUTP
#undef ATT_QK
#undef ATT_PROCESS
}

struct DeferW { const float *win, *wout, *gain; bf16 *WIN2, *WOUT2; bool on; };
constexpr int DW_IN = 16 * 176, DW_OUT = 44 * 32, DW_SUB = 2 * (DW_IN + DW_OUT);
struct DeferD { const float* W; int ldw, k0, c0, Kd, drow0; bf16* WT; const float* kgain; float cscale; };
__device__ __forceinline__ DeferD defer_decode(const DeferW& dw, int sid) {
    DeferD d; int item = sid >> 1; const int h = sid & 1; d.kgain = nullptr; d.cscale = 1.0f;
    if (item < DW_IN) { const int kb = item / 176, nb = item % 176, pn = nb >> 3, bj = (nb >> 2) & 1, c = 32 * (nb & 3);
        d.W = dw.win; d.ldw = 2 * FF; d.k0 = 64 * kb + 32 * h; d.c0 = (bj ? FF : 0) + 128 * pn + c; d.WT = dw.WIN2; d.Kd = DM; d.drow0 = 32 * nb; d.kgain = dw.gain; d.cscale = bj ? (1.0f / LOG2E) : LOG2E; }
    else { item -= DW_IN; const int kb = item / 32, nb = item % 32;
        d.W = dw.wout; d.ldw = DM; d.k0 = 64 * kb + 32 * h; d.c0 = 32 * nb; d.WT = dw.WOUT2; d.Kd = FF; d.drow0 = 32 * nb; }
    return d;
}
__device__ __forceinline__ void defer_load(const DeferW& dw, int sid, int lane, f32x4 (&v)[4]) {
    const DeferD d = defer_decode(dw, sid); const int c4 = 4 * (lane & 7), rr = lane >> 3;
#pragma unroll
    for (int i = 0; i < 4; ++i) v[i] = *(const GAS f32x4*)(d.W + (size_t)(d.k0 + 8 * i + rr) * d.ldw + d.c0 + c4);
}
__device__ __forceinline__ void defer_finish(const DeferW& dw, int sid, const f32x4 (&v)[4], LAS float* scr, int lane) {
    const DeferD d = defer_decode(dw, sid); const int c4 = 4 * (lane & 7), rr = lane >> 3;
#pragma unroll
    for (int i = 0; i < 4; ++i) { const int kk = 8 * i + rr; const float gk = (d.kgain ? d.kgain[d.k0 + kk] : 1.0f) * d.cscale; LAS float* p = scr + kk * 32;
        p[(c4 + 0) ^ kk] = v[i][0] * gk; p[(c4 + 1) ^ kk] = v[i][1] * gk; p[(c4 + 2) ^ kk] = v[i][2] * gk; p[(c4 + 3) ^ kk] = v[i][3] * gk; }
    LDS_WAIT(); asm volatile("" ::: "memory");
    const int c = lane & 3;
#pragma unroll
    for (int j = 0; j < 2; ++j) { const int n = (lane >> 2) + 16 * j; const LAS float* s = scr + (8 * c) * 32;
        v4u o; o.x = pk2(s[0 * 32 + (n ^ (8 * c + 0))], s[1 * 32 + (n ^ (8 * c + 1))]); o.y = pk2(s[2 * 32 + (n ^ (8 * c + 2))], s[3 * 32 + (n ^ (8 * c + 3))]);
        o.z = pk2(s[4 * 32 + (n ^ (8 * c + 4))], s[5 * 32 + (n ^ (8 * c + 5))]); o.w = pk2(s[6 * 32 + (n ^ (8 * c + 6))], s[7 * 32 + (n ^ (8 * c + 7))]);
        *(GAS v4u*)(d.WT + (size_t)(d.drow0 + n) * d.Kd + d.k0 + 8 * c) = o; }
    LDS_WAIT(); asm volatile("" ::: "memory");
}
__device__ __forceinline__ void defer_subitem(const DeferW& dw, int sid, LAS float* scr, int lane) { f32x4 v[4]; defer_load(dw, sid, lane, v); defer_finish(dw, sid, v, scr, lane); }
template <bool fast>
__device__ __forceinline__ void attn2_unit(Frame& F, const AttP& P, const float* sinks, int b, int g, int blk, const LAS float* lutA, const LAS float* lutB, LAS float* wscr, const DeferW& dw, int dsid) {
    const int w = F.wave; const int lane = hw_lane_id(); const int tid = w * 64 + lane;
    const int col = lane & 31, half = lane >> 5, ql = col >> 2, hd = col & 3, bg = b * 2 + g, sb = 64 * blk, s0 = sb + 8 * w, q = s0 + ql, head8 = g * 4 + hd, t = b * SEQ + q;
    LAS unsigned char* kvbuf = F.lds + RING_OFF + ATT2_KV_OFF;
    const int kt_top = (sb + 63) >> 5, ktw = s0 >> 5;
    Soft2 st; f32x16 r0, r1;
    const bf16x8 ones = (bf16x8){0x3F80, 0x3F80, 0x3F80, 0x3F80, 0x3F80, 0x3F80, 0x3F80, 0x3F80};
    const int ntc_u = (sb + 63 >= 31) ? ((sb + 63 - 31) >> 4) / 32 + 1 : 0;
    u32x4v ctile[8];
    { const bf16* KCb = P.KC + (size_t)bg * 256 * 64; const bf16* VCb = P.VCT + (size_t)bg * 8 * 2048;
#pragma unroll
      for (int kt = 0; kt < 8; ++kt) ctile[kt] = (kt < ntc_u) ? tile_load(KCb + kt * 2048, VCb + kt * 2048, tid) : (u32x4v){0u, 0u, 0u, 0u}; }
    bf16x8 qf[4]; { const bf16* qp = P.QB + ((size_t)(b * 8 + head8) * SEQ + q) * 64 + 8 * half;
#pragma unroll
        for (int s4 = 0; s4 < 4; ++s4) qf[s4] = *(const bf16x8*)(qp + 16 * s4); }
    const float g0 = P.GT[(size_t)t * 32 + head8], g1 = P.GT[(size_t)t * 32 + 8 + head8], g2 = P.GT[(size_t)t * 32 + 16 + head8];
    for (int rp_ = 0; rp_ < (KREP == 51 ? 2 : 1); ++rp_) {
        bf16x8 qfa[4]; { const bf16* qp = P.QA + ((size_t)(b * 8 + head8) * SEQ + q) * 64 + 8 * half;
#pragma unroll
            for (int s4 = 0; s4 < 4; ++s4) qfa[s4] = *(const bf16x8*)(qp + 16 * s4); }
        if (fast) soft2_init(st, 0.f, __builtin_amdgcn_exp2f(sinks[head8] * LOG2E)); else soft2_init(st, sinks[head8] * LOG2E, 1.0f);
        const LAS float* lut = lutA + head8 * LA + OFFA;
        const int kt0 = (sb > 127 ? sb - 127 : 0) >> 5, nt = kt_top - kt0 + 1, ktw_lo = (s0 > 127 ? s0 - 127 : 0) >> 5;
        const bf16* Kb = P.KA + (size_t)bg * SEQ * 64; const bf16* Vb = P.VAT + (size_t)bg * (SEQ / 32) * 2048;
        attn_stream<0, fast>(st, qfa, Kb, Vb, kt0, nt >> 1, lut, q, s0, 0u, 0u, 0.f, kvbuf, tid, col, half, ones);
        r0 = splat16(0.f); r1 = splat16(0.f);
        soft2_acc(r0, r1, st, 1.0f);
        store_o_rows((LAS unsigned char*)wscr, P.mix + (size_t)(b * SEQ + s0) * 1024 + g * 256, r0, r1, lane);
    }
    const LAS float* lut = lutB + head8 * LB + OFFB;
    constexpr float c31 = 0.f;
    r0 = splat16(0.f); r1 = splat16(0.f);
    LAS float* impG = wscr; LAS float* impL = wscr + 512;
    const int ntc = (s0 + 7 >= 31) ? ((s0 + 7 - 31) >> 4) / 32 + 1 : 0;
    { const u32x2v so_u = stage_loff(tid);
#pragma unroll
        for (int kt = 0; kt < 8; ++kt) if (kt < ntc_u) tile_store(kvbuf + kt * 8192, ctile[kt], so_u);
        __syncthreads();
    }
    unsigned mlo = 0u, mhi = 0u;
    for (int rp_ = 0; rp_ < (KREP == 52 ? 2 : 1); ++rp_) {
    if constexpr (fast) {
        soft2_init(st, 0.f, 0.f);
        float Gs[8][4], Ls[8][4];
#pragma unroll
        for (int kt = 0; kt < 8; ++kt) {
#pragma unroll
            for (int i = 0; i < 4; ++i) { Gs[kt][i] = 0.f; Ls[kt][i] = 0.f; }
            if (kt < ntc) { const LAS unsigned char* cb = kvbuf + kt * 8192;
                KFrag kf; VFrag vf; lds_k(kf, cb, col, half); lds_v(vf, cb, col, half);
                f32x16 s = qk_tile(kf, qf, splat16(0.f));
                const bool farc = 512 * kt <= s0 - 655;
                if (!farc) { const int basec = q - 31 - 512 * kt - 64 * half;
#pragma unroll
                    for (int r = 0; r < 16; ++r) { int rc = basec - 16 * ROFF(r); rc = rc < -1 ? -1 : (rc > 511 ? 511 : rc); s[r] += lut[-rc]; } }
#pragma unroll
                for (int r = 0; r < 16; ++r) s[r] = __builtin_amdgcn_exp2f(s[r]);
#pragma unroll
                for (int i = 0; i < 4; ++i) { Gs[kt][i] = (s[4 * i] + s[4 * i + 1]) + (s[4 * i + 2] + s[4 * i + 3]); Ls[kt][i] = s[4 * i + 3]; }
                st.lf.x += (Gs[kt][0] + Gs[kt][1]) + (Gs[kt][2] + Gs[kt][3]);
                u32x4v pw0, pw1;
                pw0.x = pkbf(s[0], s[1]); pw0.y = pkbf(s[2], s[3]); pw0.z = pkbf(s[4], s[5]); pw0.w = pkbf(s[6], s[7]);
                pw1.x = pkbf(s[8], s[9]); pw1.y = pkbf(s[10], s[11]); pw1.z = pkbf(s[12], s[13]); pw1.w = pkbf(s[14], s[15]);
                pv_part<false>(st, vf, ones, __builtin_bit_cast(bf16x8, pw0), __builtin_bit_cast(bf16x8, pw1));
            }
        }
        st.lv[0] += xhalf_sum(st.lf.x + st.lf.y);
        soft2_acc(r0, r1, st, rp_ == 0 ? g0 : 0.f);
#pragma unroll
        for (int j = 0; j < 8; ++j) { impG[lane + 64 * j] = 0.f; impL[lane + 64 * j] = 0.f; }
        const float invl = __builtin_amdgcn_rcpf(fmaxf(st.lv[0], 1.1754944e-38f));
#pragma unroll
        for (int kt = 0; kt < 8; ++kt) if (kt < ntc) {
#pragma unroll
            for (int i = 0; i < 4; ++i) {
                const float G = quad_sum(Gs[kt][i] * invl), L = quad_sum(Ls[kt][i] * invl);
                const int n = 8 * kt + 2 * i + half;
                if (hd == 0) { impG[ql * 64 + n] = G; if (n < 63) impL[ql * 64 + n + 1] = L; }
            }
        }
    } else {
    soft2_init(st, 0.f, 0.f);
#pragma unroll 1
    for (int kt = 0; kt < ntc; ++kt) { const LAS unsigned char* cb = kvbuf + kt * 8192;
        KFrag kf; VFrag vf; lds_k(kf, cb, col, half); lds_v(vf, cb, col, half);
        f32x16 s = qk_tile(kf, qf, splat16(0.f));
        const bool farc = 512 * kt <= s0 - 655;
        if (!farc) { const int basec = q - 31 - 512 * kt - 64 * half;
#pragma unroll
            for (int r = 0; r < 16; ++r) { int rc = basec - 16 * ROFF(r); rc = rc < -1 ? -1 : (rc > 511 ? 511 : rc); s[r] += lut[-rc]; } }
        soft_pv2(st, s, vf, ones, farc ? c31 : 0.f);
    }
    soft2_acc(r0, r1, st, rp_ == 0 ? g0 : 0.f);
#pragma unroll
    for (int j = 0; j < 8; ++j) { impG[lane + 64 * j] = 0.f; impL[lane + 64 * j] = 0.f; }
    {
        const float nmfin = -st.m, invl = __builtin_amdgcn_rcpf(fmaxf(st.lv[0], 1.1754944e-38f));
#pragma unroll 1
        for (int kt = 0; kt < ntc; ++kt) { const LAS unsigned char* cb = kvbuf + kt * 8192;
            KFrag kf; lds_k(kf, cb, col, half);
            f32x16 s = qk_tile(kf, qf, splat16(0.f));
            const bool farc = 512 * kt <= s0 - 655;
            if (farc) { const float nmc = nmfin + c31;
#pragma unroll
                for (int r = 0; r < 16; ++r) s[r] = __builtin_amdgcn_exp2f(s[r] + nmc) * invl; }
            else { const int basec = q - 31 - 512 * kt - 64 * half;
#pragma unroll
                for (int r = 0; r < 16; ++r) { int rc = basec - 16 * ROFF(r); rc = rc < -1 ? -1 : (rc > 511 ? 511 : rc); s[r] = __builtin_amdgcn_exp2f(s[r] + lut[-rc] + nmfin) * invl; } }
#pragma unroll
            for (int i = 0; i < 4; ++i) {
                const float G = quad_sum((s[4 * i] + s[4 * i + 1]) + (s[4 * i + 2] + s[4 * i + 3])), L = quad_sum(s[4 * i + 3]);
                const int n = 8 * kt + 2 * i + half;
                if (hd == 0) { impG[ql * 64 + n] = G; if (n < 63) impL[ql * 64 + n + 1] = L; }
            }
        }
    }
    }
#pragma unroll 1
    for (int q4 = 0; q4 < 8; q4 += 4) {
        int key[4]; unsigned long long selv[4]; bool need = false;
#pragma unroll
        for (int i = 0; i < 4; ++i) { const int qq = q4 + i, qs = s0 + qq, cur = qs >> 6, n = lane;
            const float imp = impG[qq * 64 + n] + impL[qq * 64 + n];
            const bool valid = n <= cur, forced = (n == 0) || (n == cur) || (n == cur - 1);
            const float score = imp + (forced ? 1000.0f : 0.0f);
            key[i] = valid ? (__float_as_int(score) & ~63) : (int)0x80000000;
            selv[i] = __ballot(valid); need = need || (cur >= 16); }
        if (need) {
            int T[4] = {0, 0, 0, 0};
#pragma unroll 1
            for (int bitp = 30; bitp >= 6; --bitp) {
#pragma unroll
                for (int i = 0; i < 4; ++i) { const int cand = T[i] | (1 << bitp); const int cnt = __builtin_popcountll(__ballot(key[i] >= cand)); T[i] = (cnt >= 16) ? cand : T[i]; } }
#pragma unroll
            for (int i = 0; i < 4; ++i) { const int cur = (s0 + q4 + i) >> 6;
                if (cur >= 16) { const unsigned long long gt = __ballot(key[i] > T[i]), eq = __ballot(key[i] == T[i]); const int k = 16 - __builtin_popcountll(gt);
                    unsigned long long mm = eq;
#pragma unroll 1
                    for (int j = 0; j < k; ++j) mm &= mm - 1ull;
                    selv[i] = gt | (eq ^ mm); } }
        }
#pragma unroll
        for (int i = 0; i < 4; ++i) if (ql == q4 + i) { mlo = (unsigned)selv[i]; mhi = (unsigned)(selv[i] >> 32); }
    }
    }
#define R0_PARK() do { if (fast) { _Pragma("unroll") for (int k = 0; k < 4; ++k) { f32x4 v_ = {r0[4 * k], r0[4 * k + 1], r0[4 * k + 2], r0[4 * k + 3]}; *(LAS f32x4*)((LAS unsigned char*)wscr + k * 1024 + lane * 16) = v_; } } } while (0)
#define R0_FETCH() do { if (fast) { _Pragma("unroll") for (int k = 0; k < 4; ++k) { const f32x4 v_ = *(const LAS f32x4*)((LAS unsigned char*)wscr + k * 1024 + lane * 16); r0[4 * k] = v_.x; r0[4 * k + 1] = v_.y; r0[4 * k + 2] = v_.z; r0[4 * k + 3] = v_.w; } } } while (0)
    R0_PARK();
    __syncthreads();
    for (int rp_ = 0; rp_ < (KREP == 53 ? 2 : 1); ++rp_) {
        const bf16* Kb = P.KS + (size_t)bg * SEQ * 64; const bf16* Vb = P.VST + (size_t)bg * (SEQ / 32) * 2048;
        soft2_init(st, 0.f, 0.f);
        attn_stream<1, fast>(st, qf, Kb, Vb, 0, blk + 1, lut, q, s0, mlo, mhi, c31, kvbuf, tid, col, half, ones);
        R0_FETCH();
        soft2_acc(r0, r1, st, rp_ == 0 ? g1 : 0.f);
        R0_PARK();
    }
    f32x4 dwv[4];
    for (int rp_ = 0; rp_ < (KREP == 54 ? 2 : 1); ++rp_) {
        const bf16* Kb = P.KW + (size_t)bg * SEQ * 64; const bf16* Vb = P.VWT + (size_t)bg * (SEQ / 32) * 2048;
        soft2_init(st, 0.f, 0.f);
        const int kt0 = (sb > 511 ? sb - 511 : 0) >> 5, nt = kt_top - kt0 + 1, ktw_lo = (s0 > 511 ? s0 - 511 : 0) >> 5;
        attn_stream<2, fast>(st, qf, Kb, Vb, kt0, nt >> 1, lut, q, s0, 0u, 0u, c31, kvbuf, tid, col, half, ones);
        R0_FETCH();
        if (dw.on) defer_load(dw, dsid, lane, dwv);
        soft2_acc(r0, r1, st, rp_ == 0 ? g2 : 0.f);
    }
    store_o_rows((LAS unsigned char*)wscr, P.mix + (size_t)(b * SEQ + s0) * 1024 + 512 + g * 256, r0, r1, lane);
    if (dw.on) defer_finish(dw, dsid, dwv, wscr, lane);
}

__device__ __forceinline__ void attn2_phase(Frame& F, const AttP& P, const float* tbl, const float* sinks, const float* qna, const float* kna, const float* qnb, const float* knb, const DeferW dw) {
    LAS float* lutA = (LAS float*)(F.lds + RING_OFF + ATT_LUTA_OFF); LAS float* lutB = (LAS float*)(F.lds + RING_OFF + ATT_LUTB_OFF);
    for (int i = F.tid; i < 8 * LA; i += NWAVES * 64) { const int h = i / LA, rel = OFFA - i % LA; lutA[i] = (rel >= 0 && rel < 128) ? tbl[t5_bucket(rel) * 16 + h] * LOG2E : NEGL; }
    for (int i = F.tid; i < 8 * LB; i += NWAVES * 64) { const int h = i / LB, rel = OFFB - i % LB; lutB[i] = (rel >= 0 && rel < 512) ? (tbl[t5_bucket(rel) * 16 + 8 + h] - tbl[31 * 16 + 8 + h]) * LOG2E : NEGL; }
    { LAS float* gsc = (LAS float*)(F.lds + RING_OFF + ATT_WSCR_OFF);
      if (F.wave < 4) { const float* gp = F.wave == 0 ? qna : F.wave == 1 ? kna : F.wave == 2 ? qnb : knb; const float m = wave_max(fabsf(gp[F.lane])); if (F.lane == 0) gsc[F.wave] = m; }
      else if (F.wave == 4) { float m = 0.f; for (int i = F.lane; i < 256; i += 64) m = fmaxf(m, fabsf(tbl[(i >> 3) * 16 + (i & 7)]));
          m = fmaxf(m, F.lane < 8 ? fabsf(sinks[F.lane]) : 0.f); m = wave_max(m); if (F.lane == 0) gsc[4] = m * LOG2E; }
      else if (F.wave == 5) { float m = 0.f; for (int i = F.lane; i < 256; i += 64) m = fmaxf(m, fabsf(tbl[(i >> 3) * 16 + 8 + (i & 7)] - tbl[31 * 16 + 8 + (i & 7)])); m = wave_max(m); if (F.lane == 0) gsc[5] = m * LOG2E; } }
    __syncthreads();
    bool fast;
    { const LAS float* gsc = (const LAS float*)(F.lds + RING_OFF + ATT_WSCR_OFF);
      const float bA = 64.0f * gsc[0] * gsc[1] * QSCALE * 1.02f + gsc[4], bB = 64.0f * gsc[2] * gsc[3] * QSCALE * 1.02f + gsc[5];
      fast = __builtin_amdgcn_readfirstlane((int)(fmaxf(bA, bB) < 60.0f)) != 0; }
    __syncthreads();
    LAS float* wscr = (LAS float*)(F.lds + RING_OFF + ATT_WSCR_OFF + F.wave * ATT_WSCR_BYTES);
    for (int v = F.vcu; v < 256; v += F.G) {
        const int bg = v >> 4, j = v & 15, b = bg >> 1, g = bg & 1;
#pragma unroll 1
        for (int i = 0; i < 4; ++i) { const int blk = (i == 0) ? j : (i == 1) ? 31 - j : (i == 2) ? 32 + j : 63 - j; const int slot = (v * 4 + i) * 8 + F.wave;
            if (fast) attn2_unit<true>(F, P, sinks, b, g, blk, lutA, lutB, wscr, dw, slot); else attn2_unit<false>(F, P, sinks, b, g, blk, lutA, lutB, wscr, dw, slot); }
    }
    __syncthreads();
}

enum { F_NORM = 1, F_PROJ = 2, F_CMP = 4, F_ATT = 8 };
struct Args { const float* in[21]; float* out; unsigned char* ws; int ph_lo, ph_hi, flags, li, rep, pad; };

__device__ __forceinline__ void p0_item(const float* W, int ldw, int k0, int c0, int nvalid, bf16* WT, int Kd, int drow0, LAS float* scr, int lane, const float* kgain = nullptr, bool fragmajor = false, float cscale = 1.0f) {
    f32x4 v[8]; const int c4 = 4 * (lane & 7), rr = lane >> 3;
#pragma unroll
    for (int i = 0; i < 8; ++i) v[i] = (c4 < nvalid) ? *(const GAS f32x4*)(W + (size_t)(k0 + 8 * i + rr) * ldw + c0 + c4) : (f32x4){0.f, 0.f, 0.f, 0.f};
#pragma unroll
    for (int i = 0; i < 8; ++i) { const int kk = 8 * i + rr; const float gk = (kgain ? kgain[k0 + kk] : 1.0f) * cscale; LAS float* d = scr + kk * 33 + c4;
        d[0] = v[i][0] * gk; d[1] = v[i][1] * gk; d[2] = v[i][2] * gk; d[3] = v[i][3] * gk; }
    LDS_WAIT(); asm volatile("" ::: "memory");
    const int c = lane & 7;
#pragma unroll
    for (int j = 0; j < 4; ++j) { const int n = (lane >> 3) + 8 * j; const LAS float* s = scr + (8 * c) * 33 + n;
        v4u o; o.x = pk2(s[0 * 33], s[1 * 33]); o.y = pk2(s[2 * 33], s[3 * 33]); o.z = pk2(s[4 * 33], s[5 * 33]); o.w = pk2(s[6 * 33], s[7 * 33]);
        if (!fragmajor) *(GAS v4u*)(WT + (size_t)(drow0 + n) * Kd + k0 + 8 * c) = o;
        else { const int kk = k0 + 8 * c, nn = drow0 + n;
            *(GAS v4u*)(WT + ((size_t)((kk >> 4) * 4 + (nn >> 5)) * 64 + (nn & 31) + 32 * ((kk >> 3) & 1)) * 8) = o; } }
    LDS_WAIT(); asm volatile("" ::: "memory");
}
__host__ __device__ __forceinline__ int main_colbase(int H) {
    if (H < 8) return 64 * H;
    if (H < 16) return 768 + 64 * (H - 8);
    if (H < 18) return 512 + 64 * (H - 16);
    if (H < 20) return 1280 + 2 * 128 + 64 * (H - 18);
    if (H < 22) return 1280 + 4 * 128 + 64 * (H - 20);
    if (H < 24) return 1280 + 0 * 128 + 64 * (H - 22);
    if (H < 26) return 1280 + 1 * 128 + 64 * (H - 24);
    if (H == 26) return 2048;
    return -1;
}
__host__ __device__ __forceinline__ int vt_colbase(int vh) {
    if (vh < 2) return 640 + 64 * vh;
    if (vh < 4) return 1280 + 3 * 128 + 64 * (vh - 2);
    if (vh < 6) return 1280 + 5 * 128 + 64 * (vh - 4);
    return -1;
}
__device__ __forceinline__ void p0_prologue(Frame& F, const Args& a) {
    LAS float* scr = (LAS float*)(F.lds + RING_OFF + F.wave * 16384);
    const int gw = F.vcu * NWAVES + F.wave, NGW = F.G * NWAVES;
    unsigned char* ws = a.ws;
    constexpr int I_IN = 16 * 176, I_OUT = 44 * 32, I_MAIN = 16 * 56, I_PLAIN = 16 * 72, I_VT = 16 * 16, I_MO = 16 * 32, I_W1 = 2 * 32 * 4, I_W2 = 2 * 2 * 2;
    const bool defer = (F.G == 256) && ((a.flags & 15) == 15);
    const bool fproj = (a.flags & F_PROJ) != 0, fnorm = (a.flags & F_NORM) != 0;
    const int i_proj = fproj ? I_MAIN + I_VT : I_PLAIN;
    const int NITEMS = 2 * I_IN + 2 * I_OUT + i_proj + I_MO + I_W1 + I_W2;
    for (int it = gw; it < NITEMS; it += NGW) {
        int r = it;
        if (r < 2 * I_IN) { const int l = r / I_IN; if (l && defer) continue; r %= I_IN; const int kb = r / 176, nb = r % 176;
            const int pn = nb >> 3, bj = (nb >> 2) & 1, c = 32 * (nb & 3);
            p0_item(a.in[l ? 19 : 3], 2 * FF, 64 * kb, (bj ? FF : 0) + 128 * pn + c, 32, (bf16*)(ws + (l ? WS_WIN2 : WS_WIN1)), DM, 32 * nb, scr, F.lane, (l && fnorm) ? a.in[18] : nullptr, false, bj ? (1.0f / LOG2E) : LOG2E); continue; }
        r -= 2 * I_IN;
        if (r < 2 * I_OUT) { const int l = r / I_OUT; r %= I_OUT; if (l && defer && I_IN + r < 4096) continue; const int kb = r / 32, nb = r % 32;
            p0_item(a.in[l ? 20 : 4], DM, 64 * kb, 32 * nb, 32, (bf16*)(ws + (l ? WS_WOUT2 : WS_WOUT1)), FF, 32 * nb, scr, F.lane); continue; }
        r -= 2 * I_OUT;
        if (r < i_proj) {
            if (!fproj) { const int kb = r / 72, nb = r % 72; const int nv = 2072 - 32 * nb; p0_item(a.in[6], 2072, 64 * kb, nv > 0 ? 32 * nb : 0, nv > 32 ? 32 : (nv > 0 ? nv : 0), (bf16*)(ws + WS_WMAIN), DM, 32 * nb, scr, F.lane, fnorm ? a.in[5] : nullptr); continue; }
            if (r < I_MAIN) { const int kb = r / 56, nb = r % 56;
                const int pn = nb >> 3, bj = (nb >> 2) & 1, wc = nb & 3, H = 4 * pn + wc, cb = main_colbase(H);
                const int nv = cb < 0 ? 0 : (H == 26 ? (bj ? 0 : 24) : 32);
                p0_item(a.in[6], 2072, 64 * kb, cb < 0 ? 0 : cb + 32 * bj, nv, (bf16*)(ws + WS_WMAIN), DM, 32 * nb, scr, F.lane, fnorm ? a.in[5] : nullptr); continue; }
            r -= I_MAIN; { const int kb = r / 16, nb = r % 16, vh = nb >> 1, cb = vt_colbase(vh);
                p0_item(a.in[6], 2072, 64 * kb, cb < 0 ? 0 : cb + 32 * (nb & 1), cb < 0 ? 0 : 32, (bf16*)(ws + WS_WVT), DM, 32 * nb, scr, F.lane, fnorm ? a.in[5] : nullptr); continue; }
        }
        r -= i_proj;
        if (r < I_MO) { const int kb = r / 32, nb = r % 32; p0_item(a.in[7], DM, 64 * kb, 32 * nb, 32, (bf16*)(ws + WS_WMO), DM, 32 * nb, scr, F.lane); continue; }
        r -= I_MO;
        if (r < I_W1) { const int kv = r / 128; r %= 128; const int kb = r / 4, nb = r % 4; p0_item(a.in[14] + (size_t)kv * 2048 * 128, 128, 64 * kb, 32 * nb, 32, (bf16*)(ws + WS_W1T) + (size_t)kv * 128 * 2048, 2048, 32 * nb, scr, F.lane, nullptr, true); continue; }
        r -= I_W1;
        { const int kv = r / 4; r %= 4; const int kb = r / 2, nb = r % 2; p0_item(a.in[16] + (size_t)kv * 128 * 64, 64, 64 * kb, 32 * nb, 32, (bf16*)(ws + WS_W2T) + (size_t)kv * 64 * 128, 128, 32 * nb, scr, F.lane); }
    }
    if (gw < 256) { const int kv = gw >> 7, hid = gw & 127; float s = 0.f;
        for (int j = 0; j < 32; ++j) { const int k = F.lane + 64 * j; s += a.in[13][kv * 2048 + k] * a.in[14][((size_t)kv * 2048 + k) * 128 + hid]; }
        s = wave_sum(s); if (F.lane == 0) ((float*)(ws + WS_POSB))[gw] = s + a.in[15][gw]; }
    const float* g1 = a.in[2];
    for (int m0 = gw; m0 < T; m0 += 4 * NGW) {
        f32x4 v[4][4];
#pragma unroll
        for (int rI = 0; rI < 4; ++rI) { const int m = m0 + rI * NGW; const GAS f32x4* xr = (const GAS f32x4*)(a.in[0] + (size_t)(m < T ? m : m0) * DM) + F.lane;
#pragma unroll
            for (int j = 0; j < 4; ++j) v[rI][j] = __builtin_nontemporal_load(xr + 64 * j); }
#pragma unroll
        for (int rI = 0; rI < 4; ++rI) { const int m = m0 + rI * NGW; if (m >= T) break;
            float s = 0.f;
#pragma unroll
            for (int j = 0; j < 4; ++j) s += (v[rI][j].x * v[rI][j].x + v[rI][j].y * v[rI][j].y) + (v[rI][j].z * v[rI][j].z + v[rI][j].w * v[rI][j].w);
            const float rstd = 1.0f / sqrtf(wave_sum(s) * (1.f / DM) + EPS); const f32x4* gr = (const f32x4*)g1 + F.lane;
            GAS unsigned long long* o8 = (GAS unsigned long long*)((bf16*)(ws + WS_A) + (size_t)m * DM) + F.lane;
#pragma unroll
            for (int j = 0; j < 4; ++j) { const f32x4 gg = gr[64 * j]; o8[64 * j] = (unsigned long long)pk2(v[rI][j].x * rstd * gg.x, v[rI][j].y * rstd * gg.y) | ((unsigned long long)pk2(v[rI][j].z * rstd * gg.z, v[rI][j].w * rstd * gg.w) << 32); } }
    }
}

__global__ void __launch_bounds__(NWAVES * 64, 2) mk(Args args) {
    extern __shared__ __attribute__((aligned(16))) unsigned char lds[];
    Frame F;
    F.lds = (LAS unsigned char*)lds; F.MISC = (volatile LAS unsigned*)(F.lds + MISC_OFF);
    F.wave = __builtin_amdgcn_readfirstlane((int)threadIdx.x >> 6);
#define FRESH() do { F.lane = hw_lane_id(); F.tid = F.wave * 64 + F.lane; } while (0)
#define LEADER() (F.wave == 0 && hw_lane_id() == 0)
    if (args.ph_lo < 0) cooperative_groups::this_grid().sync();
    FRESH();
    F.G = gridDim.x; { const int bx = blockIdx.x; F.vcu = (F.G % 8 == 0) ? (bx % 8) * (F.G / 8) + bx / 8 : bx; }
    unsigned char* ws = args.ws; F.ctl = (gu32*)(ws + WS_CTL);
    for (int u = F.tid; u < (LDS_BYTES - LDSCTL_OFF) / 4; u += NWAVES * 64) ((LAS unsigned*)(F.lds + LDSCTL_OFF))[u] = 0u;
    __syncthreads();
    const int lo = args.ph_lo, hi = args.ph_hi, flags = args.flags;
    const bool one = (hi - lo) > 1;
    XcdBarrier bar; bar.bar = (unsigned*)(F.ctl + CW_BAR) + args.li * XCD_BAR_WORDS; bar.x = 0; bar.st = nullptr;
    if (one) bar = xcd_barrier_post((unsigned*)(F.ctl + CW_BAR) + args.li * XCD_BAR_WORDS, F.MISC + 8, LEADER());
#define IN(k) (lo <= (k) && (k) < hi)
#define REP(k) for (int rep_ = 0; rep_ < ((KREP == (k)) ? 2 : 1); ++rep_)
#define SEAM(k) do { if (IN(k) && IN((k) + 1)) { xcd_barrier(bar, LEADER()); } FRESH(); } while (0)
    bf16* const A = (bf16*)(ws + WS_A); bf16* const ACT = (bf16*)(ws + WS_ACT); bf16* const MIX = (bf16*)(ws + WS_MIX);
    float* const SSQ1 = (float*)(ws + WS_SSQ1); float* const SSQ2 = (float*)(ws + WS_SSQ2);
    const bool fnorm = (flags & F_NORM) != 0;

    if (IN(0)) REP(0) { p0_prologue(F, args); } SEAM(0);
    if (IN(1)) REP(1) {
        pg8::Gemm g{A, (const bf16*)(ws + WS_WIN1), T, 2 * FF, DM}; pg8::StaticOrder S; S.init(T, 2 * FF, F.G, (int)blockIdx.x);
        pg8::EpiSwiglu E{ACT, FF, nullptr};
        pg8::gemm_phase<pg8::EpiSwiglu, pg8::StaticOrder, true, true>(F.lds + RING_OFF, g, S, E, F.wave);
    } SEAM(1);
    if (IN(2)) REP(2) {
        pg8::Gemm g{ACT, (const bf16*)(ws + WS_WOUT1), T, DM, FF}; pg8::StaticOrder S; S.init(T, DM, F.G, (int)blockIdx.x);
        pg8::EpiResid E{args.in[0], nullptr, 0.5f, fnorm ? nullptr : args.out, fnorm ? A : nullptr, fnorm ? SSQ1 : nullptr};
        pg8::gemm_phase<pg8::EpiResid, pg8::StaticOrder, true, true>(F.lds + RING_OFF, g, S, E, F.wave);
    } SEAM(2);
    if (IN(3)) REP(3) {
        if (!(flags & F_PROJ)) {
            pg8::Gemm g{A, (const bf16*)(ws + WS_WMAIN), T, NPLAIN, DM}; pg8::StaticOrder S; S.init(T, NPLAIN, F.G, (int)blockIdx.x);
            pg8::EpiPlain E{(bf16*)(ws + WS_PROJ), NPLAIN};
            pg8::gemm_phase<pg8::EpiPlain, pg8::StaticOrder, true, true>(F.lds + RING_OFF, g, S, E, F.wave);
        } else {
            pg8::Gemm g{A, (const bf16*)(ws + WS_WMAIN), T, NMAIN, DM}; pg8::StaticOrder S; S.init(T, NMAIN, F.G, (int)blockIdx.x);
            pg8::EpiProjMain E{SSQ1, (float*)(ws + WS_RSTD), args.in[8], args.in[9], args.in[11], args.in[12],
                               (bf16*)(ws + WS_QA), (bf16*)(ws + WS_QB), (bf16*)(ws + WS_KA), (bf16*)(ws + WS_KS), (bf16*)(ws + WS_KW), (bf16*)(ws + WS_KCR), (bf16*)(ws + WS_VCR), (float*)(ws + WS_GT), QSCALE, SEQ, T};
            pg8::gemm_phase<pg8::EpiProjMain, pg8::StaticOrder, true, true>(F.lds + RING_OFF, g, S, E, F.wave);
            if (F.G == 256 && (flags & F_CMP) && blockIdx.x >= 128) {
                pg8::Gemm gt{(const bf16*)(ws + WS_WVT), A, 512, T, DM}; pg8::OneUnit S1{0, (int)blockIdx.x - 128};
                pg8::EpiProjT Et{SSQ1, (bf16*)(ws + WS_VAT), (size_t)(WS_VST - WS_VAT) / 2, SEQ};
                pg8::gemm_phase<pg8::EpiProjT, pg8::OneUnit, true, true>(F.lds + RING_OFF, gt, S1, Et, F.wave);
            }
        }
    } SEAM(3);
    if (IN(4)) REP(4) {
        const bool bal = (F.G == 256) && (flags & F_PROJ) && (flags & F_CMP);
        if (flags & F_PROJ) {
            pg8::Gemm g{(const bf16*)(ws + WS_WVT), A, 512, T, DM};
            pg8::EpiProjT E{SSQ1, (bf16*)(ws + WS_VAT), (size_t)(WS_VST - WS_VAT) / 2, SEQ};
            if (bal) { if (blockIdx.x < 128) { pg8::OneUnit S1{1, (int)blockIdx.x}; pg8::gemm_phase<pg8::EpiProjT, pg8::OneUnit, true, true, true>(F.lds + RING_OFF, g, S1, E, F.wave); } }
            else { pg8::StaticOrder S; S.init(512, T, F.G, (int)blockIdx.x); pg8::gemm_phase<pg8::EpiProjT, pg8::StaticOrder, true, true>(F.lds + RING_OFF, g, S, E, F.wave); }
        }
        if (flags & F_CMP) {
            FRESH();
            if (bal) { if (blockIdx.x >= 128)
                cmp_unit2(F, 2 * ((int)blockIdx.x - 128), (const bf16*)(ws + WS_KCR), (const bf16*)(ws + WS_VCR), (const bf16*)(ws + WS_W1T), (const bf16*)(ws + WS_W2T), (const float*)(ws + WS_POSB), args.in[17], args.in[12], (bf16*)(ws + WS_KC), (bf16*)(ws + WS_VCT)); }
            else for (int u = F.vcu; u < 256; u += F.G)
                cmp_unit(F, u, (const bf16*)(ws + WS_KCR), (const bf16*)(ws + WS_VCR), (const bf16*)(ws + WS_W1T), (const bf16*)(ws + WS_W2T), (const float*)(ws + WS_POSB), args.in[17], args.in[12], (bf16*)(ws + WS_KC), (bf16*)(ws + WS_VCT));
        }
    }
    SEAM(4);
    if (IN(5) && (flags & F_ATT)) REP(5) {
        const AttP P{(const bf16*)(ws + WS_QA), (const bf16*)(ws + WS_QB), (const bf16*)(ws + WS_KA), (const bf16*)(ws + WS_VAT), (const bf16*)(ws + WS_KC), (const bf16*)(ws + WS_VCT), (const bf16*)(ws + WS_KS), (const bf16*)(ws + WS_VST),
                     (const bf16*)(ws + WS_KW), (const bf16*)(ws + WS_VWT), (const float*)(ws + WS_GT), MIX};
        const DeferW dw{args.in[19], args.in[20], fnorm ? args.in[18] : nullptr, (bf16*)(ws + WS_WIN2), (bf16*)(ws + WS_WOUT2), (F.G == 256) && ((flags & 15) == 15)};
        attn2_phase(F, P, args.in[1], args.in[10], args.in[8], args.in[9], args.in[11], args.in[12], dw);
    }
    SEAM(5);
    if (IN(6)) {
        pg8::Gemm g{MIX, (const bf16*)(ws + WS_WMO), T, DM, DM}; pg8::StaticOrder S; S.init(T, DM, F.G, (int)blockIdx.x);
        if (fnorm) { pg8::EpiResidB E{A, 1.0f, nullptr, A, SSQ2}; pg8::gemm_phase<pg8::EpiResidB, pg8::StaticOrder, true, true>(F.lds + RING_OFF, g, S, E, F.wave); }
        else { pg8::EpiResid E{args.out, nullptr, 1.0f, args.out, nullptr, nullptr}; pg8::gemm_phase<pg8::EpiResid, pg8::StaticOrder, true, true>(F.lds + RING_OFF, g, S, E, F.wave); }
    } SEAM(6);
    if (IN(7)) REP(7) {
        pg8::Gemm g{A, (const bf16*)(ws + WS_WIN2), T, 2 * FF, DM}; pg8::StaticOrder S; S.init(T, 2 * FF, F.G, (int)blockIdx.x);
        pg8::EpiSwiglu E{ACT, FF, fnorm ? SSQ2 : nullptr};
        pg8::gemm_phase<pg8::EpiSwiglu, pg8::StaticOrder, true, true>(F.lds + RING_OFF, g, S, E, F.wave);
    } SEAM(7);
    if (IN(8)) {
        pg8::Gemm g{ACT, (const bf16*)(ws + WS_WOUT2), T, DM, FF}; pg8::StaticOrder S; S.init(T, DM, F.G, (int)blockIdx.x);
        if (fnorm) { pg8::EpiResidB E{A, 0.5f, args.out, nullptr, nullptr}; pg8::gemm_phase<pg8::EpiResidB, pg8::StaticOrder, true, true>(F.lds + RING_OFF, g, S, E, F.wave); }
        else { pg8::EpiResid E{args.out, nullptr, 0.5f, args.out, nullptr, nullptr}; pg8::gemm_phase<pg8::EpiResid, pg8::StaticOrder, true, true>(F.lds + RING_OFF, g, S, E, F.wave); }
    }
#undef IN
#undef SEAM
}

static void launch_mk(const Args& base, int lo, int hi, int grid, hipStream_t stream) {
    static int li = 0;
    Args a = base; a.ph_lo = lo; a.ph_hi = hi; a.li = 0;
    if (hi - lo > 1) {
        a.li = (lo == 0) ? 0 : (lo < 6 ? 1 : 2);
        void* kargs[] = {&a};
        hipError_t e = hipLaunchCooperativeKernel((const void*)mk, dim3(grid), dim3(NWAVES * 64), kargs, LDS_BYTES, stream);
        if (e != hipSuccess) fprintf(stderr, "cooperative launch failed: %s (grid %d)\n", hipGetErrorString(e), grid);
    } else hipLaunchKernelGGL(mk, dim3(grid), dim3(NWAVES * 64), LDS_BYTES, stream, a);
    (void)li;
}
extern "C" void kernel_launch(void* const* d_in, const int* in_sizes, int n_in, void* d_out, int out_size, void* d_ws, size_t ws_size, hipStream_t stream) {
    static int grid = 0;
    if (grid == 0) {
        if (n_in != 21 || in_sizes[0] != T * DM || out_size != T * DM || ws_size < (KFLAGS == 15 ? WS_MIX + 64 * MiB : WS_END)) { fprintf(stderr, "kernel_launch: unexpected shapes / workspace (%d inputs, ws %zu)\n", n_in, ws_size); grid = -1; return; }
        int dev = 0, cus = 0;
        if (hipGetDevice(&dev) != hipSuccess || hipDeviceGetAttribute(&cus, hipDeviceAttributeMultiprocessorCount, dev) != hipSuccess) { grid = -1; return; }
        if (hipFuncSetAttribute((const void*)mk, hipFuncAttributeMaxDynamicSharedMemorySize, LDS_BYTES) != hipSuccess) { grid = -1; return; }
        (void)hipGetLastError();
        int per_cu = 0;
        if (hipOccupancyMaxActiveBlocksPerMultiprocessor(&per_cu, (const void*)mk, NWAVES * 64, LDS_BYTES) != hipSuccess || per_cu < 1) { fprintf(stderr, "occupancy query failed (%d)\n", per_cu); (void)hipGetLastError(); per_cu = 1; }
        grid = cus * (per_cu > 1 ? 1 : per_cu);
    }
    if (grid < 0) return;
    (void)hipMemsetAsync((char*)d_ws + WS_CTL, 0, CTL_ZERO_BYTES, stream);
    Args a{};
    for (int i = 0; i < 21; ++i) a.in[i] = (const float*)d_in[i];
    a.out = (float*)d_out; a.ws = (unsigned char*)d_ws; a.flags = KFLAGS; a.rep = KREP;
    unsigned char* ws = (unsigned char*)d_ws;
    const bool fnorm = (KFLAGS & F_NORM) != 0;
    if (KFLAGS == 15) { launch_mk(a, 0, 9, grid, stream); return; }
    if (fnorm) launch_mk(a, 0, 3, grid, stream);
    else { launch_mk(a, 0, 1, grid, stream); launch_mk(a, 1, 2, grid, stream); launch_mk(a, 2, 3, grid, stream); }
    if (!fnorm) hipLaunchKernelGGL(nv_rmsnorm, dim3(T / 4), dim3(256), 0, stream, (const float*)d_out, a.in[5], (bf16*)(ws + WS_A));
    launch_mk(a, 3, 4, grid, stream);
    if (!(KFLAGS & F_PROJ)) {
        HeadPrep hp{(const bf16*)(ws + WS_PROJ), fnorm ? (const float*)(ws + WS_SSQ1) : nullptr, a.in[8], a.in[9], a.in[11], a.in[12],
                    (bf16*)(ws + WS_QA), (bf16*)(ws + WS_QB), (bf16*)(ws + WS_KA), (bf16*)(ws + WS_VAT), (bf16*)(ws + WS_KCR), (bf16*)(ws + WS_VCR), (bf16*)(ws + WS_KS), (bf16*)(ws + WS_VST), (bf16*)(ws + WS_KW), (bf16*)(ws + WS_VWT), (float*)(ws + WS_GT)};
        hipLaunchKernelGGL(nv_headprep, dim3(T / 4), dim3(256), 0, stream, hp);
    }
    if (KFLAGS & (F_PROJ | F_CMP)) launch_mk(a, 4, 5, grid, stream);
    if (!(KFLAGS & F_CMP)) hipLaunchKernelGGL(nv_compress, dim3(2 * 8 * 2 * 256), dim3(128), 0, stream, (const bf16*)(ws + WS_KCR), (const bf16*)(ws + WS_VCR), a.in[13], a.in[14], a.in[15], a.in[16], a.in[17], a.in[12], (bf16*)(ws + WS_KC), (bf16*)(ws + WS_VCT));
    if (!(KFLAGS & F_ATT)) {
        hipLaunchKernelGGL(nv_band_a, dim3(T * 2), dim3(256), 0, stream, (const bf16*)(ws + WS_QA), (const bf16*)(ws + WS_KA), (const bf16*)(ws + WS_VAT), a.in[1], a.in[10], (bf16*)(ws + WS_MIX));
        hipLaunchKernelGGL(nv_nsa, dim3(T * 2), dim3(256), 0, stream, (const bf16*)(ws + WS_QB), (const bf16*)(ws + WS_KC), (const bf16*)(ws + WS_VCT), (const bf16*)(ws + WS_KS), (const bf16*)(ws + WS_VST), (const bf16*)(ws + WS_KW), (const bf16*)(ws + WS_VWT), (const float*)(ws + WS_GT), a.in[1], (bf16*)(ws + WS_MIX));
    } else launch_mk(a, 5, 6, grid, stream);
    if (fnorm) launch_mk(a, 6, 9, grid, stream);
    else { launch_mk(a, 6, 7, grid, stream);
        hipLaunchKernelGGL(nv_rmsnorm, dim3(T / 4), dim3(256), 0, stream, (const float*)d_out, a.in[18], (bf16*)(ws + WS_A));
        launch_mk(a, 7, 8, grid, stream); launch_mk(a, 8, 9, grid, stream); }
}
```

```cpp
#include <hip/hip_runtime.h>
#include <hip/hip_cooperative_groups.h>
#include <cstdio>
#include <cstdint>
#ifndef KFLAGS
#define KFLAGS 15
#endif
#ifndef KREP
#define KREP -1
#endif
__device__ __forceinline__ int hw_lane_id() { int l; asm volatile("v_mbcnt_lo_u32_b32 %0, -1, 0\n\tv_mbcnt_hi_u32_b32 %0, -1, %0" : "=v"(l)); return l; }
namespace pg8 {
#define PG8_LAS __attribute__((address_space(3)))
typedef unsigned short bf16_t;
typedef short bf16x8 __attribute__((ext_vector_type(8)));
typedef float f32x4 __attribute__((ext_vector_type(4)));
typedef unsigned u32x4 __attribute__((ext_vector_type(4)));
constexpr int BM = 256, BK = 64, HALF = 128, HTB = HALF * BK * 2  , STAGE_BYTES = 8 * HTB, NXCD = 8, WGM = 8;

__host__ __device__ __forceinline__ int lds_byte(int r, int c) { const int st = (r >> 4) * 2 + (c >> 5), rr = r & 15, cc = c & 31, ob = rr * 64 + cc * 2; return st * 1024 + (ob ^ (((ob >> 9) & 1) << 5)); }
__host__ __device__ __forceinline__ void stage_rc(int b, int& R, int& C) { const int st = b / 1024, sb = b % 1024, swz = sb ^ (((sb >> 9) & 1) << 5); R = (st >> 1) * 16 + swz / 64; C = (st & 1) * 32 + (swz % 64) / 2; }
__host__ __device__ __forceinline__ int perm32(int rho) { const int n = rho >> 4, i = rho & 15; return 8 * (i >> 2) + 4 * n + (i & 3); }

struct Unit { int pm, pn; };
struct Gemm { const bf16_t* A; const bf16_t* Bt; int M, N, K; };

struct StaticOrder {
    int nM, nN, nwg, G, c;
    __host__ __device__ void init(int M, int N, int G_, int c_) { nM = M / BM; nN = N / BM; nwg = nM * nN; G = G_; c = c_; }
    __host__ __device__ bool next(int i, Unit& u) const {
        const long L = (long)i * G + c; if (L >= nwg) return false;
        int wgid = (int)L; { const int q = nwg / NXCD, r = nwg % NXCD, xcd = wgid % NXCD, off = wgid / NXCD; wgid = (xcd < r ? xcd * (q + 1) : r * (q + 1) + (xcd - r) * q) + off; }
        const int nig = WGM * nN, gid = wgid / nig, fm = gid * WGM, gsz = (nM - fm) < WGM ? (nM - fm) : WGM;
        u.pm = fm + ((wgid % nig) % gsz); u.pn = (wgid % nig) / gsz; return true;
    }
    __device__ __forceinline__ void a_ready(const Unit&) const {}
    __device__ __forceinline__ void done(const Unit&) const {}
};


__device__ __forceinline__ unsigned cvt_pk_bf16(float lo, float hi) { unsigned r; asm volatile("v_cvt_pk_bf16_f32 %0, %1, %2" : "=v"(r) : "v"(lo), "v"(hi)); return r; }
typedef unsigned u32x2 __attribute__((ext_vector_type(2)));
constexpr float kLog2e = 1.4426950408889634f;
__device__ __forceinline__ float silu_f(float x) { return x * __builtin_amdgcn_rcpf(1.0f + __builtin_amdgcn_exp2f(-x * kLog2e)); }
typedef float f32x2 __attribute__((ext_vector_type(2)));
__device__ __forceinline__ f32x2 silu_mul_pk(f32x2 g, f32x2 u) {
    f32x2 e; e.x = __builtin_amdgcn_exp2f(-g.x); e.y = __builtin_amdgcn_exp2f(-g.y);
    const f32x2 d = e + 1.0f; f32x2 r; r.x = __builtin_amdgcn_rcpf(d.x); r.y = __builtin_amdgcn_rcpf(d.y);
    return (g * r) * u;
}
__device__ __forceinline__ float row_rstd(const float* ssq, int row, int fq) {
    const f32x4 p = *(const f32x4*)(ssq + (size_t)row * 16 + 4 * fq);
    float s = (p[0] + p[1]) + (p[2] + p[3]);
    s += __shfl_xor(s, 16); s += __shfl_xor(s, 32);
    return __builtin_amdgcn_rsqf(s * (1.0f / 1024.0f) + 1e-6f);
}

__device__ __forceinline__ void rows_rstd(float (&rs)[2][4], const float* ssq, int row0, int fq) {
    f32x4 p[2][4];
#pragma unroll
    for (int ai = 0; ai < 2; ++ai)
#pragma unroll
        for (int m = 0; m < 4; ++m) p[ai][m] = *(const f32x4*)(ssq + (size_t)(row0 + ai * HALF + m * 16) * 16 + 4 * fq);
#pragma unroll
    for (int ai = 0; ai < 2; ++ai)
#pragma unroll
        for (int m = 0; m < 4; ++m) { float s = (p[ai][m][0] + p[ai][m][1]) + (p[ai][m][2] + p[ai][m][3]); s += __shfl_xor(s, 16); s += __shfl_xor(s, 32); rs[ai][m] = __builtin_amdgcn_rsqf(s * (1.0f / 1024.0f) + 1e-6f); }
    asm volatile("" ::: "memory");
}

struct EpiPlain {
    static constexpr bool PERM = true, AFTER_DRAIN = false;
    bf16_t* O; int ldc;
    __device__ __forceinline__ void operator()(const f32x4 (&acc)[2][2][4][2], const Unit& u, int wr, int wc, int fr, int fq) const {
        const int row0 = u.pm * BM + wr * 64 + fr, col0 = u.pn * BM + wc * 32 + 8 * fq;
#pragma unroll
        for (int ai = 0; ai < 2; ++ai)
#pragma unroll
            for (int m = 0; m < 4; ++m) { bf16_t* rowp = O + (size_t)(row0 + ai * HALF + m * 16) * ldc + col0;
#pragma unroll
                for (int bj = 0; bj < 2; ++bj) { const f32x4 v0 = acc[ai][bj][m][0], v1 = acc[ai][bj][m][1]; u32x4 w;
                    w.x = cvt_pk_bf16(v0[0], v0[1]); w.y = cvt_pk_bf16(v0[2], v0[3]); w.z = cvt_pk_bf16(v1[0], v1[1]); w.w = cvt_pk_bf16(v1[2], v1[3]);
                    *(u32x4*)(rowp + bj * HALF) = w; } }
    }
};

struct EpiSwiglu {
    static constexpr bool PERM = true, AFTER_DRAIN = false;
    bf16_t* O; int ldo; const float* ssq;
    __device__ __forceinline__ void operator()(const f32x4 (&acc)[2][2][4][2], const Unit& u, int wr, int wc, int fr, int fq) const {
        const int row0 = u.pm * BM + wr * 64 + fr, col0 = u.pn * HALF + wc * 32 + 8 * fq;
        const __amdgpu_buffer_rsrc_t orsrc = __builtin_amdgcn_make_buffer_rsrc((void*)O, 0, 0x7FFFFFFF, 0x00020000);
        const unsigned ovoff = (unsigned)(row0 * ldo + col0) * 2u;
        float rsv[2][4];
        if (ssq) rows_rstd(rsv, ssq, row0, fq);
#pragma unroll
        for (int ai = 0; ai < 2; ++ai)
#pragma unroll
            for (int m = 0; m < 4; ++m) { const int row = row0 + ai * HALF + m * 16;
                const float rs = ssq ? rsv[ai][m] : 1.0f;
                const f32x4 g0 = acc[ai][0][m][0] * rs, g1 = acc[ai][0][m][1] * rs, u0 = acc[ai][1][m][0] * rs, u1 = acc[ai][1][m][1] * rs;
                u32x4 w;
                const f32x2 a0 = silu_mul_pk((f32x2){g0[0], g0[1]}, (f32x2){u0[0], u0[1]}), a1 = silu_mul_pk((f32x2){g0[2], g0[3]}, (f32x2){u0[2], u0[3]});
                const f32x2 a2 = silu_mul_pk((f32x2){g1[0], g1[1]}, (f32x2){u1[0], u1[1]}), a3 = silu_mul_pk((f32x2){g1[2], g1[3]}, (f32x2){u1[2], u1[3]});
                w.x = cvt_pk_bf16(a0.x, a0.y); w.y = cvt_pk_bf16(a1.x, a1.y); w.z = cvt_pk_bf16(a2.x, a2.y); w.w = cvt_pk_bf16(a3.x, a3.y);
                __builtin_amdgcn_raw_buffer_store_b128(w, orsrc, ovoff, (ai * HALF + m * 16) * ldo * 2, 0); }
    }
};

struct EpiResid {
    static constexpr bool PERM = true, AFTER_DRAIN = false;
    const float* bf; const bf16_t* bb; float alpha; float* of; bf16_t* ob; float* ssq;
    __device__ __forceinline__ void operator()(const f32x4 (&acc)[2][2][4][2], const Unit& u, int wr, int wc, int fr, int fq) const {
        const int row0 = u.pm * BM + wr * 64 + fr, col0 = u.pn * BM + wc * 32 + 8 * fq;
#pragma unroll
        for (int ai = 0; ai < 2; ++ai) {
            u32x4 pb[4][2];
            if (!bf) {
#pragma unroll
                for (int m = 0; m < 4; ++m)
#pragma unroll
                    for (int bj = 0; bj < 2; ++bj) pb[m][bj] = *(const u32x4*)(bb + (size_t)(row0 + ai * HALF + m * 16) * 1024 + col0 + bj * HALF);
            }
#pragma unroll
            for (int mp = 0; mp < 2; ++mp) {
                f32x4 pf[2][2][2];
                if (bf) {
#pragma unroll
                    for (int mm = 0; mm < 2; ++mm)
#pragma unroll
                        for (int bj = 0; bj < 2; ++bj)
#pragma unroll
                            for (int n = 0; n < 2; ++n) pf[mm][bj][n] = __builtin_nontemporal_load((const f32x4*)(bf + (size_t)(row0 + ai * HALF + (2 * mp + mm) * 16) * 1024 + col0 + bj * HALF + n * 4));
                }
#pragma unroll
                for (int mm = 0; mm < 2; ++mm) { const int m = 2 * mp + mm; const int row = row0 + ai * HALF + m * 16; const size_t off = (size_t)row * 1024 + col0; float ss = 0.f;
#pragma unroll
                    for (int bj = 0; bj < 2; ++bj) { const size_t o2 = off + bj * HALF; f32x4 o[2];
#pragma unroll
                        for (int n = 0; n < 2; ++n) { f32x4 bse;
                            if (bf) bse = pf[mm][bj][n];
                            else { const unsigned w0 = n ? pb[m][bj].z : pb[m][bj].x, w1 = n ? pb[m][bj].w : pb[m][bj].y;
                                bse[0] = __uint_as_float(w0 << 16); bse[1] = __uint_as_float(w0 & 0xffff0000u); bse[2] = __uint_as_float(w1 << 16); bse[3] = __uint_as_float(w1 & 0xffff0000u); }
                            o[n] = bse + acc[ai][bj][m][n] * alpha;
                            ss += (o[n][0] * o[n][0] + o[n][1] * o[n][1]) + (o[n][2] * o[n][2] + o[n][3] * o[n][3]); }
                        if (of) { __builtin_nontemporal_store(o[0], (f32x4*)(of + o2)); __builtin_nontemporal_store(o[1], (f32x4*)(of + o2 + 4)); }
                        if (ob) { u32x4 w; w.x = cvt_pk_bf16(o[0][0], o[0][1]); w.y = cvt_pk_bf16(o[0][2], o[0][3]); w.z = cvt_pk_bf16(o[1][0], o[1][1]); w.w = cvt_pk_bf16(o[1][2], o[1][3]); *(u32x4*)(ob + o2) = w; } }
                    if (ssq) { ss += __shfl_xor(ss, 16); ss += __shfl_xor(ss, 32); if (fq == 0) ssq[(size_t)row * 16 + u.pn * 4 + wc] = ss; } }
                asm volatile("" ::: "memory");
            }
        }
    }
};

struct EpiProjMain {
    static constexpr bool PERM = true, AFTER_DRAIN = false;
    const float* ssq; float* rstd_out; const float *qna, *kna, *qnb, *knb;
    bf16_t *QA, *QB, *KA, *KS, *KW, *KCR, *VCR; float* GT; float qscale; int seq, ntok;
    __device__ __forceinline__ void operator()(const f32x4 (&acc)[2][2][4][2], const Unit& u, int wr, int wc, int fr, int fq) const {
        const int H = 4 * u.pn + wc, row0 = u.pm * BM + wr * 64 + fr;
        const float* gain = nullptr; bf16_t* dst = nullptr; float sc = 1.0f; int nh = 2, hh = H & 1;
        if (H < 8) { gain = qna; dst = QA; sc = qscale; nh = 8; hh = H; }
        else if (H < 16) { gain = qnb; dst = QB; sc = qscale; nh = 8; hh = H - 8; }
        else if (H < 18) { gain = kna; dst = KA; }
        else if (H < 20) { gain = knb; dst = KS; }
        else if (H < 22) { gain = knb; dst = KW; }
        else if (H < 24) { dst = KCR; }
        else if (H < 26) { dst = VCR; }
        f32x4 gv[2][2];
#pragma unroll
        for (int bj = 0; bj < 2; ++bj)
#pragma unroll
            for (int n = 0; n < 2; ++n) gv[bj][n] = gain ? *(const f32x4*)(gain + 32 * bj + 8 * fq + 4 * n) * sc : (f32x4){1.f, 1.f, 1.f, 1.f};
        float rsv[2][4]; rows_rstd(rsv, ssq, row0, fq);
#pragma unroll
        for (int ai = 0; ai < 2; ++ai)
#pragma unroll
            for (int m = 0; m < 4; ++m) { const int row = row0 + ai * HALF + m * 16;
                const float rs = rsv[ai][m];
                if (H == 27) continue;
                if (H == 26) {
                    if (fq < 3) {
#pragma unroll
                        for (int n = 0; n < 2; ++n) { f32x4 gv4; const float nrs = -rs * kLog2e;
#pragma unroll
                            for (int i = 0; i < 4; ++i) gv4[i] = __builtin_amdgcn_rcpf(1.0f + __builtin_amdgcn_exp2f(acc[ai][0][m][n][i] * nrs));
                            *(f32x4*)(GT + (size_t)row * 32 + 8 * fq + 4 * n) = gv4; }
                    }
                    continue;
                }
                float f = rs;
                if (gain) { float ss = 0.f;
#pragma unroll
                    for (int bj = 0; bj < 2; ++bj)
#pragma unroll
                        for (int n = 0; n < 2; ++n) { const f32x4 q = acc[ai][bj][m][n]; ss += (q[0] * q[0] + q[1] * q[1]) + (q[2] * q[2] + q[3] * q[3]); }
                    ss += __shfl_xor(ss, 16); ss += __shfl_xor(ss, 32); f = rs * __builtin_amdgcn_rsqf(ss * (rs * rs) * (1.0f / 64.0f) + 1e-6f); }
                const int b = row / seq, s = row % seq;
                bf16_t* rowp = dst + ((size_t)(b * nh + hh) * seq + s) * 64 + 8 * fq;
#pragma unroll
                for (int bj = 0; bj < 2; ++bj) { const f32x4 v0 = acc[ai][bj][m][0] * gv[bj][0] * f, v1 = acc[ai][bj][m][1] * gv[bj][1] * f; u32x4 w;
                    w.x = cvt_pk_bf16(v0[0], v0[1]); w.y = cvt_pk_bf16(v0[2], v0[3]); w.z = cvt_pk_bf16(v1[0], v1[1]); w.w = cvt_pk_bf16(v1[2], v1[3]);
                    *(u32x4*)(rowp + 32 * bj) = w; } }
    }
};
struct EpiProjT {
    static constexpr bool PERM = true, AFTER_DRAIN = false;
    const float* ssq; bf16_t* VT0; size_t vstride; int seq;
    __device__ __forceinline__ void operator()(const f32x4 (&acc)[2][2][4][2], const Unit& u, int wr, int wc, int fr, int fq) const {
#pragma unroll
        for (int bj = 0; bj < 2; ++bj) { const int t0 = u.pn * BM + bj * HALF + wc * 32 + 8 * fq;
            float q8[8];
#pragma unroll
            for (int i = 0; i < 8; ++i) q8[i] = ssq[(size_t)(t0 + i) * 16 + fr];
#pragma unroll
            for (int i = 0; i < 8; ++i) { float q = q8[i]; q += __shfl_xor(q, 1); q += __shfl_xor(q, 2); q += __shfl_xor(q, 4); q += __shfl_xor(q, 8); q8[i] = __builtin_amdgcn_rsqf(q * (1.0f / 1024.0f) + 1e-6f); }
            const f32x4 r0 = {q8[0], q8[1], q8[2], q8[3]}, r1 = {q8[4], q8[5], q8[6], q8[7]};
            const int b = t0 / seq, s = t0 % seq;
#pragma unroll
            for (int ai = 0; ai < 2; ++ai) { const int vh = 4 * u.pm + 2 * ai + wr; if (vh >= 6) continue;
                bf16_t* dst = VT0 + (size_t)(vh >> 1) * vstride; const int g = vh & 1;
                bf16_t* blk = dst + ((size_t)(b * 2 + g) * (seq / 32) + (s >> 5)) * 2048 + (s & 31);
#pragma unroll
                for (int m = 0; m < 4; ++m) { const int d = 16 * m + fr; const f32x4 v0 = acc[ai][bj][m][0] * r0, v1 = acc[ai][bj][m][1] * r1; u32x4 w;
                    w.x = cvt_pk_bf16(v0[0], v0[1]); w.y = cvt_pk_bf16(v0[2], v0[3]); w.z = cvt_pk_bf16(v1[0], v1[1]); w.w = cvt_pk_bf16(v1[2], v1[3]);
                    { const auto s0 = __builtin_amdgcn_permlane16_swap(w.x, w.z, false, false), s1 = __builtin_amdgcn_permlane16_swap(w.y, w.w, false, false); w.x = s0[0]; w.z = s0[1]; w.y = s1[0]; w.w = s1[1]; }
                    *(u32x4*)(blk + d * 32) = w; } } }
    }
};
struct OneUnit {
    int pm, pn;
    __device__ __forceinline__ bool next(int i, Unit& u) const { if (i) return false; u.pm = pm; u.pn = pn; return true; }
    __device__ __forceinline__ void a_ready(const Unit&) const {}
    __device__ __forceinline__ void done(const Unit&) const {}
};
template <class Epi, class Sched, bool ALIGN_EPI = false, bool SP2 = false, bool AHALF = false>
__device__ __forceinline__ void gemm_phase(PG8_LAS unsigned char* lds, const Gemm g, const Sched& S, const Epi& E, int wv  ) {
    static_assert(!AHALF || SP2, "AHALF is written for the SP2 loop");
    const int wid = wv, lane = hw_lane_id(), tid = wid * 64 + lane, wr = wid >> 2, wc = wid & 3, fr = lane & 15, fq = lane >> 4;
    const int K = g.K, nt = K / BK;
    unsigned voffA[2], voffB[2];
#pragma unroll
    for (int i = 0; i < 2; ++i) { int R, C; stage_rc(tid * 16 + i * 8192, R, C); const int Rb = Epi::PERM ? ((R & ~31) + perm32(R & 31)) : R;
        voffA[i] = (unsigned)(R * K + C) * 2u; voffB[i] = (unsigned)(Rb * K + C) * 2u; }
    const size_t kstep = (size_t)(BK * 2);
    const size_t hstep = (size_t)HALF * K * 2;
    const size_t tstep = 2 * hstep;
    const unsigned ldsw = (unsigned)wid * 1024u;
    const int aoff = lds_byte(wr * 64 + fr, fq * 8), boff = lds_byte(wc * 32 + fr, fq * 8);
#define PG8_SA(b, h) (((b) * 2 + (h)) * HTB)
#define PG8_SB(b, h) ((4 + (b) * 2 + (h)) * HTB)
#define PG8_STAGE(bufoff, gbase, voff) do { _Pragma("unroll") for (int _i = 0; _i < 2; ++_i) \
        __builtin_amdgcn_global_load_lds((const unsigned*)((const char*)(gbase) + (voff)[_i]), (PG8_LAS unsigned*)(lds + (bufoff) + ldsw + _i * 8192), 16, 0, 0); } while (0)
#define PG8_LDA(dst, b, h) do { _Pragma("unroll") for (int m = 0; m < 4; ++m) _Pragma("unroll") for (int k = 0; k < 2; ++k) dst[m][k] = *(const PG8_LAS bf16x8*)(lds + PG8_SA(b, h) + aoff + m * 2048 + k * 1024); } while (0)
#define PG8_LDB(dst, b, h) do { _Pragma("unroll") for (int n = 0; n < 2; ++n) _Pragma("unroll") for (int k = 0; k < 2; ++k) dst[n][k] = *(const PG8_LAS bf16x8*)(lds + PG8_SB(b, h) + boff + n * 2048 + k * 1024); } while (0)
#define PG8_MMA(ai, bj, At, Bt) do { __builtin_amdgcn_s_setprio(1); _Pragma("unroll") for (int m = 0; m < 4; ++m) _Pragma("unroll") for (int n = 0; n < 2; ++n) _Pragma("unroll") for (int k = 0; k < 2; ++k) \
        acc[ai][bj][m][n] = __builtin_amdgcn_mfma_f32_16x16x32_bf16(Bt[n][k], At[m][k], acc[ai][bj][m][n], 0, 0, 0); __builtin_amdgcn_s_setprio(0); } while (0)
#define PG8_WAIT_V(n) asm volatile("s_waitcnt vmcnt(" #n ")" ::: "memory")
#define PG8_WAIT_L(n) asm volatile("s_waitcnt lgkmcnt(" #n ")" ::: "memory")
#define PG8_BAR __builtin_amdgcn_s_barrier()
#define PG8_SCHED __builtin_amdgcn_sched_barrier(0)
    Unit cur, nxt; int ui = 0;
    if (!S.next(0, cur)) return;
    f32x4 acc[2][2][4][2];
#pragma unroll
    for (int a = 0; a < 2; ++a)
#pragma unroll
        for (int b = 0; b < 2; ++b)
#pragma unroll
            for (int m = 0; m < 4; ++m)
#pragma unroll
                for (int n = 0; n < 2; ++n) acc[a][b][m][n] = (f32x4){0.f, 0.f, 0.f, 0.f};
    bf16x8 At[4][2], B0[2][2], B1[2][2];
    const char* cA = (const char*)g.A + (size_t)cur.pm * tstep; const char* cB = (const char*)g.Bt + (size_t)cur.pn * tstep;
    S.a_ready(cur);
    if constexpr (SP2) {
        PG8_STAGE(PG8_SB(0, 0), cB, voffB); PG8_STAGE(PG8_SB(0, 1), cB + hstep, voffB); PG8_STAGE(PG8_SA(0, 0), cA, voffA); PG8_STAGE(PG8_SA(0, 1), cA + hstep, voffA);
        if (wr == 1) PG8_BAR;
        PG8_WAIT_V(2); PG8_BAR;
        PG8_STAGE(PG8_SB(1, 0), cB + kstep, voffB); PG8_STAGE(PG8_SA(1, 0), cA + kstep, voffA); PG8_STAGE(PG8_SB(1, 1), cB + hstep + kstep, voffB);
        PG8_WAIT_V(6); PG8_BAR;
    } else {
        PG8_STAGE(PG8_SB(0, 0), cB, voffB); PG8_STAGE(PG8_SA(0, 0), cA, voffA); PG8_STAGE(PG8_SB(0, 1), cB + hstep, voffB); PG8_STAGE(PG8_SA(0, 1), cA + hstep, voffA);
        if (wr == 1) PG8_BAR;
        PG8_WAIT_V(4); PG8_BAR;
        PG8_STAGE(PG8_SB(1, 0), cB + kstep, voffB); PG8_STAGE(PG8_SA(1, 0), cA + kstep, voffA); PG8_STAGE(PG8_SB(1, 1), cB + hstep + kstep, voffB);
        PG8_WAIT_V(6); PG8_BAR;
    }
    for (;;) {
        const bool has_next = S.next(ui + 1, nxt);
        const char* nA = has_next ? (const char*)g.A + (size_t)nxt.pm * tstep : cA; const char* nB = has_next ? (const char*)g.Bt + (size_t)nxt.pn * tstep : cB;
        for (int t = 0; t < nt; t += 2) {
            const bool last = (t == nt - 2);
            const char* a1 = cA + (size_t)(t + 1) * kstep;
            const char* a2 = last ? nA : cA + (size_t)(t + 2) * kstep; const char* b2 = last ? nB : cB + (size_t)(t + 2) * kstep;
            const char* a3 = a2 + kstep; const char* b3 = b2 + kstep;
            if (last && has_next) S.a_ready(nxt);
            if constexpr (SP2) {
            PG8_LDB(B0, 0, 0); PG8_LDB(B1, 0, 1); PG8_SCHED; PG8_LDA(At, 0, 0); PG8_STAGE(PG8_SA(1, 1), a1 + hstep, voffA);
            PG8_WAIT_V(8); PG8_WAIT_L(0); PG8_BAR; PG8_MMA(0, 0, At, B0); PG8_MMA(0, 1, At, B1); PG8_BAR; PG8_SCHED;
            if constexpr (!AHALF) PG8_LDA(At, 0, 1);
            PG8_STAGE(PG8_SB(0, 0), b2, voffB); PG8_STAGE(PG8_SB(0, 1), b2 + hstep, voffB); PG8_STAGE(PG8_SA(0, 0), a2, voffA);
            PG8_WAIT_V(8); PG8_WAIT_L(0); PG8_BAR; if constexpr (!AHALF) { PG8_MMA(1, 0, At, B0); PG8_MMA(1, 1, At, B1); } PG8_BAR; PG8_SCHED;
            PG8_LDB(B0, 1, 0); PG8_LDB(B1, 1, 1); PG8_SCHED; PG8_LDA(At, 1, 0); PG8_STAGE(PG8_SA(0, 1), a2 + hstep, voffA);
            PG8_WAIT_V(8); PG8_WAIT_L(0); PG8_BAR; PG8_MMA(0, 0, At, B0); PG8_MMA(0, 1, At, B1); PG8_BAR; PG8_SCHED;
            if constexpr (!AHALF) PG8_LDA(At, 1, 1);
            PG8_STAGE(PG8_SB(1, 0), b3, voffB); PG8_STAGE(PG8_SB(1, 1), b3 + hstep, voffB); PG8_STAGE(PG8_SA(1, 0), a3, voffA);
            PG8_WAIT_V(8); PG8_WAIT_L(0); PG8_BAR; if constexpr (!AHALF) { PG8_MMA(1, 0, At, B0); PG8_MMA(1, 1, At, B1); } PG8_BAR; PG8_SCHED;
            } else {
            PG8_LDB(B0, 0, 0); PG8_SCHED; PG8_LDA(At, 0, 0); PG8_STAGE(PG8_SA(1, 1), a1 + hstep, voffA);
            PG8_WAIT_L(8); PG8_BAR; PG8_WAIT_L(0); PG8_MMA(0, 0, At, B0); PG8_BAR; PG8_SCHED;
            PG8_LDB(B1, 0, 1); PG8_STAGE(PG8_SB(0, 0), b2, voffB);
            PG8_BAR; PG8_WAIT_L(0); PG8_MMA(0, 1, At, B1); PG8_BAR;
            PG8_LDA(At, 0, 1); PG8_STAGE(PG8_SA(0, 0), a2, voffA);
            PG8_BAR; PG8_WAIT_L(0); PG8_MMA(1, 0, At, B0); PG8_BAR; PG8_SCHED;
            PG8_STAGE(PG8_SB(0, 1), b2 + hstep, voffB);
            PG8_WAIT_V(6); PG8_BAR; PG8_MMA(1, 1, At, B1); PG8_BAR;
            PG8_LDB(B0, 1, 0); PG8_SCHED; PG8_LDA(At, 1, 0); PG8_STAGE(PG8_SA(0, 1), a2 + hstep, voffA);
            PG8_WAIT_L(8); PG8_BAR; PG8_WAIT_L(0); PG8_MMA(0, 0, At, B0); PG8_BAR; PG8_SCHED;
            PG8_LDB(B1, 1, 1); PG8_STAGE(PG8_SB(1, 0), b3, voffB);
            PG8_BAR; PG8_WAIT_L(0); PG8_MMA(0, 1, At, B1); PG8_BAR;
            PG8_LDA(At, 1, 1); PG8_STAGE(PG8_SA(1, 0), a3, voffA);
            PG8_BAR; PG8_WAIT_L(0); PG8_MMA(1, 0, At, B0); PG8_BAR; PG8_SCHED;
            PG8_STAGE(PG8_SB(1, 1), b3 + hstep, voffB);
            PG8_WAIT_V(6); PG8_BAR; PG8_MMA(1, 1, At, B1); PG8_BAR;
            }
        }
        if constexpr (ALIGN_EPI) { if (wr == 0) PG8_BAR; }
        if constexpr (!Epi::AFTER_DRAIN) { E(acc, cur, wr, wc, fr, fq); S.done(cur); }
        if (!has_next) break;
#pragma unroll
        for (int a = 0; a < 2; ++a)
#pragma unroll
            for (int b = 0; b < 2; ++b)
#pragma unroll
                for (int m = 0; m < 4; ++m)
#pragma unroll
                    for (int n = 0; n < 2; ++n) acc[a][b][m][n] = (f32x4){0.f, 0.f, 0.f, 0.f};
        cur = nxt; cA = nA; cB = nB; ++ui;
        if constexpr (ALIGN_EPI) { if (wr == 1) PG8_BAR; }
    }
    PG8_WAIT_V(0);
    if constexpr (!ALIGN_EPI) { if (wr == 0) PG8_BAR; }
    PG8_BAR;
    if constexpr (Epi::AFTER_DRAIN) { E.fused(acc, cur, wr, wc, fr, fq, lds, wid, lane); S.done(cur); }
#undef PG8_SA
#undef PG8_SB
#undef PG8_STAGE
#undef PG8_LDA
#undef PG8_LDB
#undef PG8_MMA
#undef PG8_WAIT_V
#undef PG8_WAIT_L
#undef PG8_BAR
#undef PG8_SCHED
}
}
#define GAS __attribute__((address_space(1)))
#define LAS __attribute__((address_space(3)))
typedef unsigned short bf16;
typedef unsigned v4u __attribute__((ext_vector_type(4)));
typedef float f32x4 __attribute__((ext_vector_type(4)));
typedef short bf16x8 __attribute__((ext_vector_type(8)));
typedef GAS unsigned gu32;
typedef GAS unsigned long long gu64;
#define RLX_AGENT __ATOMIC_RELAXED, __HIP_MEMORY_SCOPE_AGENT
#define LDS_WAIT() asm volatile("s_waitcnt lgkmcnt(0)" ::: "memory")
#define VM_WAIT() asm volatile("s_waitcnt vmcnt(0)" ::: "memory")
__device__ __forceinline__ unsigned long long rt() { return __builtin_amdgcn_s_memrealtime(); }
__device__ __forceinline__ unsigned f2bf(float f) { unsigned u = __builtin_bit_cast(unsigned, f); return (u + 0x7fffu + ((u >> 16) & 1u)) >> 16; }
__device__ __forceinline__ unsigned pk2(float lo, float hi) { return f2bf(lo) | (f2bf(hi) << 16); }

#define XB_TMO      128
#define XB_XCNT(j)  (256  + 64 * (j))
#define XB_XSUB(j)  (1280 + 64 * (j))
#define XB_XGEN(j)  (2304 + 64 * (j))
#define XB_TOP      3328
#define XB_TOPGEN   3392
#define XCD_BAR_WORDS 3456
#define XB_SPIN_CAP (1u << 18)

__device__ __forceinline__ unsigned xb_ld(unsigned* p)              { return __hip_atomic_load(p, __ATOMIC_RELAXED, __HIP_MEMORY_SCOPE_AGENT); }
__device__ __forceinline__ unsigned xb_add(unsigned* p, unsigned v) { return __hip_atomic_fetch_add(p, v, __ATOMIC_RELAXED, __HIP_MEMORY_SCOPE_AGENT); }
__device__ __forceinline__ unsigned xb_xcc_id() { return (unsigned)__builtin_amdgcn_s_getreg((3 << 11) | 20) & 0xFu; }
#define XB_SPIN(cond, bar) do { unsigned _sp = 0; while (cond) { __builtin_amdgcn_s_sleep(1); \
    if ((++_sp & 255u) == 0u) { if (xb_ld(&(bar)[XB_TMO])) break; if (_sp > XB_SPIN_CAP) { atomicAdd(&(bar)[XB_TMO], 1u); break; } } } } while (0)

struct XcdBarrier {
    unsigned* bar; unsigned x;
    volatile LAS unsigned* st;
};

__device__ __forceinline__ XcdBarrier xcd_barrier_post(unsigned* bar, volatile LAS unsigned* st, bool leader  ) {
    XcdBarrier b; b.bar = bar; b.x = xb_xcc_id(); b.st = st;
    if (leader) (void)xb_add(&bar[XB_XCNT(b.x)], 1u);
    return b;
}
__device__ __forceinline__ void xcd_barrier_complete(unsigned* bar, unsigned x, unsigned& nloc, unsigned& nx) {
    const unsigned G = gridDim.x * gridDim.y * gridDim.z;
    unsigned sum, cnt, mine, sp = 0u;
    for (;;) {
        sum = 0u; cnt = 0u; mine = 0u;
#pragma unroll
        for (unsigned j = 0; j < 16; ++j) { const unsigned c = xb_ld(&bar[XB_XCNT(j)]); sum += c; cnt += (c > 0u) ? 1u : 0u; mine = (j == x) ? c : mine; }
        if (sum == G) break;
        __builtin_amdgcn_s_sleep(1);
        if ((++sp & 255u) == 0u) { if (xb_ld(&bar[XB_TMO])) break; if (sp > XB_SPIN_CAP) { atomicAdd(&bar[XB_TMO], 1u); break; } }
    }
    nloc = mine > 0u ? mine : 1u; nx = cnt > 0u ? cnt : 1u;
}

__device__ __forceinline__ void xcd_barrier(const XcdBarrier& b, bool leader  ) {
    asm volatile("s_waitcnt vmcnt(0)" ::: "memory");
    __syncthreads();
    if (leader) {
        unsigned* bar = b.bar;
        __builtin_amdgcn_s_waitcnt(0);
        unsigned nloc = b.st[0], nx = b.st[1];
        if (nloc == 0u) { xcd_barrier_complete(bar, b.x, nloc, nx); b.st[0] = nloc; b.st[1] = nx; }
        const unsigned old = xb_add(&bar[XB_XSUB(b.x)], 1u);
        const unsigned gen = old / nloc;
        if (old + 1u == (gen + 1u) * nloc) {
            __builtin_amdgcn_fence(__ATOMIC_RELEASE, "agent");
            asm volatile("s_waitcnt vmcnt(0)" ::: "memory");
            const unsigned og = xb_add(&bar[XB_TOP], 1u);
            const unsigned tg = og / nx;
            if (og + 1u == (tg + 1u) * nx) xb_add(&bar[XB_TOPGEN], 1u);
            else XB_SPIN(xb_ld(&bar[XB_TOPGEN]) == tg, bar);
            __builtin_amdgcn_fence(__ATOMIC_ACQUIRE, "agent");
            xb_add(&bar[XB_XGEN(b.x)], 1u);
            asm volatile("s_waitcnt vmcnt(0)" ::: "memory");
        } else {
            XB_SPIN(xb_ld(&bar[XB_XGEN(b.x)]) == gen, bar);
            __builtin_amdgcn_fence(__ATOMIC_ACQUIRE, "agent");
            asm volatile("s_waitcnt vmcnt(0)" ::: "memory");
        }
    }
    __syncthreads();
}

constexpr int NWAVES = 8;
constexpr int BATCH = 8, SEQ = 4096, DM = 1024, FF = 2816, T = BATCH * SEQ;
constexpr float EPS = 1e-6f;
constexpr float LOG2E = 1.4426950408889634f;
constexpr float QSCALE = 0.125f * LOG2E;
constexpr float NEGL = -1.0e9f * LOG2E;
constexpr int NMAIN = 1792;
constexpr int NPLAIN = 2304;

constexpr size_t MiB = 1u << 20, KiB = 1u << 10;
constexpr size_t WS_CTL = 0, CTL_ZERO_BYTES = 64 * KiB;
constexpr size_t WS_WIN1 = 2 * MiB, WS_WOUT1 = 13 * MiB, WS_WIN2 = 19 * MiB, WS_WOUT2 = 30 * MiB, WS_WMAIN = 36 * MiB, WS_WVT = 41 * MiB, WS_WMO = 42 * MiB;
constexpr size_t WS_W1T = 44 * MiB, WS_W2T = 45 * MiB, WS_POSB = 45 * MiB + 64 * KiB, WS_RSTD = 45 * MiB + 128 * KiB, WS_SSQ1 = 46 * MiB, WS_SSQ2 = 48 * MiB, WS_GT = 50 * MiB  , WS_KC = 54 * MiB, WS_VCT = 54 * MiB + 512 * KiB;
constexpr size_t WS_A = 56 * MiB;
constexpr size_t WS_ACT = 120 * MiB;
constexpr size_t WS_QA = 120 * MiB, WS_QB = 152 * MiB, WS_KA = 184 * MiB, WS_KCR = 192 * MiB, WS_VCR = 200 * MiB, WS_KS = 208 * MiB, WS_KW = 216 * MiB, WS_VAT = 224 * MiB, WS_VST = 232 * MiB, WS_VWT = 240 * MiB;
constexpr size_t WS_MIX = 296 * MiB;
constexpr size_t WS_PROJ = 360 * MiB;
constexpr size_t WS_END = 504 * MiB;
constexpr int CW_BAR = 4096;

constexpr int RING_OFF = 0, RING_BYTES = 131072;
constexpr int LDSCTL_OFF = RING_BYTES, MISC_OFF = LDSCTL_OFF + 320;
constexpr int LDS_BYTES = 147456;

typedef unsigned short bf16;
__device__ __forceinline__ float bf2f(bf16 v) { return __uint_as_float(((unsigned)v) << 16); }
__device__ __forceinline__ float wave_sum(float v) {
#pragma unroll
    for (int o = 1; o < 64; o <<= 1) v += __shfl_xor(v, o);
    return v;
}
__device__ __forceinline__ float wave_max(float v) {
#pragma unroll
    for (int o = 1; o < 64; o <<= 1) v = fmaxf(v, __shfl_xor(v, o));
    return v;
}
__device__ __forceinline__ int t5_bucket(int n) {
    if (n < 16) return n < 0 ? 0 : n;
    const int b = 16 + (int)(__log2f((float)n * 0.0625f) * (16.0f / 3.0f));
    return b > 31 ? 31 : b;
}
struct Frame {
    LAS unsigned char* lds; volatile LAS unsigned* MISC; gu32* ctl;
    int tid, lane, wave, vcu, G;
};

__global__ void __launch_bounds__(256) nv_rmsnorm(const float* x, const float* g, bf16* out) {
    const int lane = threadIdx.x & 63, row = blockIdx.x * 4 + (threadIdx.x >> 6);
    const f32x4* xr = (const f32x4*)(x + (size_t)row * DM) + lane; const f32x4* gr = (const f32x4*)g + lane;
    f32x4 v[4]; float s = 0.f;
#pragma unroll
    for (int j = 0; j < 4; ++j) { v[j] = xr[64 * j]; s += (v[j].x * v[j].x + v[j].y * v[j].y) + (v[j].z * v[j].z + v[j].w * v[j].w); }
    const float rstd = 1.0f / sqrtf(wave_sum(s) * (1.f / DM) + EPS);
    unsigned long long* o8 = (unsigned long long*)(out + (size_t)row * DM) + lane;
#pragma unroll
    for (int j = 0; j < 4; ++j) { const f32x4 gg = gr[64 * j]; o8[64 * j] = (unsigned long long)pk2(v[j].x * rstd * gg.x, v[j].y * rstd * gg.y) | ((unsigned long long)pk2(v[j].z * rstd * gg.z, v[j].w * rstd * gg.w) << 32); }
}

struct HeadPrep {
    const bf16* proj; const float* ssq;
    const float *qna, *kna, *qnb, *knb;
    bf16 *QA, *QB, *KA, *VAT, *KCR, *VCR, *KS, *VST, *KW, *VWT; float* GT;
};
__global__ void __launch_bounds__(256) nv_headprep(HeadPrep p) {
    const int lane = threadIdx.x & 63, t = blockIdx.x * 4 + (threadIdx.x >> 6), b = t / SEQ, s = t % SEQ;
    float rs = 1.0f;
    if (p.ssq) { float q = p.ssq[(size_t)t * 16 + (lane & 15)]; q += __shfl_xor(q, 1); q += __shfl_xor(q, 2); q += __shfl_xor(q, 4); q += __shfl_xor(q, 8); rs = 1.0f / sqrtf(q * (1.f / DM) + EPS); }
    const bf16* pr = p.proj + (size_t)t * NPLAIN;
    for (int H = 0; H < 32; ++H) {
        const float v = bf2f(pr[H * 64 + lane]) * rs;
        const float* gain = nullptr; float sc = 1.0f; bf16* dst; bool tr = false; int hh, nh;
        if (H < 8) { gain = p.qna; sc = QSCALE; dst = p.QA; hh = H; nh = 8; }
        else if (H < 10) { gain = p.kna; dst = p.KA; hh = H - 8; nh = 2; }
        else if (H < 12) { dst = p.VAT; hh = H - 10; nh = 2; tr = true; }
        else if (H < 20) { gain = p.qnb; sc = QSCALE; dst = p.QB; hh = H - 12; nh = 8; }
        else { const int slot = (H - 20) >> 1; hh = (H - 20) & 1; nh = 2;
            if (slot == 0) dst = p.KCR; else if (slot == 1) dst = p.VCR; else if (slot == 2) { dst = p.KS; gain = p.knb; } else if (slot == 3) { dst = p.VST; tr = true; } else if (slot == 4) { dst = p.KW; gain = p.knb; } else { dst = p.VWT; tr = true; } }
        float y = v;
        if (gain) { const float ss = wave_sum(v * v); y = v * (1.0f / sqrtf(ss * (1.f / 64.f) + EPS)) * gain[lane] * sc; }
        if (!tr) dst[((size_t)(b * nh + hh) * SEQ + s) * 64 + lane] = (bf16)f2bf(y);
        else dst[(((size_t)(b * nh + hh) * (SEQ / 32) + (s >> 5)) * 64 + lane) * 32 + (s & 31)] = (bf16)f2bf(y);
    }
    if (lane < 24) { const float v = bf2f(pr[2048 + lane]) * rs; p.GT[(size_t)t * 32 + lane] = 1.0f / (1.0f + __expf(-v)); }
}

__global__ void __launch_bounds__(128) nv_compress(const bf16* KCR, const bf16* VCR, const float* pos, const float* w1, const float* b1, const float* w2, const float* b2, const float* knb, bf16* KC, bf16* VCT) {
    __shared__ float sh[128];
    const int tid = threadIdx.x; int idx = blockIdx.x; const int c = idx & 255; idx >>= 8; const int g = idx & 1, b = (idx >> 1) & 7, kv = idx >> 4;
    if (c == 255) { if (tid < 64) { if (kv == 0) KC[((size_t)(b * 2 + g) * 256 + c) * 64 + tid] = 0; else VCT[(((size_t)(b * 2 + g) * 8 + (c >> 5)) * 64 + tid) * 32 + (c & 31)] = 0; } return; }
    const bf16* raw = (kv == 0 ? KCR : VCR) + ((size_t)(b * 2 + g) * SEQ + 16 * c) * 64;
    float acc = b1[kv * 128 + tid];
    for (int k = 0; k < 2048; ++k) acc += (bf2f(raw[k]) + pos[kv * 2048 + k]) * w1[((size_t)kv * 2048 + k) * 128 + tid];
    sh[tid] = acc / (1.0f + __expf(-acc));
    __syncthreads();
    if (tid < 64) {
        float o = b2[kv * 64 + tid];
        for (int h = 0; h < 128; ++h) o += sh[h] * w2[((size_t)kv * 128 + h) * 64 + tid];
        if (kv == 0) { const float ss = wave_sum(o * o); const float y = o * (1.0f / sqrtf(ss * (1.f / 64.f) + EPS)) * knb[tid]; KC[((size_t)(b * 2 + g) * 256 + c) * 64 + tid] = (bf16)f2bf(y); }
        else VCT[(((size_t)(b * 2 + g) * 8 + (c >> 5)) * 64 + tid) * 32 + (c & 31)] = (bf16)f2bf(o);
    }
}

__device__ __forceinline__ float vt_at(const bf16* VT, int bg, int nblk, int key, int d) { return bf2f(VT[(((size_t)bg * nblk + (key >> 5)) * 64 + d) * 32 + (key & 31)]); }

__global__ void __launch_bounds__(256) nv_band_a(const bf16* QA, const bf16* KA, const bf16* VAT, const float* tbl, const float* sinks, bf16* mix) {
    __shared__ float sq[4][64], sl[4][128];
    const int lane = threadIdx.x & 63, w = threadIdx.x >> 6; const int s = blockIdx.x % SEQ, bg = blockIdx.x / SEQ, g = bg & 1, b = bg >> 1, head = g * 4 + w;
    sq[w][lane] = bf2f(QA[((size_t)(b * 8 + head) * SEQ + s) * 64 + lane]);
    __syncthreads();
    float lg[2];
#pragma unroll
    for (int j = 0; j < 2; ++j) { const int rel = 64 * j + lane, key = s - rel; float v = NEGL;
        if (key >= 0) { const bf16* kr = KA + ((size_t)bg * SEQ + key) * 64; float dot = 0.f; for (int d = 0; d < 64; ++d) dot += sq[w][d] * bf2f(kr[d]); v = dot + tbl[t5_bucket(rel) * 16 + head] * LOG2E; }
        lg[j] = v; }
    const float sk = sinks[head] * LOG2E;
    const float m = fmaxf(wave_max(fmaxf(lg[0], lg[1])), sk);
    const float p0 = exp2f(lg[0] - m), p1 = exp2f(lg[1] - m);
    const float sum = wave_sum(p0 + p1) + exp2f(sk - m);
    sl[w][lane] = p0; sl[w][64 + lane] = p1;
    __syncthreads();
    float o = 0.f;
    for (int rel = 0; rel < 128; ++rel) { const int key = s - rel; if (key >= 0) o += sl[w][rel] * vt_at(VAT, bg, SEQ / 32, key, lane); }
    mix[(size_t)(b * SEQ + s) * 1024 + head * 64 + lane] = (bf16)f2bf(o / sum);
}

__global__ void __launch_bounds__(256) nv_nsa(const bf16* QB, const bf16* KC, const bf16* VCT, const bf16* KS, const bf16* VST, const bf16* KW, const bf16* VWT, const float* GT, const float* tbl, bf16* mix) {
    __shared__ float sq[4][64], sP[4][256], sL[4][1024]; __shared__ unsigned long long smask;
    const int lane = threadIdx.x & 63, w = threadIdx.x >> 6; const int s = blockIdx.x % SEQ, bg = blockIdx.x / SEQ, g = bg & 1, b = bg >> 1, head = g * 4 + w, tc = 8 + head;
    const int t = b * SEQ + s;
    sq[w][lane] = bf2f(QB[((size_t)(b * 8 + head) * SEQ + s) * 64 + lane]);
    __syncthreads();
    const int ncv = s >= 31 ? ((s - 31) / 16 + 1 > 255 ? 255 : (s - 31) / 16 + 1) : 0;
    float lc[4];
#pragma unroll
    for (int j = 0; j < 4; ++j) { const int c = lane + 64 * j; float v = NEGL;
        if (c < ncv) { const bf16* kr = KC + ((size_t)bg * 256 + c) * 64; float dot = 0.f; for (int d = 0; d < 64; ++d) dot += sq[w][d] * bf2f(kr[d]); v = dot + tbl[t5_bucket(s - (16 * c + 31)) * 16 + tc] * LOG2E; }
        lc[j] = v; }
    {
        const float m = wave_max(fmaxf(fmaxf(lc[0], lc[1]), fmaxf(lc[2], lc[3])));
        float p[4]; float ps = 0.f;
#pragma unroll
        for (int j = 0; j < 4; ++j) { p[j] = (lane + 64 * j < ncv) ? exp2f(lc[j] - m) : 0.f; ps += p[j]; }
        const float inv = 1.0f / fmaxf(wave_sum(ps), 1.1754944e-38f);
#pragma unroll
        for (int j = 0; j < 4; ++j) sP[w][lane + 64 * j] = p[j] * inv;
    }
    __syncthreads();
    float o_cmp = 0.f;
    for (int c = 0; c < ncv; ++c) o_cmp += sP[w][c] * vt_at(VCT, bg, 8, c, lane);
    if (w == 0) {
        const int n = lane, cur = s >> 6; float imp = 0.f;
        for (int c = 4 * n - 1; c <= 4 * n + 3; ++c) if (c >= 0 && c < 255) imp += (sP[0][c] + sP[1][c]) + (sP[2][c] + sP[3][c]);
        const bool valid = n <= cur, forced = (n == 0) || (n == cur) || (n == cur - 1);
        const float score = valid ? imp + (forced ? 1000.0f : 0.0f) : -1.0e9f;
        int rank = 0;
        for (int mm = 0; mm < 64; ++mm) { const float sm = __shfl(score, mm); rank += (sm > score || (sm == score && mm < n)) ? 1 : 0; }
        const unsigned long long mk = __ballot(valid && rank < 16);
        if (lane == 0) smask = mk;
    }
    __syncthreads();
    const unsigned long long mask = smask;
    float o_sel = 0.f;
    {
        int cnt = 0; float mx = NEGL;
        for (int n = 0; n < 64; ++n) if ((mask >> n) & 1ull) { const int key = 64 * n + lane, rel = s - key; float v = NEGL;
            if (rel >= 0) { const bf16* kr = KS + ((size_t)bg * SEQ + key) * 64; float dot = 0.f; for (int d = 0; d < 64; ++d) dot += sq[w][d] * bf2f(kr[d]); v = dot + tbl[t5_bucket(rel) * 16 + tc] * LOG2E; }
            sL[w][cnt * 64 + lane] = v; mx = fmaxf(mx, v); ++cnt; }
        mx = wave_max(mx); float ps = 0.f;
        for (int i = 0; i < cnt; ++i) { const float p = exp2f(sL[w][i * 64 + lane] - mx); sL[w][i * 64 + lane] = p; ps += p; }
        ps = wave_sum(ps);
        __syncthreads();
        int i = 0;
        for (int n = 0; n < 64; ++n) if ((mask >> n) & 1ull) { for (int k = 0; k < 64; ++k) { const int key = 64 * n + k; if (key <= s) o_sel += sL[w][i * 64 + k] * vt_at(VST, bg, SEQ / 32, key, lane); } ++i; }
        o_sel /= ps;
        __syncthreads();
    }
    float o_win = 0.f;
    {
        float mx = NEGL;
        for (int j = 0; j < 8; ++j) { const int rel = 64 * j + lane, key = s - rel; float v = NEGL;
            if (key >= 0) { const bf16* kr = KW + ((size_t)bg * SEQ + key) * 64; float dot = 0.f; for (int d = 0; d < 64; ++d) dot += sq[w][d] * bf2f(kr[d]); v = dot + tbl[t5_bucket(rel) * 16 + tc] * LOG2E; }
            sL[w][rel] = v; mx = fmaxf(mx, v); }
        mx = wave_max(mx); float ps = 0.f;
        for (int j = 0; j < 8; ++j) { const float p = exp2f(sL[w][64 * j + lane] - mx); sL[w][64 * j + lane] = p; ps += p; }
        ps = wave_sum(ps);
        __syncthreads();
        for (int rel = 0; rel < 512; ++rel) { const int key = s - rel; if (key >= 0) o_win += sL[w][rel] * vt_at(VWT, bg, SEQ / 32, key, lane); }
        o_win /= ps;
    }
    const float g0 = GT[(size_t)t * 32 + 0 * 8 + head], g1 = GT[(size_t)t * 32 + 1 * 8 + head], g2 = GT[(size_t)t * 32 + 2 * 8 + head];
    mix[(size_t)t * 1024 + 512 + head * 64 + lane] = (bf16)f2bf(g0 * o_cmp + g1 * o_sel + g2 * o_win);
}

typedef float f32x16 __attribute__((ext_vector_type(16)));
typedef short s16x4 __attribute__((ext_vector_type(4)));
typedef unsigned u32x4v __attribute__((ext_vector_type(4)));
typedef unsigned u32x2v __attribute__((ext_vector_type(2)));
constexpr int LA = 296, OFFA = 231;
constexpr int LB = 680, OFFB = 615;
constexpr int ATT_LUTA_OFF = 0, ATT_LUTB_OFF = 8 * LA * 4, ATT_WSCR_OFF = ATT_LUTB_OFF + 8 * LB * 4, ATT_WSCR_BYTES = 4096;
static_assert(ATT_WSCR_OFF % 16 == 0 && ATT_WSCR_OFF + 8 * ATT_WSCR_BYTES <= RING_BYTES, "attention LDS map");

struct AttP { const bf16 *QA, *QB, *KA, *VAT, *KC, *VCT, *KS, *VST, *KW, *VWT; const float* GT; bf16* mix; };

__device__ __forceinline__ float xhalf_max(float v) { auto rr = __builtin_amdgcn_permlane32_swap(__float_as_uint(v), __float_as_uint(v), false, false); return fmaxf(__uint_as_float(rr[0]), __uint_as_float(rr[1])); }
__device__ __forceinline__ float xhalf_sum(float v) { auto rr = __builtin_amdgcn_permlane32_swap(__float_as_uint(v), __float_as_uint(v), false, false); return __uint_as_float(rr[0]) + __uint_as_float(rr[1]); }
__device__ __forceinline__ float quad_sum(float v) {
    v += __int_as_float(__builtin_amdgcn_mov_dpp(__float_as_int(v), 0xB1, 0xF, 0xF, true));
    v += __int_as_float(__builtin_amdgcn_mov_dpp(__float_as_int(v), 0x4E, 0xF, 0xF, true));
    return v;
}
__device__ __forceinline__ unsigned pkbf(float lo, float hi) { typedef float f2 __attribute__((ext_vector_type(2))); typedef __bf16 b2 __attribute__((ext_vector_type(2))); f2 v = {lo, hi}; b2 b = __builtin_convertvector(v, b2); return __builtin_bit_cast(unsigned, b); }

struct KFrag { bf16x8 k[4]; };
struct VFrag { bf16x8 v[2][2]; };
__device__ __forceinline__ f32x16 qk_tile(const KFrag& kf, const bf16x8 (&qf)[4], f32x16 c) {
#pragma unroll
    for (int s4 = 0; s4 < 4; ++s4) c = __builtin_amdgcn_mfma_f32_32x32x16_bf16(kf.k[s4], qf[s4], c, 0, 0, 0);
    return c;
}
#define ROFF(r) (((r) & 3) + 8 * ((r) >> 2))
__device__ __forceinline__ void store_o(bf16* rowp, const f32x16& r0, const f32x16& r1, int half) {
#pragma unroll
    for (int i = 0; i < 4; ++i) {
        u32x2v w; w.x = pkbf(r0[4 * i], r0[4 * i + 1]); w.y = pkbf(r0[4 * i + 2], r0[4 * i + 3]); *(u32x2v*)(rowp + 8 * i + 4 * half) = w;
        u32x2v z; z.x = pkbf(r1[4 * i], r1[4 * i + 1]); z.y = pkbf(r1[4 * i + 2], r1[4 * i + 3]); *(u32x2v*)(rowp + 32 + 8 * i + 4 * half) = z; }
}

__device__ __forceinline__ void store_o_rows(LAS unsigned char* scr, bf16* base  , const f32x16& r0, const f32x16& r1, int lane) {
    const int col = lane & 31, half = lane >> 5, ql = col >> 2, hd = col & 3, sx = (ql + 4 * (hd >> 1)) & 7;
    LAS unsigned char* wp = scr + ql * 512 + hd * 128 + half * 8;
#pragma unroll
    for (int i = 0; i < 4; ++i) {
        u32x2v w; w.x = pkbf(r0[4 * i], r0[4 * i + 1]); w.y = pkbf(r0[4 * i + 2], r0[4 * i + 3]); *(LAS u32x2v*)(wp + ((i ^ sx) << 4)) = w;
        u32x2v z; z.x = pkbf(r1[4 * i], r1[4 * i + 1]); z.y = pkbf(r1[4 * i + 2], r1[4 * i + 3]); *(LAS u32x2v*)(wp + (((4 + i) ^ sx) << 4)) = z; }
    const int c = lane & 31;
#pragma unroll
    for (int j = 0; j < 4; ++j) { const int row = 2 * j + (lane >> 5), pc = (c & 24) | ((c & 7) ^ ((row + 4 * (c >> 4)) & 7));
        const u32x4v v = *(const LAS u32x4v*)(scr + row * 512 + pc * 16);
        *(u32x4v*)(base + (size_t)row * 1024 + c * 8) = v; }
}

__device__ __forceinline__ void cmp_unit(Frame& F, int u, const bf16* KCR, const bf16* VCR, const bf16* W1T, const bf16* W2T, const float* posb, const float* b2, const float* knb, bf16* KC, bf16* VCT) {
    const int kv = u >> 7, bg = (u >> 3) & 15, strip = u & 7, lane = F.lane, w = F.wave, col = lane & 31, half = lane >> 5;
    const bf16* raw = (kv ? VCR : KCR) + ((size_t)bg * SEQ + 16 * (32 * strip + col)) * 64;
    const bf16* w1 = W1T + (size_t)kv * 128 * 2048;
    f32x16 acc[4];
#pragma unroll
    for (int nt = 0; nt < 4; ++nt)
#pragma unroll
        for (int r = 0; r < 16; ++r) acc[nt][r] = 0.f;
    const int kb = 256 * w;
#pragma unroll 8
    for (int s = 0; s < 16; ++s) { const int k = kb + 16 * s + 8 * half;
        const bf16x8 a = *(const bf16x8*)(raw + k);
#pragma unroll
        for (int nt = 0; nt < 4; ++nt) { const bf16x8 bb = *(const bf16x8*)(w1 + ((size_t)((16 * w + s) * 4 + nt) * 64 + lane) * 8); acc[nt] = __builtin_amdgcn_mfma_f32_32x32x16_bf16(a, bb, acc[nt], 0, 0, 0); } }
    LAS float* part = (LAS float*)(F.lds + RING_OFF);
#pragma unroll
    for (int nt = 0; nt < 4; ++nt)
#pragma unroll
        for (int r = 0; r < 16; ++r) part[w * 4096 + (ROFF(r) + 4 * half) * 128 + 32 * nt + col] = acc[nt][r];
    __syncthreads();
    float hv[8];
#pragma unroll
    for (int j = 0; j < 8; ++j) { const int e = F.tid + 512 * j; float sacc = posb[kv * 128 + (e & 127)];
#pragma unroll
        for (int ww = 0; ww < 8; ++ww) sacc += part[ww * 4096 + e];
        hv[j] = sacc * __builtin_amdgcn_rcpf(1.0f + __builtin_amdgcn_exp2f(-sacc * LOG2E)); }
    __syncthreads();
    LAS bf16* hid = (LAS bf16*)(F.lds + RING_OFF);
#pragma unroll
    for (int j = 0; j < 8; ++j) hid[F.tid + 512 * j] = (bf16)f2bf(hv[j]);
    __syncthreads();
    if (w == 0) {
        f32x16 o[2];
#pragma unroll
        for (int nt = 0; nt < 2; ++nt)
#pragma unroll
            for (int r = 0; r < 16; ++r) o[nt][r] = 0.f;
        const bf16* w2 = W2T + (size_t)kv * 64 * 128;
#pragma unroll
        for (int s = 0; s < 8; ++s) { const bf16x8 a = *(const LAS bf16x8*)(hid + col * 128 + 16 * s + 8 * half);
#pragma unroll
            for (int nt = 0; nt < 2; ++nt) { const bf16x8 bb = *(const bf16x8*)(w2 + (32 * nt + col) * 128 + 16 * s + 8 * half); o[nt] = __builtin_amdgcn_mfma_f32_32x32x16_bf16(a, bb, o[nt], 0, 0, 0); } }
        const float bi0 = b2[kv * 64 + col], bi1 = b2[kv * 64 + 32 + col];
        if (kv == 0) {
            const float k0 = knb[col], k1 = knb[32 + col];
#pragma unroll
            for (int r = 0; r < 16; ++r) { const float v0 = o[0][r] + bi0, v1 = o[1][r] + bi1; float ss = v0 * v0 + v1 * v1;
                ss += __shfl_xor(ss, 1); ss += __shfl_xor(ss, 2); ss += __shfl_xor(ss, 4); ss += __shfl_xor(ss, 8); ss += __shfl_xor(ss, 16);
                const float f = __builtin_amdgcn_rsqf(ss * (1.0f / 64.0f) + EPS); const int c = 32 * strip + ROFF(r) + 4 * half; const bool z = (c == 255);
                bf16* kp = KC + ((size_t)bg * 256 + c) * 64;
                kp[col] = z ? (bf16)0 : (bf16)f2bf(v0 * f * k0); kp[32 + col] = z ? (bf16)0 : (bf16)f2bf(v1 * f * k1); }
        } else {
#pragma unroll
            for (int nt = 0; nt < 2; ++nt) { const float bi = nt ? bi1 : bi0;
#pragma unroll
                for (int i = 0; i < 4; ++i) { const int cl = 8 * i + 4 * half; const bool zl = (32 * strip + cl + 3 == 255);
                    const int pos = 8 * (2 * (i >> 1) + half) + 4 * (i & 1);
                    u32x2v wv; wv.x = pkbf(o[nt][4 * i] + bi, o[nt][4 * i + 1] + bi); wv.y = pkbf(o[nt][4 * i + 2] + bi, zl ? 0.f : o[nt][4 * i + 3] + bi);
                    *(u32x2v*)(VCT + (((size_t)bg * 8 + strip) * 64 + 32 * nt + col) * 32 + pos) = wv; } }
        }
    }
    __syncthreads();
}

__device__ __forceinline__ void cmp_unit2(Frame& F, int u, const bf16* KCR, const bf16* VCR, const bf16* W1T, const bf16* W2T, const float* posb, const float* b2, const float* knb, bf16* KC, bf16* VCT) {
    const int kv = u >> 7, bg = (u >> 3) & 15, strip0 = u & 7, lane = F.lane, w = F.wave, col = lane & 31, half = lane >> 5;
    const bf16* raw = (kv ? VCR : KCR) + ((size_t)bg * SEQ + 16 * (32 * strip0 + col)) * 64;
    const bf16* w1 = W1T + (size_t)kv * 128 * 2048;
    f32x16 acc2[2][4];
#pragma unroll
    for (int hh = 0; hh < 2; ++hh)
#pragma unroll
    for (int nt = 0; nt < 4; ++nt)
#pragma unroll
        for (int r = 0; r < 16; ++r) acc2[hh][nt][r] = 0.f;
    const int kb = 256 * w;
#pragma unroll 4
    for (int s = 0; s < 16; ++s) { const int k = kb + 16 * s + 8 * half;
        const bf16x8 a0 = *(const bf16x8*)(raw + k), a1 = *(const bf16x8*)(raw + 32 * 16 * 64 + k);
#pragma unroll
        for (int nt = 0; nt < 4; ++nt) { const bf16x8 bb = *(const bf16x8*)(w1 + ((size_t)((16 * w + s) * 4 + nt) * 64 + lane) * 8);
            acc2[0][nt] = __builtin_amdgcn_mfma_f32_32x32x16_bf16(a0, bb, acc2[0][nt], 0, 0, 0); acc2[1][nt] = __builtin_amdgcn_mfma_f32_32x32x16_bf16(a1, bb, acc2[1][nt], 0, 0, 0); } }
#pragma unroll
    for (int hh = 0; hh < 2; ++hh) { const int strip = strip0 + hh; f32x16 (&acc)[4] = acc2[hh];
    LAS float* part = (LAS float*)(F.lds + RING_OFF);
#pragma unroll
    for (int nt = 0; nt < 4; ++nt)
#pragma unroll
        for (int r = 0; r < 16; ++r) part[w * 4096 + (ROFF(r) + 4 * half) * 128 + 32 * nt + col] = acc[nt][r];
    __syncthreads();
    float hv[8];
#pragma unroll
    for (int j = 0; j < 8; ++j) { const int e = F.tid + 512 * j; float sacc = posb[kv * 128 + (e & 127)];
#pragma unroll
        for (int ww = 0; ww < 8; ++ww) sacc += part[ww * 4096 + e];
        hv[j] = sacc * __builtin_amdgcn_rcpf(1.0f + __builtin_amdgcn_exp2f(-sacc * LOG2E)); }
    __syncthreads();
    LAS bf16* hid = (LAS bf16*)(F.lds + RING_OFF);
#pragma unroll
    for (int j = 0; j < 8; ++j) hid[F.tid + 512 * j] = (bf16)f2bf(hv[j]);
    __syncthreads();
    if (w == 0) {
        f32x16 o[2];
#pragma unroll
        for (int nt = 0; nt < 2; ++nt)
#pragma unroll
            for (int r = 0; r < 16; ++r) o[nt][r] = 0.f;
        const bf16* w2 = W2T + (size_t)kv * 64 * 128;
#pragma unroll
        for (int s = 0; s < 8; ++s) { const bf16x8 a = *(const LAS bf16x8*)(hid + col * 128 + 16 * s + 8 * half);
#pragma unroll
            for (int nt = 0; nt < 2; ++nt) { const bf16x8 bb = *(const bf16x8*)(w2 + (32 * nt + col) * 128 + 16 * s + 8 * half); o[nt] = __builtin_amdgcn_mfma_f32_32x32x16_bf16(a, bb, o[nt], 0, 0, 0); } }
        const float bi0 = b2[kv * 64 + col], bi1 = b2[kv * 64 + 32 + col];
        if (kv == 0) {
            const float k0 = knb[col], k1 = knb[32 + col];
#pragma unroll
            for (int r = 0; r < 16; ++r) { const float v0 = o[0][r] + bi0, v1 = o[1][r] + bi1; float ss = v0 * v0 + v1 * v1;
                ss += __shfl_xor(ss, 1); ss += __shfl_xor(ss, 2); ss += __shfl_xor(ss, 4); ss += __shfl_xor(ss, 8); ss += __shfl_xor(ss, 16);
                const float f = __builtin_amdgcn_rsqf(ss * (1.0f / 64.0f) + EPS); const int c = 32 * strip + ROFF(r) + 4 * half; const bool z = (c == 255);
                bf16* kp = KC + ((size_t)bg * 256 + c) * 64;
                kp[col] = z ? (bf16)0 : (bf16)f2bf(v0 * f * k0); kp[32 + col] = z ? (bf16)0 : (bf16)f2bf(v1 * f * k1); }
        } else {
#pragma unroll
            for (int nt = 0; nt < 2; ++nt) { const float bi = nt ? bi1 : bi0;
#pragma unroll
                for (int i = 0; i < 4; ++i) { const int cl = 8 * i + 4 * half; const bool zl = (32 * strip + cl + 3 == 255);
                    const int pos = 8 * (2 * (i >> 1) + half) + 4 * (i & 1);
                    u32x2v wv; wv.x = pkbf(o[nt][4 * i] + bi, o[nt][4 * i + 1] + bi); wv.y = pkbf(o[nt][4 * i + 2] + bi, zl ? 0.f : o[nt][4 * i + 3] + bi);
                    *(u32x2v*)(VCT + (((size_t)bg * 8 + strip) * 64 + 32 * nt + col) * 32 + pos) = wv; } }
        }
    }
    __syncthreads();
    }
}

constexpr int ATT2_KV_OFF = 65536;
static_assert(ATT_WSCR_OFF + 8 * ATT_WSCR_BYTES <= ATT2_KV_OFF && ATT2_KV_OFF + 65536 <= RING_BYTES, "attention-2 LDS map");
constexpr float ATT_THR = 6.0f;

__device__ __forceinline__ unsigned stage_goff(int tid) {
    const int t = tid & 255, key = 8 * (t >> 6) + ((t & 15) >> 1), c = 2 * ((t >> 4) & 3) + (t & 1);
    const int row = 16 * (t >> 6) + 8 * ((t >> 5) & 1) + ((t & 15) >> 1), p = 2 * ((t >> 4) & 1) + (t & 1);
    return __builtin_amdgcn_readfirstlane(tid) < 256 ? (unsigned)(key * 128 + c * 16) : (unsigned)(row * 64 + p * 16);
}
__device__ __forceinline__ u32x4v tile_load(const bf16* Kt, const bf16* Vt, int tid) {
    const bool isk = __builtin_amdgcn_readfirstlane(tid) < 256;
    const char* sbase = (const char*)(isk ? Kt : Vt);
    return *(const u32x4v*)(sbase + stage_goff(tid));
}
__device__ __forceinline__ unsigned stage_loff(int tid) {
    const int t = tid & 255;
    if (__builtin_amdgcn_readfirstlane(tid) < 256) { const int key = 8 * (t >> 6) + ((t & 15) >> 1), c = 2 * ((t >> 4) & 3) + (t & 1);
        return (unsigned)((c >> 1) * 1024 + key * 32 + (((c & 1) ^ ((key >> 3) & 1)) << 4)); }
    const int row = 16 * (t >> 6) + 8 * ((t >> 5) & 1) + ((t & 15) >> 1), p = 2 * ((t >> 4) & 1) + (t & 1);
    return (unsigned)(4096 + (p >> 1) * 2048 + row * 32 + (((p & 1) ^ ((row >> 3) & 1)) << 4));
}
__device__ __forceinline__ void tile_store(LAS unsigned char* buf, u32x4v v, unsigned so) { *(LAS u32x4v*)(buf + so) = v; }
__device__ __forceinline__ __amdgpu_buffer_rsrc_t stage_rsrc(const bf16* Kb, const bf16* Vb, int tid) {
    const bool isk = __builtin_amdgcn_readfirstlane(tid) < 256;
    return __builtin_amdgcn_make_buffer_rsrc((void*)(isk ? Kb : Vb), 0, 0x7FFFFFFF, 0x00020000);
}
__device__ __forceinline__ void pair_load(__amdgpu_buffer_rsrc_t rs, int kt, unsigned loff, u32x4v& a, u32x4v& b) {
    a = __builtin_amdgcn_raw_buffer_load_b128(rs, loff, kt * 4096, 0); b = __builtin_amdgcn_raw_buffer_load_b128(rs, loff, kt * 4096 + 4096, 0);
}
__device__ __forceinline__ void pair_store(LAS unsigned char* buf, const u32x4v& a, const u32x4v& b, unsigned so) { tile_store(buf, a, so); tile_store(buf + 8192, b, so); }
__device__ __forceinline__ int frag_off(int r, int half) { return r * 32 + ((half ^ ((r >> 3) & 1)) << 4); }
__device__ __forceinline__ void lds_k(KFrag& f, const LAS unsigned char* buf, int r, int half) {
    const LAS unsigned char* p = buf + frag_off(r, half);
#pragma unroll
    for (int s4 = 0; s4 < 4; ++s4) f.k[s4] = *(const LAS bf16x8*)(p + s4 * 1024);
}
__device__ __forceinline__ void lds_v(VFrag& f, const LAS unsigned char* buf, int r, int half) {
    const LAS unsigned char* p = buf + 4096 + frag_off(r, half);
#pragma unroll
    for (int dt = 0; dt < 2; ++dt)
#pragma unroll
        for (int s2 = 0; s2 < 2; ++s2) f.v[dt][s2] = *(const LAS bf16x8*)(p + s2 * 2048 + dt * 1024);
}
typedef float f32x2s __attribute__((ext_vector_type(2)));
struct Soft2 { f32x16 o0, o1, lv; float m; f32x2s lf; };
__device__ __forceinline__ void soft2_init(Soft2& st, float m0, float l0) {
#pragma unroll
    for (int r = 0; r < 16; ++r) { st.o0[r] = 0.f; st.o1[r] = 0.f; st.lv[r] = l0; }
    st.m = m0; st.lf = (f32x2s){0.f, 0.f};
}
__device__ __forceinline__ void soft2_acc(f32x16& r0, f32x16& r1, const Soft2& st, float scale) {
    const float f = scale * __builtin_amdgcn_rcpf(fmaxf(st.lv[0], 1.1754944e-38f));
#pragma unroll
    for (int r = 0; r < 16; ++r) { r0[r] += st.o0[r] * f; r1[r] += st.o1[r] * f; }
}
__device__ __forceinline__ void soft_part(Soft2& st, f32x16 s, float cadd, bf16x8& p0, bf16x8& p1) {
    const float nm = cadd - st.m;
#pragma unroll
    for (int r = 0; r < 16; ++r) s[r] += nm;
    float mx = fmaxf(fmaxf(s[0], s[1]), fmaxf(s[2], s[3]));
#pragma unroll
    for (int r = 4; r < 16; r += 4) mx = fmaxf(mx, fmaxf(fmaxf(s[r], s[r + 1]), fmaxf(s[r + 2], s[r + 3])));
    mx = xhalf_max(mx);
    if (__any(mx > ATT_THR)) {
        const float d = fmaxf(mx, 0.f), alpha = __builtin_amdgcn_exp2f(-d);
        st.m += d;
#pragma unroll
        for (int r = 0; r < 16; ++r) { st.o0[r] *= alpha; st.o1[r] *= alpha; st.lv[r] *= alpha; s[r] -= d; }
    }
#pragma unroll
    for (int r = 0; r < 16; ++r) s[r] = __builtin_amdgcn_exp2f(s[r]);
    u32x4v pw0, pw1;
    pw0.x = pkbf(s[0], s[1]); pw0.y = pkbf(s[2], s[3]); pw0.z = pkbf(s[4], s[5]); pw0.w = pkbf(s[6], s[7]);
    pw1.x = pkbf(s[8], s[9]); pw1.y = pkbf(s[10], s[11]); pw1.z = pkbf(s[12], s[13]); pw1.w = pkbf(s[14], s[15]);
    p0 = __builtin_bit_cast(bf16x8, pw0); p1 = __builtin_bit_cast(bf16x8, pw1);
}
__device__ __forceinline__ f32x16 splat16(float v);
template <bool SUMS = true>
__device__ __forceinline__ void pv_part(Soft2& st, const VFrag& vf, const bf16x8 ones, const bf16x8 p0, const bf16x8 p1) {
    st.o0 = __builtin_amdgcn_mfma_f32_32x32x16_bf16(vf.v[0][0], p0, st.o0, 0, 0, 0);
    st.o1 = __builtin_amdgcn_mfma_f32_32x32x16_bf16(vf.v[1][0], p0, st.o1, 0, 0, 0);
    if (SUMS) st.lv = __builtin_amdgcn_mfma_f32_32x32x16_bf16(ones, p0, st.lv, 0, 0, 0);
    st.o0 = __builtin_amdgcn_mfma_f32_32x32x16_bf16(vf.v[0][1], p1, st.o0, 0, 0, 0);
    st.o1 = __builtin_amdgcn_mfma_f32_32x32x16_bf16(vf.v[1][1], p1, st.o1, 0, 0, 0);
    if (SUMS) st.lv = __builtin_amdgcn_mfma_f32_32x32x16_bf16(ones, p1, st.lv, 0, 0, 0);
}
__device__ __forceinline__ void soft_pv2(Soft2& st, f32x16 s, const VFrag& vf, const bf16x8 ones, float cadd = 0.f) {
    bf16x8 p0, p1; soft_part(st, s, cadd, p0, p1); pv_part(st, vf, ones, p0, p1);
}
template <bool MASKED>
__device__ __forceinline__ void soft_fast_pv(Soft2& st, f32x16 s, const VFrag& vf, const bf16x8 ones, unsigned sel) {
#pragma unroll
    for (int r = 0; r < 16; ++r) s[r] = __builtin_amdgcn_exp2f(s[r]);
    {
        f32x2s a0 = (f32x2s){s[0], s[1]} + (f32x2s){s[2], s[3]}, a1 = (f32x2s){s[4], s[5]} + (f32x2s){s[6], s[7]}, a2 = (f32x2s){s[8], s[9]} + (f32x2s){s[10], s[11]}, a3 = (f32x2s){s[12], s[13]} + (f32x2s){s[14], s[15]};
        a0 += a1; a2 += a3; a0 += a2;
        if (MASKED) { const float bf_ = (sel == 0x07060302u) ? 1.0f : 0.0f; st.lf = a0 * (f32x2s){bf_, bf_} + st.lf; } else st.lf += a0;
    }
    u32x4v pw0, pw1;
    if (MASKED) {
        pw0.x = __builtin_amdgcn_perm(__float_as_uint(s[1]), __float_as_uint(s[0]), sel); pw0.y = __builtin_amdgcn_perm(__float_as_uint(s[3]), __float_as_uint(s[2]), sel);
        pw0.z = __builtin_amdgcn_perm(__float_as_uint(s[5]), __float_as_uint(s[4]), sel); pw0.w = __builtin_amdgcn_perm(__float_as_uint(s[7]), __float_as_uint(s[6]), sel);
        pw1.x = __builtin_amdgcn_perm(__float_as_uint(s[9]), __float_as_uint(s[8]), sel); pw1.y = __builtin_amdgcn_perm(__float_as_uint(s[11]), __float_as_uint(s[10]), sel);
        pw1.z = __builtin_amdgcn_perm(__float_as_uint(s[13]), __float_as_uint(s[12]), sel); pw1.w = __builtin_amdgcn_perm(__float_as_uint(s[15]), __float_as_uint(s[14]), sel);
    } else {
        pw0.x = pkbf(s[0], s[1]); pw0.y = pkbf(s[2], s[3]); pw0.z = pkbf(s[4], s[5]); pw0.w = pkbf(s[6], s[7]);
        pw1.x = pkbf(s[8], s[9]); pw1.y = pkbf(s[10], s[11]); pw1.z = pkbf(s[12], s[13]); pw1.w = pkbf(s[14], s[15]);
    }
    pv_part<false>(st, vf, ones, __builtin_bit_cast(bf16x8, pw0), __builtin_bit_cast(bf16x8, pw1));
}
__device__ __forceinline__ f32x16 splat16(float v) { f32x16 s;
#pragma unroll
    for (int r = 0; r < 16; ++r) s[r] = v;
    return s; }

__device__ __forceinline__ f32x16 lut16(const LAS float* lutp) { f32x16 v;
#pragma unroll
    for (int r = 0; r < 16; ++r) v[r] = lutp[ROFF(r)];
    return v; }
template <int MODE, bool FAST>
__device__ __forceinline__ void attn_stream(Soft2& st, const bf16x8 (&qf)[4], const bf16* Kb, const bf16* Vb, int kt0, int np, const LAS float* lut, int q, int s0, unsigned mlo, unsigned mhi, float c31,
                                            LAS unsigned char* kvbuf, int tid, int col, int half, const bf16x8 ones) {
    u32x4v ra, rb;
    const __amdgpu_buffer_rsrc_t rs = stage_rsrc(Kb, Vb, tid); const unsigned loff = stage_goff(tid);
    const unsigned so = stage_loff(tid);
    pair_load(rs, kt0, loff, ra, rb); pair_store(kvbuf, ra, rb, so);
    if (np > 1) { pair_load(rs, kt0 + 2, loff, ra, rb); pair_store(kvbuf + 16384, ra, rb, so); }
    if (np > 2) pair_load(rs, kt0 + 4, loff, ra, rb);
    __syncthreads();
#define ATT_LUTP(KT_) (MODE == 0 ? true : (MODE == 1 ? ((s0 - 32 * (KT_) - 31) < 128) : !((s0 - 32 * (KT_) - 31) >= 128 && (s0 + 7 - 32 * (KT_)) < 512)))
#define ATT_QK(DST_, KT_) do { if (ATT_LUTP(KT_)) DST_ = qk_tile(kf, qf, lut16(lut - (q - 32 * (KT_) - 4 * half))); else DST_ = qk_tile(kf, qf, splat16(0.f)); } while (0)
#define ATT_PROCESS(S_, KT_, VF_) do { const int kt_ = (KT_); float cadd_ = 0.f; bool bit_ = true; \
        if (MODE == 1) { const int i_ = kt_ >> 1; bit_ = (((((unsigned long long)mhi << 32) | mlo) >> i_) & 1ull) != 0ull; cadd_ = bit_ ? 0.f : NEGL; } \
        if (FAST) soft_fast_pv<MODE == 1>(st, S_, VF_, ones, bit_ ? 0x07060302u : 0x0C0C0C0Cu); else soft_pv2(st, S_, VF_, ones, cadd_); } while (0)
    const bool lead = __builtin_amdgcn_readfirstlane(tid) < 256;
    KFrag kf; lds_k(kf, kvbuf, col, half);
    f32x16 sA, sB; ATT_QK(sA, kt0);
    int bo0 = 0, bo1 = 16384, bo2 = 32768;
#define ATT_PAIR(FAR_) do { \
        const LAS unsigned char* pb = kvbuf + bo0; const LAS unsigned char* pbn = kvbuf + bo1; \
        if ((FAR_) || p + 2 < np) pair_store(kvbuf + bo2, ra, rb, so); \
        if ((FAR_) || p + 3 < np) pair_load(rs, kt0 + 2 * p + 6, loff, ra, rb); \
        {     \
            VFrag vf; lds_v(vf, pb, col, half); lds_k(kf, pb + 8192, col, half); \
            if (FAR_) sB = qk_tile(kf, qf, splat16(0.f)); else ATT_QK(sB, kt0 + 2 * p + 1); \
            __builtin_amdgcn_sched_barrier(0); \
            ATT_PROCESS(sA, kt0 + 2 * p, vf); \
        } \
        {     \
            VFrag vf; lds_v(vf, pb + 8192, col, half); \
            if (FAR_) { lds_k(kf, pbn, col, half); sA = qk_tile(kf, qf, splat16(0.f)); } \
            else if (p + 1 < np) { lds_k(kf, pbn, col, half); ATT_QK(sA, kt0 + 2 * p + 2); } \
            __builtin_amdgcn_sched_barrier(0); \
            ATT_PROCESS(sB, kt0 + 2 * p + 1, vf); \
        } \
        __syncthreads(); \
        { const int tb = bo0; bo0 = bo1; bo1 = bo2; bo2 = tb; } } while (0)
    int p = 0;
    if (FAST && MODE != 0) {
        const int ktmax = (s0 - 159) >> 5;
        int pl = 0, ph = ((ktmax - kt0 - 2) >> 1) + 1;
        if (MODE == 2) { const int ktmin = ((s0 - 505) >> 5) + 1; pl = (ktmin - kt0) >> 1; pl = pl < 0 ? 0 : pl; }
        ph = ph > np - 3 ? np - 3 : ph;
#pragma unroll 1
        for (; p < pl && p < np; ++p) ATT_PAIR(false);
#pragma unroll 1
        for (; p < ph; ++p) ATT_PAIR(true);
    }
#pragma unroll 1
    for (; p < np; ++p) ATT_PAIR(false);
#undef ATT_PAIR
    if (FAST) st.lv[0] += xhalf_sum(st.lf.x + st.lf.y);
#undef ATT_LUTP
#undef ATT_QK
#undef ATT_PROCESS
}

struct DeferW { const float *win, *wout, *gain; bf16 *WIN2, *WOUT2; bool on; };
constexpr int DW_IN = 16 * 176, DW_OUT = 44 * 32, DW_SUB = 2 * (DW_IN + DW_OUT);
struct DeferD { const float* W; int ldw, k0, c0, Kd, drow0; bf16* WT; const float* kgain; float cscale; };
__device__ __forceinline__ DeferD defer_decode(const DeferW& dw, int sid) {
    DeferD d; int item = sid >> 1; const int h = sid & 1; d.kgain = nullptr; d.cscale = 1.0f;
    if (item < DW_IN) { const int kb = item / 176, nb = item % 176, pn = nb >> 3, bj = (nb >> 2) & 1, c = 32 * (nb & 3);
        d.W = dw.win; d.ldw = 2 * FF; d.k0 = 64 * kb + 32 * h; d.c0 = (bj ? FF : 0) + 128 * pn + c; d.WT = dw.WIN2; d.Kd = DM; d.drow0 = 32 * nb; d.kgain = dw.gain; d.cscale = bj ? (1.0f / LOG2E) : LOG2E; }
    else { item -= DW_IN; const int kb = item / 32, nb = item % 32;
        d.W = dw.wout; d.ldw = DM; d.k0 = 64 * kb + 32 * h; d.c0 = 32 * nb; d.WT = dw.WOUT2; d.Kd = FF; d.drow0 = 32 * nb; }
    return d;
}
__device__ __forceinline__ void defer_load(const DeferW& dw, int sid, int lane, f32x4 (&v)[4]) {
    const DeferD d = defer_decode(dw, sid); const int c4 = 4 * (lane & 7), rr = lane >> 3;
#pragma unroll
    for (int i = 0; i < 4; ++i) v[i] = *(const GAS f32x4*)(d.W + (size_t)(d.k0 + 8 * i + rr) * d.ldw + d.c0 + c4);
}
__device__ __forceinline__ void defer_finish(const DeferW& dw, int sid, const f32x4 (&v)[4], LAS float* scr, int lane) {
    const DeferD d = defer_decode(dw, sid); const int c4 = 4 * (lane & 7), rr = lane >> 3;
#pragma unroll
    for (int i = 0; i < 4; ++i) { const int kk = 8 * i + rr; const float gk = (d.kgain ? d.kgain[d.k0 + kk] : 1.0f) * d.cscale; LAS float* p = scr + kk * 32;
        p[(c4 + 0) ^ kk] = v[i][0] * gk; p[(c4 + 1) ^ kk] = v[i][1] * gk; p[(c4 + 2) ^ kk] = v[i][2] * gk; p[(c4 + 3) ^ kk] = v[i][3] * gk; }
    LDS_WAIT(); asm volatile("" ::: "memory");
    const int c = lane & 3;
#pragma unroll
    for (int j = 0; j < 2; ++j) { const int n = (lane >> 2) + 16 * j; const LAS float* s = scr + (8 * c) * 32;
        v4u o; o.x = pk2(s[0 * 32 + (n ^ (8 * c + 0))], s[1 * 32 + (n ^ (8 * c + 1))]); o.y = pk2(s[2 * 32 + (n ^ (8 * c + 2))], s[3 * 32 + (n ^ (8 * c + 3))]);
        o.z = pk2(s[4 * 32 + (n ^ (8 * c + 4))], s[5 * 32 + (n ^ (8 * c + 5))]); o.w = pk2(s[6 * 32 + (n ^ (8 * c + 6))], s[7 * 32 + (n ^ (8 * c + 7))]);
        *(GAS v4u*)(d.WT + (size_t)(d.drow0 + n) * d.Kd + d.k0 + 8 * c) = o; }
    LDS_WAIT(); asm volatile("" ::: "memory");
}
__device__ __forceinline__ void defer_subitem(const DeferW& dw, int sid, LAS float* scr, int lane) { f32x4 v[4]; defer_load(dw, sid, lane, v); defer_finish(dw, sid, v, scr, lane); }
template <bool fast>
__device__ __forceinline__ void attn2_unit(Frame& F, const AttP& P, const float* sinks, int b, int g, int blk, const LAS float* lutA, const LAS float* lutB, LAS float* wscr, const DeferW& dw, int dsid) {
    const int w = F.wave; const int lane = hw_lane_id(); const int tid = w * 64 + lane;
    const int col = lane & 31, half = lane >> 5, ql = col >> 2, hd = col & 3, bg = b * 2 + g, sb = 64 * blk, s0 = sb + 8 * w, q = s0 + ql, head8 = g * 4 + hd, t = b * SEQ + q;
    LAS unsigned char* kvbuf = F.lds + RING_OFF + ATT2_KV_OFF;
    const int kt_top = (sb + 63) >> 5, ktw = s0 >> 5;
    Soft2 st; f32x16 r0, r1;
    const bf16x8 ones = (bf16x8){0x3F80, 0x3F80, 0x3F80, 0x3F80, 0x3F80, 0x3F80, 0x3F80, 0x3F80};
    const int ntc_u = (sb + 63 >= 31) ? ((sb + 63 - 31) >> 4) / 32 + 1 : 0;
    u32x4v ctile[8];
    { const bf16* KCb = P.KC + (size_t)bg * 256 * 64; const bf16* VCb = P.VCT + (size_t)bg * 8 * 2048;
#pragma unroll
      for (int kt = 0; kt < 8; ++kt) ctile[kt] = (kt < ntc_u) ? tile_load(KCb + kt * 2048, VCb + kt * 2048, tid) : (u32x4v){0u, 0u, 0u, 0u}; }
    bf16x8 qf[4]; { const bf16* qp = P.QB + ((size_t)(b * 8 + head8) * SEQ + q) * 64 + 8 * half;
#pragma unroll
        for (int s4 = 0; s4 < 4; ++s4) qf[s4] = *(const bf16x8*)(qp + 16 * s4); }
    const float g0 = P.GT[(size_t)t * 32 + head8], g1 = P.GT[(size_t)t * 32 + 8 + head8], g2 = P.GT[(size_t)t * 32 + 16 + head8];
    for (int rp_ = 0; rp_ < (KREP == 51 ? 2 : 1); ++rp_) {
        bf16x8 qfa[4]; { const bf16* qp = P.QA + ((size_t)(b * 8 + head8) * SEQ + q) * 64 + 8 * half;
#pragma unroll
            for (int s4 = 0; s4 < 4; ++s4) qfa[s4] = *(const bf16x8*)(qp + 16 * s4); }
        if (fast) soft2_init(st, 0.f, __builtin_amdgcn_exp2f(sinks[head8] * LOG2E)); else soft2_init(st, sinks[head8] * LOG2E, 1.0f);
        const LAS float* lut = lutA + head8 * LA + OFFA;
        const int kt0 = (sb > 127 ? sb - 127 : 0) >> 5, nt = kt_top - kt0 + 1, ktw_lo = (s0 > 127 ? s0 - 127 : 0) >> 5;
        const bf16* Kb = P.KA + (size_t)bg * SEQ * 64; const bf16* Vb = P.VAT + (size_t)bg * (SEQ / 32) * 2048;
        attn_stream<0, fast>(st, qfa, Kb, Vb, kt0, nt >> 1, lut, q, s0, 0u, 0u, 0.f, kvbuf, tid, col, half, ones);
        r0 = splat16(0.f); r1 = splat16(0.f);
        soft2_acc(r0, r1, st, 1.0f);
        store_o_rows((LAS unsigned char*)wscr, P.mix + (size_t)(b * SEQ + s0) * 1024 + g * 256, r0, r1, lane);
    }
    const LAS float* lut = lutB + head8 * LB + OFFB;
    constexpr float c31 = 0.f;
    r0 = splat16(0.f); r1 = splat16(0.f);
    LAS float* impG = wscr; LAS float* impL = wscr + 512;
    const int ntc = (s0 + 7 >= 31) ? ((s0 + 7 - 31) >> 4) / 32 + 1 : 0;
    { const unsigned so_u = stage_loff(tid);
#pragma unroll
        for (int kt = 0; kt < 8; ++kt) if (kt < ntc_u) tile_store(kvbuf + kt * 8192, ctile[kt], so_u);
        __syncthreads();
    }
    unsigned mlo = 0u, mhi = 0u;
    for (int rp_ = 0; rp_ < (KREP == 52 ? 2 : 1); ++rp_) {
    if constexpr (fast) {
        soft2_init(st, 0.f, 0.f);
        float Gs[8][4], Ls[8][4];
#pragma unroll
        for (int kt = 0; kt < 8; ++kt) {
#pragma unroll
            for (int i = 0; i < 4; ++i) { Gs[kt][i] = 0.f; Ls[kt][i] = 0.f; }
            if (kt < ntc) { const LAS unsigned char* cb = kvbuf + kt * 8192;
                KFrag kf; VFrag vf; lds_k(kf, cb, col, half); lds_v(vf, cb, col, half);
                f32x16 s = qk_tile(kf, qf, splat16(0.f));
                const bool farc = 512 * kt <= s0 - 655;
                if (!farc) { const int basec = q - 31 - 512 * kt - 64 * half;
#pragma unroll
                    for (int r = 0; r < 16; ++r) { int rc = basec - 16 * ROFF(r); rc = rc < -1 ? -1 : (rc > 511 ? 511 : rc); s[r] += lut[-rc]; } }
#pragma unroll
                for (int r = 0; r < 16; ++r) s[r] = __builtin_amdgcn_exp2f(s[r]);
#pragma unroll
                for (int i = 0; i < 4; ++i) { Gs[kt][i] = (s[4 * i] + s[4 * i + 1]) + (s[4 * i + 2] + s[4 * i + 3]); Ls[kt][i] = s[4 * i + 3]; }
                st.lf.x += (Gs[kt][0] + Gs[kt][1]) + (Gs[kt][2] + Gs[kt][3]);
                u32x4v pw0, pw1;
                pw0.x = pkbf(s[0], s[1]); pw0.y = pkbf(s[2], s[3]); pw0.z = pkbf(s[4], s[5]); pw0.w = pkbf(s[6], s[7]);
                pw1.x = pkbf(s[8], s[9]); pw1.y = pkbf(s[10], s[11]); pw1.z = pkbf(s[12], s[13]); pw1.w = pkbf(s[14], s[15]);
                pv_part<false>(st, vf, ones, __builtin_bit_cast(bf16x8, pw0), __builtin_bit_cast(bf16x8, pw1));
            }
        }
        st.lv[0] += xhalf_sum(st.lf.x + st.lf.y);
        soft2_acc(r0, r1, st, rp_ == 0 ? g0 : 0.f);
#pragma unroll
        for (int j = 0; j < 8; ++j) { impG[lane + 64 * j] = 0.f; impL[lane + 64 * j] = 0.f; }
        const float invl = __builtin_amdgcn_rcpf(fmaxf(st.lv[0], 1.1754944e-38f));
#pragma unroll
        for (int kt = 0; kt < 8; ++kt) if (kt < ntc) {
#pragma unroll
            for (int i = 0; i < 4; ++i) {
                const float G = quad_sum(Gs[kt][i] * invl), L = quad_sum(Ls[kt][i] * invl);
                const int n = 8 * kt + 2 * i + half;
                if (hd == 0) { impG[ql * 64 + n] = G; if (n < 63) impL[ql * 64 + n + 1] = L; }
            }
        }
    } else {
    soft2_init(st, 0.f, 0.f);
#pragma unroll 1
    for (int kt = 0; kt < ntc; ++kt) { const LAS unsigned char* cb = kvbuf + kt * 8192;
        KFrag kf; VFrag vf; lds_k(kf, cb, col, half); lds_v(vf, cb, col, half);
        f32x16 s = qk_tile(kf, qf, splat16(0.f));
        const bool farc = 512 * kt <= s0 - 655;
        if (!farc) { const int basec = q - 31 - 512 * kt - 64 * half;
#pragma unroll
            for (int r = 0; r < 16; ++r) { int rc = basec - 16 * ROFF(r); rc = rc < -1 ? -1 : (rc > 511 ? 511 : rc); s[r] += lut[-rc]; } }
        soft_pv2(st, s, vf, ones, farc ? c31 : 0.f);
    }
    soft2_acc(r0, r1, st, rp_ == 0 ? g0 : 0.f);
#pragma unroll
    for (int j = 0; j < 8; ++j) { impG[lane + 64 * j] = 0.f; impL[lane + 64 * j] = 0.f; }
    {
        const float nmfin = -st.m, invl = __builtin_amdgcn_rcpf(fmaxf(st.lv[0], 1.1754944e-38f));
#pragma unroll 1
        for (int kt = 0; kt < ntc; ++kt) { const LAS unsigned char* cb = kvbuf + kt * 8192;
            KFrag kf; lds_k(kf, cb, col, half);
            f32x16 s = qk_tile(kf, qf, splat16(0.f));
            const bool farc = 512 * kt <= s0 - 655;
            if (farc) { const float nmc = nmfin + c31;
#pragma unroll
                for (int r = 0; r < 16; ++r) s[r] = __builtin_amdgcn_exp2f(s[r] + nmc) * invl; }
            else { const int basec = q - 31 - 512 * kt - 64 * half;
#pragma unroll
                for (int r = 0; r < 16; ++r) { int rc = basec - 16 * ROFF(r); rc = rc < -1 ? -1 : (rc > 511 ? 511 : rc); s[r] = __builtin_amdgcn_exp2f(s[r] + lut[-rc] + nmfin) * invl; } }
#pragma unroll
            for (int i = 0; i < 4; ++i) {
                const float G = quad_sum((s[4 * i] + s[4 * i + 1]) + (s[4 * i + 2] + s[4 * i + 3])), L = quad_sum(s[4 * i + 3]);
                const int n = 8 * kt + 2 * i + half;
                if (hd == 0) { impG[ql * 64 + n] = G; if (n < 63) impL[ql * 64 + n + 1] = L; }
            }
        }
    }
    }
#pragma unroll 1
    for (int q4 = 0; q4 < 8; q4 += 4) {
        int key[4]; unsigned long long selv[4]; bool need = false;
#pragma unroll
        for (int i = 0; i < 4; ++i) { const int qq = q4 + i, qs = s0 + qq, cur = qs >> 6, n = lane;
            const float imp = impG[qq * 64 + n] + impL[qq * 64 + n];
            const bool valid = n <= cur, forced = (n == 0) || (n == cur) || (n == cur - 1);
            const float score = imp + (forced ? 1000.0f : 0.0f);
            key[i] = valid ? (__float_as_int(score) & ~63) : (int)0x80000000;
            selv[i] = __ballot(valid); need = need || (cur >= 16); }
        if (need) {
            int T[4] = {0, 0, 0, 0};
#pragma unroll 1
            for (int bitp = 30; bitp >= 6; --bitp) {
#pragma unroll
                for (int i = 0; i < 4; ++i) { const int cand = T[i] | (1 << bitp); const int cnt = __builtin_popcountll(__ballot(key[i] >= cand)); T[i] = (cnt >= 16) ? cand : T[i]; } }
#pragma unroll
            for (int i = 0; i < 4; ++i) { const int cur = (s0 + q4 + i) >> 6;
                if (cur >= 16) { const unsigned long long gt = __ballot(key[i] > T[i]), eq = __ballot(key[i] == T[i]); const int k = 16 - __builtin_popcountll(gt);
                    unsigned long long mm = eq;
#pragma unroll 1
                    for (int j = 0; j < k; ++j) mm &= mm - 1ull;
                    selv[i] = gt | (eq ^ mm); } }
        }
#pragma unroll
        for (int i = 0; i < 4; ++i) if (ql == q4 + i) { mlo = (unsigned)selv[i]; mhi = (unsigned)(selv[i] >> 32); }
    }
    }
#define R0_PARK() do { if (fast) { _Pragma("unroll") for (int k = 0; k < 4; ++k) { f32x4 v_ = {r0[4 * k], r0[4 * k + 1], r0[4 * k + 2], r0[4 * k + 3]}; *(LAS f32x4*)((LAS unsigned char*)wscr + k * 1024 + lane * 16) = v_; } } } while (0)
#define R0_FETCH() do { if (fast) { _Pragma("unroll") for (int k = 0; k < 4; ++k) { const f32x4 v_ = *(const LAS f32x4*)((LAS unsigned char*)wscr + k * 1024 + lane * 16); r0[4 * k] = v_.x; r0[4 * k + 1] = v_.y; r0[4 * k + 2] = v_.z; r0[4 * k + 3] = v_.w; } } } while (0)
    R0_PARK();
    __syncthreads();
    for (int rp_ = 0; rp_ < (KREP == 53 ? 2 : 1); ++rp_) {
        const bf16* Kb = P.KS + (size_t)bg * SEQ * 64; const bf16* Vb = P.VST + (size_t)bg * (SEQ / 32) * 2048;
        soft2_init(st, 0.f, 0.f);
        attn_stream<1, fast>(st, qf, Kb, Vb, 0, blk + 1, lut, q, s0, mlo, mhi, c31, kvbuf, tid, col, half, ones);
        R0_FETCH();
        soft2_acc(r0, r1, st, rp_ == 0 ? g1 : 0.f);
        R0_PARK();
    }
    f32x4 dwv[4];
    for (int rp_ = 0; rp_ < (KREP == 54 ? 2 : 1); ++rp_) {
        const bf16* Kb = P.KW + (size_t)bg * SEQ * 64; const bf16* Vb = P.VWT + (size_t)bg * (SEQ / 32) * 2048;
        soft2_init(st, 0.f, 0.f);
        const int kt0 = (sb > 511 ? sb - 511 : 0) >> 5, nt = kt_top - kt0 + 1, ktw_lo = (s0 > 511 ? s0 - 511 : 0) >> 5;
        attn_stream<2, fast>(st, qf, Kb, Vb, kt0, nt >> 1, lut, q, s0, 0u, 0u, c31, kvbuf, tid, col, half, ones);
        R0_FETCH();
        if (dw.on) defer_load(dw, dsid, lane, dwv);
        soft2_acc(r0, r1, st, rp_ == 0 ? g2 : 0.f);
    }
    store_o_rows((LAS unsigned char*)wscr, P.mix + (size_t)(b * SEQ + s0) * 1024 + 512 + g * 256, r0, r1, lane);
    if (dw.on) defer_finish(dw, dsid, dwv, wscr, lane);
}

__device__ __forceinline__ void attn2_phase(Frame& F, const AttP& P, const float* tbl, const float* sinks, const float* qna, const float* kna, const float* qnb, const float* knb, const DeferW dw) {
    LAS float* lutA = (LAS float*)(F.lds + RING_OFF + ATT_LUTA_OFF); LAS float* lutB = (LAS float*)(F.lds + RING_OFF + ATT_LUTB_OFF);
    for (int i = F.tid; i < 8 * LA; i += NWAVES * 64) { const int h = i / LA, rel = OFFA - i % LA; lutA[i] = (rel >= 0 && rel < 128) ? tbl[t5_bucket(rel) * 16 + h] * LOG2E : NEGL; }
    for (int i = F.tid; i < 8 * LB; i += NWAVES * 64) { const int h = i / LB, rel = OFFB - i % LB; lutB[i] = (rel >= 0 && rel < 512) ? (tbl[t5_bucket(rel) * 16 + 8 + h] - tbl[31 * 16 + 8 + h]) * LOG2E : NEGL; }
    { LAS float* gsc = (LAS float*)(F.lds + RING_OFF + ATT_WSCR_OFF);
      if (F.wave < 4) { const float* gp = F.wave == 0 ? qna : F.wave == 1 ? kna : F.wave == 2 ? qnb : knb; const float m = wave_max(fabsf(gp[F.lane])); if (F.lane == 0) gsc[F.wave] = m; }
      else if (F.wave == 4) { float m = 0.f; for (int i = F.lane; i < 256; i += 64) m = fmaxf(m, fabsf(tbl[(i >> 3) * 16 + (i & 7)]));
          m = fmaxf(m, F.lane < 8 ? fabsf(sinks[F.lane]) : 0.f); m = wave_max(m); if (F.lane == 0) gsc[4] = m * LOG2E; }
      else if (F.wave == 5) { float m = 0.f; for (int i = F.lane; i < 256; i += 64) m = fmaxf(m, fabsf(tbl[(i >> 3) * 16 + 8 + (i & 7)] - tbl[31 * 16 + 8 + (i & 7)])); m = wave_max(m); if (F.lane == 0) gsc[5] = m * LOG2E; } }
    __syncthreads();
    bool fast;
    { const LAS float* gsc = (const LAS float*)(F.lds + RING_OFF + ATT_WSCR_OFF);
      const float bA = 64.0f * gsc[0] * gsc[1] * QSCALE * 1.02f + gsc[4], bB = 64.0f * gsc[2] * gsc[3] * QSCALE * 1.02f + gsc[5];
      fast = __builtin_amdgcn_readfirstlane((int)(fmaxf(bA, bB) < 60.0f)) != 0; }
    __syncthreads();
    LAS float* wscr = (LAS float*)(F.lds + RING_OFF + ATT_WSCR_OFF + F.wave * ATT_WSCR_BYTES);
    for (int v = F.vcu; v < 256; v += F.G) {
        const int bg = v >> 4, j = v & 15, b = bg >> 1, g = bg & 1;
#pragma unroll 1
        for (int i = 0; i < 4; ++i) { const int blk = (i == 0) ? j : (i == 1) ? 31 - j : (i == 2) ? 32 + j : 63 - j; const int slot = (v * 4 + i) * 8 + F.wave;
            if (fast) attn2_unit<true>(F, P, sinks, b, g, blk, lutA, lutB, wscr, dw, slot); else attn2_unit<false>(F, P, sinks, b, g, blk, lutA, lutB, wscr, dw, slot); }
    }
    __syncthreads();
}

enum { F_NORM = 1, F_PROJ = 2, F_CMP = 4, F_ATT = 8 };
struct Args { const float* in[21]; float* out; unsigned char* ws; int ph_lo, ph_hi, flags, li, rep, pad; };

__device__ __forceinline__ void p0_item(const float* W, int ldw, int k0, int c0, int nvalid, bf16* WT, int Kd, int drow0, LAS float* scr, int lane, const float* kgain = nullptr, bool fragmajor = false, float cscale = 1.0f) {
    f32x4 v[8]; const int c4 = 4 * (lane & 7), rr = lane >> 3;
#pragma unroll
    for (int i = 0; i < 8; ++i) v[i] = (c4 < nvalid) ? *(const GAS f32x4*)(W + (size_t)(k0 + 8 * i + rr) * ldw + c0 + c4) : (f32x4){0.f, 0.f, 0.f, 0.f};
#pragma unroll
    for (int i = 0; i < 8; ++i) { const int kk = 8 * i + rr; const float gk = (kgain ? kgain[k0 + kk] : 1.0f) * cscale; LAS float* d = scr + kk * 33 + c4;
        d[0] = v[i][0] * gk; d[1] = v[i][1] * gk; d[2] = v[i][2] * gk; d[3] = v[i][3] * gk; }
    LDS_WAIT(); asm volatile("" ::: "memory");
    const int c = lane & 7;
#pragma unroll
    for (int j = 0; j < 4; ++j) { const int n = (lane >> 3) + 8 * j; const LAS float* s = scr + (8 * c) * 33 + n;
        v4u o; o.x = pk2(s[0 * 33], s[1 * 33]); o.y = pk2(s[2 * 33], s[3 * 33]); o.z = pk2(s[4 * 33], s[5 * 33]); o.w = pk2(s[6 * 33], s[7 * 33]);
        if (!fragmajor) *(GAS v4u*)(WT + (size_t)(drow0 + n) * Kd + k0 + 8 * c) = o;
        else { const int kk = k0 + 8 * c, nn = drow0 + n;
            *(GAS v4u*)(WT + ((size_t)((kk >> 4) * 4 + (nn >> 5)) * 64 + (nn & 31) + 32 * ((kk >> 3) & 1)) * 8) = o; } }
    LDS_WAIT(); asm volatile("" ::: "memory");
}
__host__ __device__ __forceinline__ int main_colbase(int H) {
    if (H < 8) return 64 * H;
    if (H < 16) return 768 + 64 * (H - 8);
    if (H < 18) return 512 + 64 * (H - 16);
    if (H < 20) return 1280 + 2 * 128 + 64 * (H - 18);
    if (H < 22) return 1280 + 4 * 128 + 64 * (H - 20);
    if (H < 24) return 1280 + 0 * 128 + 64 * (H - 22);
    if (H < 26) return 1280 + 1 * 128 + 64 * (H - 24);
    if (H == 26) return 2048;
    return -1;
}
__host__ __device__ __forceinline__ int vt_colbase(int vh) {
    if (vh < 2) return 640 + 64 * vh;
    if (vh < 4) return 1280 + 3 * 128 + 64 * (vh - 2);
    if (vh < 6) return 1280 + 5 * 128 + 64 * (vh - 4);
    return -1;
}
__device__ __forceinline__ void p0_prologue(Frame& F, const Args& a) {
    LAS float* scr = (LAS float*)(F.lds + RING_OFF + F.wave * 16384);
    const int gw = F.vcu * NWAVES + F.wave, NGW = F.G * NWAVES;
    unsigned char* ws = a.ws;
    constexpr int I_IN = 16 * 176, I_OUT = 44 * 32, I_MAIN = 16 * 56, I_PLAIN = 16 * 72, I_VT = 16 * 16, I_MO = 16 * 32, I_W1 = 2 * 32 * 4, I_W2 = 2 * 2 * 2;
    const bool defer = (F.G == 256) && ((a.flags & 15) == 15);
    const bool fproj = (a.flags & F_PROJ) != 0, fnorm = (a.flags & F_NORM) != 0;
    const int i_proj = fproj ? I_MAIN + I_VT : I_PLAIN;
    const int NITEMS = 2 * I_IN + 2 * I_OUT + i_proj + I_MO + I_W1 + I_W2;
    for (int it = gw; it < NITEMS; it += NGW) {
        int r = it;
        if (r < 2 * I_IN) { const int l = r / I_IN; if (l && defer) continue; r %= I_IN; const int kb = r / 176, nb = r % 176;
            const int pn = nb >> 3, bj = (nb >> 2) & 1, c = 32 * (nb & 3);
            p0_item(a.in[l ? 19 : 3], 2 * FF, 64 * kb, (bj ? FF : 0) + 128 * pn + c, 32, (bf16*)(ws + (l ? WS_WIN2 : WS_WIN1)), DM, 32 * nb, scr, F.lane, (l && fnorm) ? a.in[18] : nullptr, false, bj ? (1.0f / LOG2E) : LOG2E); continue; }
        r -= 2 * I_IN;
        if (r < 2 * I_OUT) { const int l = r / I_OUT; r %= I_OUT; if (l && defer && I_IN + r < 4096) continue; const int kb = r / 32, nb = r % 32;
            p0_item(a.in[l ? 20 : 4], DM, 64 * kb, 32 * nb, 32, (bf16*)(ws + (l ? WS_WOUT2 : WS_WOUT1)), FF, 32 * nb, scr, F.lane); continue; }
        r -= 2 * I_OUT;
        if (r < i_proj) {
            if (!fproj) { const int kb = r / 72, nb = r % 72; const int nv = 2072 - 32 * nb; p0_item(a.in[6], 2072, 64 * kb, nv > 0 ? 32 * nb : 0, nv > 32 ? 32 : (nv > 0 ? nv : 0), (bf16*)(ws + WS_WMAIN), DM, 32 * nb, scr, F.lane, fnorm ? a.in[5] : nullptr); continue; }
            if (r < I_MAIN) { const int kb = r / 56, nb = r % 56;
                const int pn = nb >> 3, bj = (nb >> 2) & 1, wc = nb & 3, H = 4 * pn + wc, cb = main_colbase(H);
                const int nv = cb < 0 ? 0 : (H == 26 ? (bj ? 0 : 24) : 32);
                p0_item(a.in[6], 2072, 64 * kb, cb < 0 ? 0 : cb + 32 * bj, nv, (bf16*)(ws + WS_WMAIN), DM, 32 * nb, scr, F.lane, fnorm ? a.in[5] : nullptr); continue; }
            r -= I_MAIN; { const int kb = r / 16, nb = r % 16, vh = nb >> 1, cb = vt_colbase(vh);
                p0_item(a.in[6], 2072, 64 * kb, cb < 0 ? 0 : cb + 32 * (nb & 1), cb < 0 ? 0 : 32, (bf16*)(ws + WS_WVT), DM, 32 * nb, scr, F.lane, fnorm ? a.in[5] : nullptr); continue; }
        }
        r -= i_proj;
        if (r < I_MO) { const int kb = r / 32, nb = r % 32; p0_item(a.in[7], DM, 64 * kb, 32 * nb, 32, (bf16*)(ws + WS_WMO), DM, 32 * nb, scr, F.lane); continue; }
        r -= I_MO;
        if (r < I_W1) { const int kv = r / 128; r %= 128; const int kb = r / 4, nb = r % 4; p0_item(a.in[14] + (size_t)kv * 2048 * 128, 128, 64 * kb, 32 * nb, 32, (bf16*)(ws + WS_W1T) + (size_t)kv * 128 * 2048, 2048, 32 * nb, scr, F.lane, nullptr, true); continue; }
        r -= I_W1;
        { const int kv = r / 4; r %= 4; const int kb = r / 2, nb = r % 2; p0_item(a.in[16] + (size_t)kv * 128 * 64, 64, 64 * kb, 32 * nb, 32, (bf16*)(ws + WS_W2T) + (size_t)kv * 64 * 128, 128, 32 * nb, scr, F.lane); }
    }
    if (gw < 256) { const int kv = gw >> 7, hid = gw & 127; float s = 0.f;
        for (int j = 0; j < 32; ++j) { const int k = F.lane + 64 * j; s += a.in[13][kv * 2048 + k] * a.in[14][((size_t)kv * 2048 + k) * 128 + hid]; }
        s = wave_sum(s); if (F.lane == 0) ((float*)(ws + WS_POSB))[gw] = s + a.in[15][gw]; }
    const float* g1 = a.in[2];
    for (int m0 = gw; m0 < T; m0 += 4 * NGW) {
        f32x4 v[4][4];
#pragma unroll
        for (int rI = 0; rI < 4; ++rI) { const int m = m0 + rI * NGW; const GAS f32x4* xr = (const GAS f32x4*)(a.in[0] + (size_t)(m < T ? m : m0) * DM) + F.lane;
#pragma unroll
            for (int j = 0; j < 4; ++j) v[rI][j] = __builtin_nontemporal_load(xr + 64 * j); }
#pragma unroll
        for (int rI = 0; rI < 4; ++rI) { const int m = m0 + rI * NGW; if (m >= T) break;
            float s = 0.f;
#pragma unroll
            for (int j = 0; j < 4; ++j) s += (v[rI][j].x * v[rI][j].x + v[rI][j].y * v[rI][j].y) + (v[rI][j].z * v[rI][j].z + v[rI][j].w * v[rI][j].w);
            const float rstd = 1.0f / sqrtf(wave_sum(s) * (1.f / DM) + EPS); const f32x4* gr = (const f32x4*)g1 + F.lane;
            GAS unsigned long long* o8 = (GAS unsigned long long*)((bf16*)(ws + WS_A) + (size_t)m * DM) + F.lane;
#pragma unroll
            for (int j = 0; j < 4; ++j) { const f32x4 gg = gr[64 * j]; o8[64 * j] = (unsigned long long)pk2(v[rI][j].x * rstd * gg.x, v[rI][j].y * rstd * gg.y) | ((unsigned long long)pk2(v[rI][j].z * rstd * gg.z, v[rI][j].w * rstd * gg.w) << 32); } }
    }
}

__global__ void __launch_bounds__(NWAVES * 64, 2) mk(Args args) {
    extern __shared__ __attribute__((aligned(16))) unsigned char lds[];
    Frame F;
    F.lds = (LAS unsigned char*)lds; F.MISC = (volatile LAS unsigned*)(F.lds + MISC_OFF);
    F.wave = __builtin_amdgcn_readfirstlane((int)threadIdx.x >> 6);
#define FRESH() do { F.lane = hw_lane_id(); F.tid = F.wave * 64 + F.lane; } while (0)
#define LEADER() (F.wave == 0 && hw_lane_id() == 0)
    if (args.ph_lo < 0) cooperative_groups::this_grid().sync();
    FRESH();
    F.G = gridDim.x; { const int bx = blockIdx.x; F.vcu = (F.G % 8 == 0) ? (bx % 8) * (F.G / 8) + bx / 8 : bx; }
    unsigned char* ws = args.ws; F.ctl = (gu32*)(ws + WS_CTL);
    for (int u = F.tid; u < (LDS_BYTES - LDSCTL_OFF) / 4; u += NWAVES * 64) ((LAS unsigned*)(F.lds + LDSCTL_OFF))[u] = 0u;
    __syncthreads();
    const int lo = args.ph_lo, hi = args.ph_hi, flags = args.flags;
    const bool one = (hi - lo) > 1;
    XcdBarrier bar; bar.bar = (unsigned*)(F.ctl + CW_BAR) + args.li * XCD_BAR_WORDS; bar.x = 0; bar.st = nullptr;
    if (one) bar = xcd_barrier_post((unsigned*)(F.ctl + CW_BAR) + args.li * XCD_BAR_WORDS, F.MISC + 8, LEADER());
#define IN(k) (lo <= (k) && (k) < hi)
#define REP(k) for (int rep_ = 0; rep_ < ((KREP == (k)) ? 2 : 1); ++rep_)
#define SEAM(k) do { if (IN(k) && IN((k) + 1)) { xcd_barrier(bar, LEADER()); } FRESH(); } while (0)
    bf16* const A = (bf16*)(ws + WS_A); bf16* const ACT = (bf16*)(ws + WS_ACT); bf16* const MIX = (bf16*)(ws + WS_MIX);
    float* const SSQ1 = (float*)(ws + WS_SSQ1); float* const SSQ2 = (float*)(ws + WS_SSQ2);
    const bool fnorm = (flags & F_NORM) != 0;

    if (IN(0)) REP(0) { p0_prologue(F, args); } SEAM(0);
    if (IN(1)) REP(1) {
        pg8::Gemm g{A, (const bf16*)(ws + WS_WIN1), T, 2 * FF, DM}; pg8::StaticOrder S; S.init(T, 2 * FF, F.G, (int)blockIdx.x);
        pg8::EpiSwiglu E{ACT, FF, nullptr};
        pg8::gemm_phase<pg8::EpiSwiglu, pg8::StaticOrder, true, true>(F.lds + RING_OFF, g, S, E, F.wave);
    } SEAM(1);
    if (IN(2)) REP(2) {
        pg8::Gemm g{ACT, (const bf16*)(ws + WS_WOUT1), T, DM, FF}; pg8::StaticOrder S; S.init(T, DM, F.G, (int)blockIdx.x);
        pg8::EpiResid E{args.in[0], nullptr, 0.5f, fnorm ? nullptr : args.out, fnorm ? A : nullptr, fnorm ? SSQ1 : nullptr};
        pg8::gemm_phase<pg8::EpiResid, pg8::StaticOrder, true, true>(F.lds + RING_OFF, g, S, E, F.wave);
    } SEAM(2);
    if (IN(3)) REP(3) {
        if (!(flags & F_PROJ)) {
            pg8::Gemm g{A, (const bf16*)(ws + WS_WMAIN), T, NPLAIN, DM}; pg8::StaticOrder S; S.init(T, NPLAIN, F.G, (int)blockIdx.x);
            pg8::EpiPlain E{(bf16*)(ws + WS_PROJ), NPLAIN};
            pg8::gemm_phase<pg8::EpiPlain, pg8::StaticOrder, true, true>(F.lds + RING_OFF, g, S, E, F.wave);
        } else {
            pg8::Gemm g{A, (const bf16*)(ws + WS_WMAIN), T, NMAIN, DM}; pg8::StaticOrder S; S.init(T, NMAIN, F.G, (int)blockIdx.x);
            pg8::EpiProjMain E{SSQ1, (float*)(ws + WS_RSTD), args.in[8], args.in[9], args.in[11], args.in[12],
                               (bf16*)(ws + WS_QA), (bf16*)(ws + WS_QB), (bf16*)(ws + WS_KA), (bf16*)(ws + WS_KS), (bf16*)(ws + WS_KW), (bf16*)(ws + WS_KCR), (bf16*)(ws + WS_VCR), (float*)(ws + WS_GT), QSCALE, SEQ, T};
            pg8::gemm_phase<pg8::EpiProjMain, pg8::StaticOrder, true, true>(F.lds + RING_OFF, g, S, E, F.wave);
            if (F.G == 256 && (flags & F_CMP) && blockIdx.x >= 128) {
                pg8::Gemm gt{(const bf16*)(ws + WS_WVT), A, 512, T, DM}; pg8::OneUnit S1{0, (int)blockIdx.x - 128};
                pg8::EpiProjT Et{SSQ1, (bf16*)(ws + WS_VAT), (size_t)(WS_VST - WS_VAT) / 2, SEQ};
                pg8::gemm_phase<pg8::EpiProjT, pg8::OneUnit, true, true>(F.lds + RING_OFF, gt, S1, Et, F.wave);
            }
        }
    } SEAM(3);
    if (IN(4)) REP(4) {
        const bool bal = (F.G == 256) && (flags & F_PROJ) && (flags & F_CMP);
        if (flags & F_PROJ) {
            pg8::Gemm g{(const bf16*)(ws + WS_WVT), A, 512, T, DM};
            pg8::EpiProjT E{SSQ1, (bf16*)(ws + WS_VAT), (size_t)(WS_VST - WS_VAT) / 2, SEQ};
            if (bal) { if (blockIdx.x < 128) { pg8::OneUnit S1{1, (int)blockIdx.x}; pg8::gemm_phase<pg8::EpiProjT, pg8::OneUnit, true, true, true>(F.lds + RING_OFF, g, S1, E, F.wave); } }
            else { pg8::StaticOrder S; S.init(512, T, F.G, (int)blockIdx.x); pg8::gemm_phase<pg8::EpiProjT, pg8::StaticOrder, true, true>(F.lds + RING_OFF, g, S, E, F.wave); }
        }
        if (flags & F_CMP) {
            FRESH();
            if (bal) { if (blockIdx.x >= 128)
                cmp_unit2(F, 2 * ((int)blockIdx.x - 128), (const bf16*)(ws + WS_KCR), (const bf16*)(ws + WS_VCR), (const bf16*)(ws + WS_W1T), (const bf16*)(ws + WS_W2T), (const float*)(ws + WS_POSB), args.in[17], args.in[12], (bf16*)(ws + WS_KC), (bf16*)(ws + WS_VCT)); }
            else for (int u = F.vcu; u < 256; u += F.G)
                cmp_unit(F, u, (const bf16*)(ws + WS_KCR), (const bf16*)(ws + WS_VCR), (const bf16*)(ws + WS_W1T), (const bf16*)(ws + WS_W2T), (const float*)(ws + WS_POSB), args.in[17], args.in[12], (bf16*)(ws + WS_KC), (bf16*)(ws + WS_VCT));
        }
    }
    SEAM(4);
    if (IN(5) && (flags & F_ATT)) REP(5) {
        const AttP P{(const bf16*)(ws + WS_QA), (const bf16*)(ws + WS_QB), (const bf16*)(ws + WS_KA), (const bf16*)(ws + WS_VAT), (const bf16*)(ws + WS_KC), (const bf16*)(ws + WS_VCT), (const bf16*)(ws + WS_KS), (const bf16*)(ws + WS_VST),
                     (const bf16*)(ws + WS_KW), (const bf16*)(ws + WS_VWT), (const float*)(ws + WS_GT), MIX};
        const DeferW dw{args.in[19], args.in[20], fnorm ? args.in[18] : nullptr, (bf16*)(ws + WS_WIN2), (bf16*)(ws + WS_WOUT2), (F.G == 256) && ((flags & 15) == 15)};
        attn2_phase(F, P, args.in[1], args.in[10], args.in[8], args.in[9], args.in[11], args.in[12], dw);
    }
    SEAM(5);
    if (IN(6)) {
        pg8::Gemm g{MIX, (const bf16*)(ws + WS_WMO), T, DM, DM}; pg8::StaticOrder S; S.init(T, DM, F.G, (int)blockIdx.x);
        pg8::EpiResid E{fnorm ? nullptr : args.out, fnorm ? A : nullptr, 1.0f, fnorm ? nullptr : args.out, fnorm ? A : nullptr, fnorm ? SSQ2 : nullptr};
        pg8::gemm_phase<pg8::EpiResid, pg8::StaticOrder, true, true>(F.lds + RING_OFF, g, S, E, F.wave);
    } SEAM(6);
    if (IN(7)) REP(7) {
        pg8::Gemm g{A, (const bf16*)(ws + WS_WIN2), T, 2 * FF, DM}; pg8::StaticOrder S; S.init(T, 2 * FF, F.G, (int)blockIdx.x);
        pg8::EpiSwiglu E{ACT, FF, fnorm ? SSQ2 : nullptr};
        pg8::gemm_phase<pg8::EpiSwiglu, pg8::StaticOrder, true, true>(F.lds + RING_OFF, g, S, E, F.wave);
    } SEAM(7);
    if (IN(8)) {
        pg8::Gemm g{ACT, (const bf16*)(ws + WS_WOUT2), T, DM, FF}; pg8::StaticOrder S; S.init(T, DM, F.G, (int)blockIdx.x);
        pg8::EpiResid E{fnorm ? nullptr : args.out, fnorm ? A : nullptr, 0.5f, args.out, nullptr, nullptr};
        pg8::gemm_phase<pg8::EpiResid, pg8::StaticOrder, true, true>(F.lds + RING_OFF, g, S, E, F.wave);
    }
#undef IN
#undef SEAM
}

static void launch_mk(const Args& base, int lo, int hi, int grid, hipStream_t stream) {
    static int li = 0;
    Args a = base; a.ph_lo = lo; a.ph_hi = hi; a.li = 0;
    if (hi - lo > 1) {
        a.li = (lo == 0) ? 0 : (lo < 6 ? 1 : 2);
        void* kargs[] = {&a};
        hipError_t e = hipLaunchCooperativeKernel((const void*)mk, dim3(grid), dim3(NWAVES * 64), kargs, LDS_BYTES, stream);
        if (e != hipSuccess) fprintf(stderr, "cooperative launch failed: %s (grid %d)\n", hipGetErrorString(e), grid);
    } else hipLaunchKernelGGL(mk, dim3(grid), dim3(NWAVES * 64), LDS_BYTES, stream, a);
    (void)li;
}
extern "C" void kernel_launch(void* const* d_in, const int* in_sizes, int n_in, void* d_out, int out_size, void* d_ws, size_t ws_size, hipStream_t stream) {
    static int grid = 0;
    if (grid == 0) {
        if (n_in != 21 || in_sizes[0] != T * DM || out_size != T * DM || ws_size < (KFLAGS == 15 ? WS_MIX + 64 * MiB : WS_END)) { fprintf(stderr, "kernel_launch: unexpected shapes / workspace (%d inputs, ws %zu)\n", n_in, ws_size); grid = -1; return; }
        int dev = 0, cus = 0;
        if (hipGetDevice(&dev) != hipSuccess || hipDeviceGetAttribute(&cus, hipDeviceAttributeMultiprocessorCount, dev) != hipSuccess) { grid = -1; return; }
        if (hipFuncSetAttribute((const void*)mk, hipFuncAttributeMaxDynamicSharedMemorySize, LDS_BYTES) != hipSuccess) { grid = -1; return; }
        (void)hipGetLastError();
        int per_cu = 0;
        if (hipOccupancyMaxActiveBlocksPerMultiprocessor(&per_cu, (const void*)mk, NWAVES * 64, LDS_BYTES) != hipSuccess || per_cu < 1) { fprintf(stderr, "occupancy query failed (%d)\n", per_cu); (void)hipGetLastError(); per_cu = 1; }
        grid = cus * (per_cu > 1 ? 1 : per_cu);
    }
    if (grid < 0) return;
    (void)hipMemsetAsync((char*)d_ws + WS_CTL, 0, CTL_ZERO_BYTES, stream);
    Args a{};
    for (int i = 0; i < 21; ++i) a.in[i] = (const float*)d_in[i];
    a.out = (float*)d_out; a.ws = (unsigned char*)d_ws; a.flags = KFLAGS; a.rep = KREP;
    unsigned char* ws = (unsigned char*)d_ws;
    const bool fnorm = (KFLAGS & F_NORM) != 0;
    if (KFLAGS == 15) { launch_mk(a, 0, 9, grid, stream); return; }
    if (fnorm) launch_mk(a, 0, 3, grid, stream);
    else { launch_mk(a, 0, 1, grid, stream); launch_mk(a, 1, 2, grid, stream); launch_mk(a, 2, 3, grid, stream); }
    if (!fnorm) hipLaunchKernelGGL(nv_rmsnorm, dim3(T / 4), dim3(256), 0, stream, (const float*)d_out, a.in[5], (bf16*)(ws + WS_A));
    launch_mk(a, 3, 4, grid, stream);
    if (!(KFLAGS & F_PROJ)) {
        HeadPrep hp{(const bf16*)(ws + WS_PROJ), fnorm ? (const float*)(ws + WS_SSQ1) : nullptr, a.in[8], a.in[9], a.in[11], a.in[12],
                    (bf16*)(ws + WS_QA), (bf16*)(ws + WS_QB), (bf16*)(ws + WS_KA), (bf16*)(ws + WS_VAT), (bf16*)(ws + WS_KCR), (bf16*)(ws + WS_VCR), (bf16*)(ws + WS_KS), (bf16*)(ws + WS_VST), (bf16*)(ws + WS_KW), (bf16*)(ws + WS_VWT), (float*)(ws + WS_GT)};
        hipLaunchKernelGGL(nv_headprep, dim3(T / 4), dim3(256), 0, stream, hp);
    }
    if (KFLAGS & (F_PROJ | F_CMP)) launch_mk(a, 4, 5, grid, stream);
    if (!(KFLAGS & F_CMP)) hipLaunchKernelGGL(nv_compress, dim3(2 * 8 * 2 * 256), dim3(128), 0, stream, (const bf16*)(ws + WS_KCR), (const bf16*)(ws + WS_VCR), a.in[13], a.in[14], a.in[15], a.in[16], a.in[17], a.in[12], (bf16*)(ws + WS_KC), (bf16*)(ws + WS_VCT));
    if (!(KFLAGS & F_ATT)) {
        hipLaunchKernelGGL(nv_band_a, dim3(T * 2), dim3(256), 0, stream, (const bf16*)(ws + WS_QA), (const bf16*)(ws + WS_KA), (const bf16*)(ws + WS_VAT), a.in[1], a.in[10], (bf16*)(ws + WS_MIX));
        hipLaunchKernelGGL(nv_nsa, dim3(T * 2), dim3(256), 0, stream, (const bf16*)(ws + WS_QB), (const bf16*)(ws + WS_KC), (const bf16*)(ws + WS_VCT), (const bf16*)(ws + WS_KS), (const bf16*)(ws + WS_VST), (const bf16*)(ws + WS_KW), (const bf16*)(ws + WS_VWT), (const float*)(ws + WS_GT), a.in[1], (bf16*)(ws + WS_MIX));
    } else launch_mk(a, 5, 6, grid, stream);
    if (fnorm) launch_mk(a, 6, 9, grid, stream);
    else { launch_mk(a, 6, 7, grid, stream);
        hipLaunchKernelGGL(nv_rmsnorm, dim3(T / 4), dim3(256), 0, stream, (const float*)d_out, a.in[18], (bf16*)(ws + WS_A));
        launch_mk(a, 7, 8, grid, stream); launch_mk(a, 8, 9, grid, stream); }
}
```

```cpp
#include <hip/hip_runtime.h>
#include <hip/hip_cooperative_groups.h>
#include <cstdio>
#include <cstdint>
#ifndef KFLAGS
#define KFLAGS 15
#endif
#ifndef KREP
#define KREP -1
#endif
__device__ __forceinline__ int hw_lane_id() { int l; asm volatile("v_mbcnt_lo_u32_b32 %0, -1, 0\n\tv_mbcnt_hi_u32_b32 %0, -1, %0" : "=v"(l)); return l; }
namespace pg8 {
#define PG8_LAS __attribute__((address_space(3)))
typedef unsigned short bf16_t;
typedef short bf16x8 __attribute__((ext_vector_type(8)));
typedef float f32x4 __attribute__((ext_vector_type(4)));
typedef unsigned u32x4 __attribute__((ext_vector_type(4)));
constexpr int BM = 256, BK = 64, HALF = 128, HTB = HALF * BK * 2  , STAGE_BYTES = 8 * HTB, NXCD = 8, WGM = 8;

__host__ __device__ __forceinline__ int lds_byte(int r, int c) { const int st = (r >> 4) * 2 + (c >> 5), rr = r & 15, cc = c & 31, ob = rr * 64 + cc * 2; return st * 1024 + (ob ^ (((ob >> 9) & 1) << 5)); }
__host__ __device__ __forceinline__ void stage_rc(int b, int& R, int& C) { const int st = b / 1024, sb = b % 1024, swz = sb ^ (((sb >> 9) & 1) << 5); R = (st >> 1) * 16 + swz / 64; C = (st & 1) * 32 + (swz % 64) / 2; }
__host__ __device__ __forceinline__ int perm32(int rho) { const int n = rho >> 4, i = rho & 15; return 8 * (i >> 2) + 4 * n + (i & 3); }

struct Unit { int pm, pn; };
struct Gemm { const bf16_t* A; const bf16_t* Bt; int M, N, K; };

struct StaticOrder {
    int nM, nN, nwg, G, c;
    __host__ __device__ void init(int M, int N, int G_, int c_) { nM = M / BM; nN = N / BM; nwg = nM * nN; G = G_; c = c_; }
    __host__ __device__ bool next(int i, Unit& u) const {
        const long L = (long)i * G + c; if (L >= nwg) return false;
        int wgid = (int)L; { const int q = nwg / NXCD, r = nwg % NXCD, xcd = wgid % NXCD, off = wgid / NXCD; wgid = (xcd < r ? xcd * (q + 1) : r * (q + 1) + (xcd - r) * q) + off; }
        const int nig = WGM * nN, gid = wgid / nig, fm = gid * WGM, gsz = (nM - fm) < WGM ? (nM - fm) : WGM;
        u.pm = fm + ((wgid % nig) % gsz); u.pn = (wgid % nig) / gsz; return true;
    }
    __device__ __forceinline__ void a_ready(const Unit&) const {}
    __device__ __forceinline__ void done(const Unit&) const {}
};


__device__ __forceinline__ unsigned cvt_pk_bf16(float lo, float hi) { unsigned r; asm volatile("v_cvt_pk_bf16_f32 %0, %1, %2" : "=v"(r) : "v"(lo), "v"(hi)); return r; }
typedef unsigned u32x2 __attribute__((ext_vector_type(2)));
constexpr float kLog2e = 1.4426950408889634f;
__device__ __forceinline__ float silu_f(float x) { return x * __builtin_amdgcn_rcpf(1.0f + __builtin_amdgcn_exp2f(-x * kLog2e)); }
typedef float f32x2 __attribute__((ext_vector_type(2)));
__device__ __forceinline__ f32x2 silu_mul_pk(f32x2 g, f32x2 u) {
    f32x2 e; e.x = __builtin_amdgcn_exp2f(-g.x); e.y = __builtin_amdgcn_exp2f(-g.y);
    const f32x2 d = e + 1.0f; f32x2 r; r.x = __builtin_amdgcn_rcpf(d.x); r.y = __builtin_amdgcn_rcpf(d.y);
    return (g * r) * u;
}
__device__ __forceinline__ float row_rstd(const float* ssq, int row, int fq) {
    const f32x4 p = *(const f32x4*)(ssq + (size_t)row * 16 + 4 * fq);
    float s = (p[0] + p[1]) + (p[2] + p[3]);
    s += __shfl_xor(s, 16); s += __shfl_xor(s, 32);
    return __builtin_amdgcn_rsqf(s * (1.0f / 1024.0f) + 1e-6f);
}

__device__ __forceinline__ void rows_rstd(float (&rs)[2][4], const float* ssq, int row0, int fq) {
    f32x4 p[2][4];
#pragma unroll
    for (int ai = 0; ai < 2; ++ai)
#pragma unroll
        for (int m = 0; m < 4; ++m) p[ai][m] = *(const f32x4*)(ssq + (size_t)(row0 + ai * HALF + m * 16) * 16 + 4 * fq);
#pragma unroll
    for (int ai = 0; ai < 2; ++ai)
#pragma unroll
        for (int m = 0; m < 4; ++m) { float s = (p[ai][m][0] + p[ai][m][1]) + (p[ai][m][2] + p[ai][m][3]); s += __shfl_xor(s, 16); s += __shfl_xor(s, 32); rs[ai][m] = __builtin_amdgcn_rsqf(s * (1.0f / 1024.0f) + 1e-6f); }
    asm volatile("" ::: "memory");
}

struct EpiPlain {
    static constexpr bool PERM = true, AFTER_DRAIN = false;
    bf16_t* O; int ldc;
    __device__ __forceinline__ void operator()(const f32x4 (&acc)[2][2][4][2], const Unit& u, int wr, int wc, int fr, int fq) const {
        const int row0 = u.pm * BM + wr * 64 + fr, col0 = u.pn * BM + wc * 32 + 8 * fq;
#pragma unroll
        for (int ai = 0; ai < 2; ++ai)
#pragma unroll
            for (int m = 0; m < 4; ++m) { bf16_t* rowp = O + (size_t)(row0 + ai * HALF + m * 16) * ldc + col0;
#pragma unroll
                for (int bj = 0; bj < 2; ++bj) { const f32x4 v0 = acc[ai][bj][m][0], v1 = acc[ai][bj][m][1]; u32x4 w;
                    w.x = cvt_pk_bf16(v0[0], v0[1]); w.y = cvt_pk_bf16(v0[2], v0[3]); w.z = cvt_pk_bf16(v1[0], v1[1]); w.w = cvt_pk_bf16(v1[2], v1[3]);
                    *(u32x4*)(rowp + bj * HALF) = w; } }
    }
};

struct EpiSwiglu {
    static constexpr bool PERM = true, AFTER_DRAIN = false;
    bf16_t* O; int ldo; const float* ssq;
    __device__ __forceinline__ void operator()(const f32x4 (&acc)[2][2][4][2], const Unit& u, int wr, int wc, int fr, int fq) const {
        const int row0 = u.pm * BM + wr * 64 + fr, col0 = u.pn * HALF + wc * 32 + 8 * fq;
        const __amdgpu_buffer_rsrc_t orsrc = __builtin_amdgcn_make_buffer_rsrc((void*)O, 0, 0x7FFFFFFF, 0x00020000);
        const unsigned ovoff = (unsigned)(row0 * ldo + col0) * 2u;
        float rsv[2][4];
        if (ssq) rows_rstd(rsv, ssq, row0, fq);
#pragma unroll
        for (int ai = 0; ai < 2; ++ai)
#pragma unroll
            for (int m = 0; m < 4; ++m) { const int row = row0 + ai * HALF + m * 16;
                const float rs = ssq ? rsv[ai][m] : 1.0f;
                const f32x4 g0 = acc[ai][0][m][0] * rs, g1 = acc[ai][0][m][1] * rs, u0 = acc[ai][1][m][0] * rs, u1 = acc[ai][1][m][1] * rs;
                u32x4 w;
                const f32x2 a0 = silu_mul_pk((f32x2){g0[0], g0[1]}, (f32x2){u0[0], u0[1]}), a1 = silu_mul_pk((f32x2){g0[2], g0[3]}, (f32x2){u0[2], u0[3]});
                const f32x2 a2 = silu_mul_pk((f32x2){g1[0], g1[1]}, (f32x2){u1[0], u1[1]}), a3 = silu_mul_pk((f32x2){g1[2], g1[3]}, (f32x2){u1[2], u1[3]});
                w.x = cvt_pk_bf16(a0.x, a0.y); w.y = cvt_pk_bf16(a1.x, a1.y); w.z = cvt_pk_bf16(a2.x, a2.y); w.w = cvt_pk_bf16(a3.x, a3.y);
                __builtin_amdgcn_raw_buffer_store_b128(w, orsrc, ovoff, (ai * HALF + m * 16) * ldo * 2, 0); }
    }
};

struct EpiResid {
    static constexpr bool PERM = true, AFTER_DRAIN = false;
    const float* bf; const bf16_t* bb; float alpha; float* of; bf16_t* ob; float* ssq;
    __device__ __forceinline__ void operator()(const f32x4 (&acc)[2][2][4][2], const Unit& u, int wr, int wc, int fr, int fq) const {
        const int row0 = u.pm * BM + wr * 64 + fr, col0 = u.pn * BM + wc * 32 + 8 * fq;
#pragma unroll
        for (int ai = 0; ai < 2; ++ai) {
            u32x4 pb[4][2];
            if (!bf) {
#pragma unroll
                for (int m = 0; m < 4; ++m)
#pragma unroll
                    for (int bj = 0; bj < 2; ++bj) pb[m][bj] = *(const u32x4*)(bb + (size_t)(row0 + ai * HALF + m * 16) * 1024 + col0 + bj * HALF);
            }
#pragma unroll
            for (int mp = 0; mp < 2; ++mp) {
                f32x4 pf[2][2][2];
                if (bf) {
#pragma unroll
                    for (int mm = 0; mm < 2; ++mm)
#pragma unroll
                        for (int bj = 0; bj < 2; ++bj)
#pragma unroll
                            for (int n = 0; n < 2; ++n) pf[mm][bj][n] = __builtin_nontemporal_load((const f32x4*)(bf + (size_t)(row0 + ai * HALF + (2 * mp + mm) * 16) * 1024 + col0 + bj * HALF + n * 4));
                }
#pragma unroll
                for (int mm = 0; mm < 2; ++mm) { const int m = 2 * mp + mm; const int row = row0 + ai * HALF + m * 16; const size_t off = (size_t)row * 1024 + col0; float ss = 0.f;
#pragma unroll
                    for (int bj = 0; bj < 2; ++bj) { const size_t o2 = off + bj * HALF; f32x4 o[2];
#pragma unroll
                        for (int n = 0; n < 2; ++n) { f32x4 bse;
                            if (bf) bse = pf[mm][bj][n];
                            else { const unsigned w0 = n ? pb[m][bj].z : pb[m][bj].x, w1 = n ? pb[m][bj].w : pb[m][bj].y;
                                bse[0] = __uint_as_float(w0 << 16); bse[1] = __uint_as_float(w0 & 0xffff0000u); bse[2] = __uint_as_float(w1 << 16); bse[3] = __uint_as_float(w1 & 0xffff0000u); }
                            o[n] = bse + acc[ai][bj][m][n] * alpha;
                            ss += (o[n][0] * o[n][0] + o[n][1] * o[n][1]) + (o[n][2] * o[n][2] + o[n][3] * o[n][3]); }
                        if (of) { __builtin_nontemporal_store(o[0], (f32x4*)(of + o2)); __builtin_nontemporal_store(o[1], (f32x4*)(of + o2 + 4)); }
                        if (ob) { u32x4 w; w.x = cvt_pk_bf16(o[0][0], o[0][1]); w.y = cvt_pk_bf16(o[0][2], o[0][3]); w.z = cvt_pk_bf16(o[1][0], o[1][1]); w.w = cvt_pk_bf16(o[1][2], o[1][3]); *(u32x4*)(ob + o2) = w; } }
                    if (ssq) { ss += __shfl_xor(ss, 16); ss += __shfl_xor(ss, 32); if (fq == 0) ssq[(size_t)row * 16 + u.pn * 4 + wc] = ss; } }
                asm volatile("" ::: "memory");
            }
        }
    }
};

struct EpiResidF {
    static constexpr bool PERM = true, AFTER_DRAIN = false;
    const float* bf; float alpha; bf16_t* ob; float* ssq;
    __device__ __forceinline__ void load_q(f32x4 (&pf)[2][2][2], int row0, int col0, int q) const {
#pragma unroll
        for (int mm = 0; mm < 2; ++mm)
#pragma unroll
            for (int bj = 0; bj < 2; ++bj)
#pragma unroll
                for (int n = 0; n < 2; ++n) pf[mm][bj][n] = __builtin_nontemporal_load((const f32x4*)(bf + (size_t)(row0 + (q >> 1) * HALF + (2 * (q & 1) + mm) * 16) * 1024 + col0 + bj * HALF + n * 4));
    }
    __device__ __forceinline__ void operator()(const f32x4 (&acc)[2][2][4][2], const Unit& u, int wr, int wc, int fr, int fq) const {
        const int row0 = u.pm * BM + wr * 64 + fr, col0 = u.pn * BM + wc * 32 + 8 * fq;
        f32x4 pfa[2][2][2], pfb[2][2][2];
        load_q(pfa, row0, col0, 0);
#pragma unroll
        for (int q = 0; q < 4; ++q) { const int ai = q >> 1, mp = q & 1;
            f32x4 (&cur)[2][2][2] = (q & 1) ? pfb : pfa; f32x4 (&nxt)[2][2][2] = (q & 1) ? pfa : pfb;
            if (q < 3) load_q(nxt, row0, col0, q + 1);
#pragma unroll
            for (int mm = 0; mm < 2; ++mm) { const int m = 2 * mp + mm; const int row = row0 + ai * HALF + m * 16; const size_t off = (size_t)row * 1024 + col0; float ss = 0.f;
#pragma unroll
                for (int bj = 0; bj < 2; ++bj) { const size_t o2 = off + bj * HALF; f32x4 o[2];
#pragma unroll
                    for (int n = 0; n < 2; ++n) { o[n] = cur[mm][bj][n] + acc[ai][bj][m][n] * alpha; ss += (o[n][0] * o[n][0] + o[n][1] * o[n][1]) + (o[n][2] * o[n][2] + o[n][3] * o[n][3]); }
                    u32x4 w; w.x = cvt_pk_bf16(o[0][0], o[0][1]); w.y = cvt_pk_bf16(o[0][2], o[0][3]); w.z = cvt_pk_bf16(o[1][0], o[1][1]); w.w = cvt_pk_bf16(o[1][2], o[1][3]); *(u32x4*)(ob + o2) = w; }
                ss += __shfl_xor(ss, 16); ss += __shfl_xor(ss, 32); if (fq == 0) ssq[(size_t)row * 16 + u.pn * 4 + wc] = ss; }
            asm volatile("" ::: "memory");
        }
    }
};

struct EpiProjMain {
    static constexpr bool PERM = true, AFTER_DRAIN = false;
    const float* ssq; float* rstd_out; const float *qna, *kna, *qnb, *knb;
    bf16_t *QA, *QB, *KA, *KS, *KW, *KCR, *VCR; float* GT; float qscale; int seq, ntok;
    __device__ __forceinline__ void operator()(const f32x4 (&acc)[2][2][4][2], const Unit& u, int wr, int wc, int fr, int fq) const {
        const int H = 4 * u.pn + wc, row0 = u.pm * BM + wr * 64 + fr;
        const float* gain = nullptr; bf16_t* dst = nullptr; float sc = 1.0f; int nh = 2, hh = H & 1;
        if (H < 8) { gain = qna; dst = QA; sc = qscale; nh = 8; hh = H; }
        else if (H < 16) { gain = qnb; dst = QB; sc = qscale; nh = 8; hh = H - 8; }
        else if (H < 18) { gain = kna; dst = KA; }
        else if (H < 20) { gain = knb; dst = KS; }
        else if (H < 22) { gain = knb; dst = KW; }
        else if (H < 24) { dst = KCR; }
        else if (H < 26) { dst = VCR; }
        f32x4 gv[2][2];
#pragma unroll
        for (int bj = 0; bj < 2; ++bj)
#pragma unroll
            for (int n = 0; n < 2; ++n) gv[bj][n] = gain ? *(const f32x4*)(gain + 32 * bj + 8 * fq + 4 * n) * sc : (f32x4){1.f, 1.f, 1.f, 1.f};
        float rsv[2][4]; rows_rstd(rsv, ssq, row0, fq);
#pragma unroll
        for (int ai = 0; ai < 2; ++ai)
#pragma unroll
            for (int m = 0; m < 4; ++m) { const int row = row0 + ai * HALF + m * 16;
                const float rs = rsv[ai][m];
                if (H == 27) continue;
                if (H == 26) {
                    if (fq < 3) {
#pragma unroll
                        for (int n = 0; n < 2; ++n) { f32x4 gv4; const float nrs = -rs * kLog2e;
#pragma unroll
                            for (int i = 0; i < 4; ++i) gv4[i] = __builtin_amdgcn_rcpf(1.0f + __builtin_amdgcn_exp2f(acc[ai][0][m][n][i] * nrs));
                            *(f32x4*)(GT + (size_t)row * 32 + 8 * fq + 4 * n) = gv4; }
                    }
                    continue;
                }
                float f = rs;
                if (gain) { float ss = 0.f;
#pragma unroll
                    for (int bj = 0; bj < 2; ++bj)
#pragma unroll
                        for (int n = 0; n < 2; ++n) { const f32x4 q = acc[ai][bj][m][n]; ss += (q[0] * q[0] + q[1] * q[1]) + (q[2] * q[2] + q[3] * q[3]); }
                    ss += __shfl_xor(ss, 16); ss += __shfl_xor(ss, 32); f = rs * __builtin_amdgcn_rsqf(ss * (rs * rs) * (1.0f / 64.0f) + 1e-6f); }
                const int b = row / seq, s = row % seq;
                bf16_t* rowp = dst + ((size_t)(b * nh + hh) * seq + s) * 64 + 8 * fq;
#pragma unroll
                for (int bj = 0; bj < 2; ++bj) { const f32x4 v0 = acc[ai][bj][m][0] * gv[bj][0] * f, v1 = acc[ai][bj][m][1] * gv[bj][1] * f; u32x4 w;
                    w.x = cvt_pk_bf16(v0[0], v0[1]); w.y = cvt_pk_bf16(v0[2], v0[3]); w.z = cvt_pk_bf16(v1[0], v1[1]); w.w = cvt_pk_bf16(v1[2], v1[3]);
                    *(u32x4*)(rowp + 32 * bj) = w; } }
    }
};
struct EpiProjT {
    static constexpr bool PERM = true, AFTER_DRAIN = false;
    const float* ssq; bf16_t* VT0; size_t vstride; int seq;
    __device__ __forceinline__ void operator()(const f32x4 (&acc)[2][2][4][2], const Unit& u, int wr, int wc, int fr, int fq) const {
#pragma unroll
        for (int bj = 0; bj < 2; ++bj) { const int t0 = u.pn * BM + bj * HALF + wc * 32 + 8 * fq;
            float q8[8];
#pragma unroll
            for (int i = 0; i < 8; ++i) q8[i] = ssq[(size_t)(t0 + i) * 16 + fr];
#pragma unroll
            for (int i = 0; i < 8; ++i) { float q = q8[i]; q += __shfl_xor(q, 1); q += __shfl_xor(q, 2); q += __shfl_xor(q, 4); q += __shfl_xor(q, 8); q8[i] = __builtin_amdgcn_rsqf(q * (1.0f / 1024.0f) + 1e-6f); }
            const f32x4 r0 = {q8[0], q8[1], q8[2], q8[3]}, r1 = {q8[4], q8[5], q8[6], q8[7]};
            const int b = t0 / seq, s = t0 % seq;
#pragma unroll
            for (int ai = 0; ai < 2; ++ai) { const int vh = 4 * u.pm + 2 * ai + wr; if (vh >= 6) continue;
                bf16_t* dst = VT0 + (size_t)(vh >> 1) * vstride; const int g = vh & 1;
                bf16_t* blk = dst + ((size_t)(b * 2 + g) * (seq / 32) + (s >> 5)) * 2048 + (s & 31);
#pragma unroll
                for (int m = 0; m < 4; ++m) { const int d = 16 * m + fr; const f32x4 v0 = acc[ai][bj][m][0] * r0, v1 = acc[ai][bj][m][1] * r1; u32x4 w;
                    w.x = cvt_pk_bf16(v0[0], v0[1]); w.y = cvt_pk_bf16(v0[2], v0[3]); w.z = cvt_pk_bf16(v1[0], v1[1]); w.w = cvt_pk_bf16(v1[2], v1[3]);
                    { const auto s0 = __builtin_amdgcn_permlane16_swap(w.x, w.z, false, false), s1 = __builtin_amdgcn_permlane16_swap(w.y, w.w, false, false); w.x = s0[0]; w.z = s0[1]; w.y = s1[0]; w.w = s1[1]; }
                    *(u32x4*)(blk + d * 32) = w; } } }
    }
};
struct OneUnit {
    int pm, pn;
    __device__ __forceinline__ bool next(int i, Unit& u) const { if (i) return false; u.pm = pm; u.pn = pn; return true; }
    __device__ __forceinline__ void a_ready(const Unit&) const {}
    __device__ __forceinline__ void done(const Unit&) const {}
};
template <class Epi, class Sched, bool ALIGN_EPI = false, bool SP2 = false, bool AHALF = false>
__device__ __forceinline__ void gemm_phase(PG8_LAS unsigned char* lds, const Gemm g, const Sched& S, const Epi& E, int wv  ) {
    static_assert(!AHALF || SP2, "AHALF is written for the SP2 loop");
    const int wid = wv, lane = hw_lane_id(), tid = wid * 64 + lane, wr = wid >> 2, wc = wid & 3, fr = lane & 15, fq = lane >> 4;
    const int K = g.K, nt = K / BK;
    unsigned voffA[2], voffB[2];
#pragma unroll
    for (int i = 0; i < 2; ++i) { int R, C; stage_rc(tid * 16 + i * 8192, R, C); const int Rb = Epi::PERM ? ((R & ~31) + perm32(R & 31)) : R;
        voffA[i] = (unsigned)(R * K + C) * 2u; voffB[i] = (unsigned)(Rb * K + C) * 2u; }
    const size_t kstep = (size_t)(BK * 2);
    const size_t hstep = (size_t)HALF * K * 2;
    const size_t tstep = 2 * hstep;
    const unsigned ldsw = (unsigned)wid * 1024u;
    const int aoff = lds_byte(wr * 64 + fr, fq * 8), boff = lds_byte(wc * 32 + fr, fq * 8);
#define PG8_SA(b, h) (((b) * 2 + (h)) * HTB)
#define PG8_SB(b, h) ((4 + (b) * 2 + (h)) * HTB)
#define PG8_STAGE(bufoff, gbase, voff) do { _Pragma("unroll") for (int _i = 0; _i < 2; ++_i) \
        __builtin_amdgcn_global_load_lds((const unsigned*)((const char*)(gbase) + (voff)[_i]), (PG8_LAS unsigned*)(lds + (bufoff) + ldsw + _i * 8192), 16, 0, 0); } while (0)
#define PG8_LDA(dst, b, h) do { _Pragma("unroll") for (int m = 0; m < 4; ++m) _Pragma("unroll") for (int k = 0; k < 2; ++k) dst[m][k] = *(const PG8_LAS bf16x8*)(lds + PG8_SA(b, h) + aoff + m * 2048 + k * 1024); } while (0)
#define PG8_LDB(dst, b, h) do { _Pragma("unroll") for (int n = 0; n < 2; ++n) _Pragma("unroll") for (int k = 0; k < 2; ++k) dst[n][k] = *(const PG8_LAS bf16x8*)(lds + PG8_SB(b, h) + boff + n * 2048 + k * 1024); } while (0)
#define PG8_MMA(ai, bj, At, Bt) do { __builtin_amdgcn_s_setprio(1); _Pragma("unroll") for (int m = 0; m < 4; ++m) _Pragma("unroll") for (int n = 0; n < 2; ++n) _Pragma("unroll") for (int k = 0; k < 2; ++k) \
        acc[ai][bj][m][n] = __builtin_amdgcn_mfma_f32_16x16x32_bf16(Bt[n][k], At[m][k], acc[ai][bj][m][n], 0, 0, 0); __builtin_amdgcn_s_setprio(0); } while (0)
#define PG8_WAIT_V(n) asm volatile("s_waitcnt vmcnt(" #n ")" ::: "memory")
#define PG8_WAIT_L(n) asm volatile("s_waitcnt lgkmcnt(" #n ")" ::: "memory")
#define PG8_BAR __builtin_amdgcn_s_barrier()
#define PG8_SCHED __builtin_amdgcn_sched_barrier(0)
    Unit cur, nxt; int ui = 0;
    if (!S.next(0, cur)) return;
    f32x4 acc[2][2][4][2];
#pragma unroll
    for (int a = 0; a < 2; ++a)
#pragma unroll
        for (int b = 0; b < 2; ++b)
#pragma unroll
            for (int m = 0; m < 4; ++m)
#pragma unroll
                for (int n = 0; n < 2; ++n) acc[a][b][m][n] = (f32x4){0.f, 0.f, 0.f, 0.f};
    bf16x8 At[4][2], B0[2][2], B1[2][2];
    const char* cA = (const char*)g.A + (size_t)cur.pm * tstep; const char* cB = (const char*)g.Bt + (size_t)cur.pn * tstep;
    S.a_ready(cur);
    if constexpr (SP2) {
        PG8_STAGE(PG8_SB(0, 0), cB, voffB); PG8_STAGE(PG8_SB(0, 1), cB + hstep, voffB); PG8_STAGE(PG8_SA(0, 0), cA, voffA); PG8_STAGE(PG8_SA(0, 1), cA + hstep, voffA);
        if (wr == 1) PG8_BAR;
        PG8_WAIT_V(2); PG8_BAR;
        PG8_STAGE(PG8_SB(1, 0), cB + kstep, voffB); PG8_STAGE(PG8_SA(1, 0), cA + kstep, voffA); PG8_STAGE(PG8_SB(1, 1), cB + hstep + kstep, voffB);
        PG8_WAIT_V(6); PG8_BAR;
    } else {
        PG8_STAGE(PG8_SB(0, 0), cB, voffB); PG8_STAGE(PG8_SA(0, 0), cA, voffA); PG8_STAGE(PG8_SB(0, 1), cB + hstep, voffB); PG8_STAGE(PG8_SA(0, 1), cA + hstep, voffA);
        if (wr == 1) PG8_BAR;
        PG8_WAIT_V(4); PG8_BAR;
        PG8_STAGE(PG8_SB(1, 0), cB + kstep, voffB); PG8_STAGE(PG8_SA(1, 0), cA + kstep, voffA); PG8_STAGE(PG8_SB(1, 1), cB + hstep + kstep, voffB);
        PG8_WAIT_V(6); PG8_BAR;
    }
    for (;;) {
        const bool has_next = S.next(ui + 1, nxt);
        const char* nA = has_next ? (const char*)g.A + (size_t)nxt.pm * tstep : cA; const char* nB = has_next ? (const char*)g.Bt + (size_t)nxt.pn * tstep : cB;
        for (int t = 0; t < nt; t += 2) {
            const bool last = (t == nt - 2);
            const char* a1 = cA + (size_t)(t + 1) * kstep;
            const char* a2 = last ? nA : cA + (size_t)(t + 2) * kstep; const char* b2 = last ? nB : cB + (size_t)(t + 2) * kstep;
            const char* a3 = a2 + kstep; const char* b3 = b2 + kstep;
            if (last && has_next) S.a_ready(nxt);
            if constexpr (SP2) {
            PG8_LDB(B0, 0, 0); PG8_LDB(B1, 0, 1); PG8_SCHED; PG8_LDA(At, 0, 0); PG8_STAGE(PG8_SA(1, 1), a1 + hstep, voffA);
            PG8_WAIT_V(8); PG8_WAIT_L(0); PG8_BAR; PG8_MMA(0, 0, At, B0); PG8_MMA(0, 1, At, B1); PG8_BAR; PG8_SCHED;
            if constexpr (!AHALF) PG8_LDA(At, 0, 1);
            PG8_STAGE(PG8_SB(0, 0), b2, voffB); PG8_STAGE(PG8_SB(0, 1), b2 + hstep, voffB); PG8_STAGE(PG8_SA(0, 0), a2, voffA);
            PG8_WAIT_V(8); PG8_WAIT_L(0); PG8_BAR; if constexpr (!AHALF) { PG8_MMA(1, 0, At, B0); PG8_MMA(1, 1, At, B1); } PG8_BAR; PG8_SCHED;
            PG8_LDB(B0, 1, 0); PG8_LDB(B1, 1, 1); PG8_SCHED; PG8_LDA(At, 1, 0); PG8_STAGE(PG8_SA(0, 1), a2 + hstep, voffA);
            PG8_WAIT_V(8); PG8_WAIT_L(0); PG8_BAR; PG8_MMA(0, 0, At, B0); PG8_MMA(0, 1, At, B1); PG8_BAR; PG8_SCHED;
            if constexpr (!AHALF) PG8_LDA(At, 1, 1);
            PG8_STAGE(PG8_SB(1, 0), b3, voffB); PG8_STAGE(PG8_SB(1, 1), b3 + hstep, voffB); PG8_STAGE(PG8_SA(1, 0), a3, voffA);
            PG8_WAIT_V(8); PG8_WAIT_L(0); PG8_BAR; if constexpr (!AHALF) { PG8_MMA(1, 0, At, B0); PG8_MMA(1, 1, At, B1); } PG8_BAR; PG8_SCHED;
            } else {
            PG8_LDB(B0, 0, 0); PG8_SCHED; PG8_LDA(At, 0, 0); PG8_STAGE(PG8_SA(1, 1), a1 + hstep, voffA);
            PG8_WAIT_L(8); PG8_BAR; PG8_WAIT_L(0); PG8_MMA(0, 0, At, B0); PG8_BAR; PG8_SCHED;
            PG8_LDB(B1, 0, 1); PG8_STAGE(PG8_SB(0, 0), b2, voffB);
            PG8_BAR; PG8_WAIT_L(0); PG8_MMA(0, 1, At, B1); PG8_BAR;
            PG8_LDA(At, 0, 1); PG8_STAGE(PG8_SA(0, 0), a2, voffA);
            PG8_BAR; PG8_WAIT_L(0); PG8_MMA(1, 0, At, B0); PG8_BAR; PG8_SCHED;
            PG8_STAGE(PG8_SB(0, 1), b2 + hstep, voffB);
            PG8_WAIT_V(6); PG8_BAR; PG8_MMA(1, 1, At, B1); PG8_BAR;
            PG8_LDB(B0, 1, 0); PG8_SCHED; PG8_LDA(At, 1, 0); PG8_STAGE(PG8_SA(0, 1), a2 + hstep, voffA);
            PG8_WAIT_L(8); PG8_BAR; PG8_WAIT_L(0); PG8_MMA(0, 0, At, B0); PG8_BAR; PG8_SCHED;
            PG8_LDB(B1, 1, 1); PG8_STAGE(PG8_SB(1, 0), b3, voffB);
            PG8_BAR; PG8_WAIT_L(0); PG8_MMA(0, 1, At, B1); PG8_BAR;
            PG8_LDA(At, 1, 1); PG8_STAGE(PG8_SA(1, 0), a3, voffA);
            PG8_BAR; PG8_WAIT_L(0); PG8_MMA(1, 0, At, B0); PG8_BAR; PG8_SCHED;
            PG8_STAGE(PG8_SB(1, 1), b3 + hstep, voffB);
            PG8_WAIT_V(6); PG8_BAR; PG8_MMA(1, 1, At, B1); PG8_BAR;
            }
        }
        if constexpr (ALIGN_EPI) { if (wr == 0) PG8_BAR; }
        if constexpr (!Epi::AFTER_DRAIN) { E(acc, cur, wr, wc, fr, fq); S.done(cur); }
        if (!has_next) break;
#pragma unroll
        for (int a = 0; a < 2; ++a)
#pragma unroll
            for (int b = 0; b < 2; ++b)
#pragma unroll
                for (int m = 0; m < 4; ++m)
#pragma unroll
                    for (int n = 0; n < 2; ++n) acc[a][b][m][n] = (f32x4){0.f, 0.f, 0.f, 0.f};
        cur = nxt; cA = nA; cB = nB; ++ui;
        if constexpr (ALIGN_EPI) { if (wr == 1) PG8_BAR; }
    }
    PG8_WAIT_V(0);
    if constexpr (!ALIGN_EPI) { if (wr == 0) PG8_BAR; }
    PG8_BAR;
    if constexpr (Epi::AFTER_DRAIN) { E.fused(acc, cur, wr, wc, fr, fq, lds, wid, lane); S.done(cur); }
#undef PG8_SA
#undef PG8_SB
#undef PG8_STAGE
#undef PG8_LDA
#undef PG8_LDB
#undef PG8_MMA
#undef PG8_WAIT_V
#undef PG8_WAIT_L
#undef PG8_BAR
#undef PG8_SCHED
}
}
#define GAS __attribute__((address_space(1)))
#define LAS __attribute__((address_space(3)))
typedef unsigned short bf16;
typedef unsigned v4u __attribute__((ext_vector_type(4)));
typedef float f32x4 __attribute__((ext_vector_type(4)));
typedef short bf16x8 __attribute__((ext_vector_type(8)));
typedef GAS unsigned gu32;
typedef GAS unsigned long long gu64;
#define RLX_AGENT __ATOMIC_RELAXED, __HIP_MEMORY_SCOPE_AGENT
#define LDS_WAIT() asm volatile("s_waitcnt lgkmcnt(0)" ::: "memory")
#define VM_WAIT() asm volatile("s_waitcnt vmcnt(0)" ::: "memory")
__device__ __forceinline__ unsigned long long rt() { return __builtin_amdgcn_s_memrealtime(); }
__device__ __forceinline__ unsigned f2bf(float f) { unsigned u = __builtin_bit_cast(unsigned, f); return (u + 0x7fffu + ((u >> 16) & 1u)) >> 16; }
__device__ __forceinline__ unsigned pk2(float lo, float hi) { return f2bf(lo) | (f2bf(hi) << 16); }

#define XB_TMO      128
#define XB_XCNT(j)  (256  + 64 * (j))
#define XB_XSUB(j)  (1280 + 64 * (j))
#define XB_XGEN(j)  (2304 + 64 * (j))
#define XB_TOP      3328
#define XB_TOPGEN   3392
#define XCD_BAR_WORDS 3456
#define XB_SPIN_CAP (1u << 18)

__device__ __forceinline__ unsigned xb_ld(unsigned* p)              { return __hip_atomic_load(p, __ATOMIC_RELAXED, __HIP_MEMORY_SCOPE_AGENT); }
__device__ __forceinline__ unsigned xb_add(unsigned* p, unsigned v) { return __hip_atomic_fetch_add(p, v, __ATOMIC_RELAXED, __HIP_MEMORY_SCOPE_AGENT); }
__device__ __forceinline__ unsigned xb_xcc_id() { return (unsigned)__builtin_amdgcn_s_getreg((3 << 11) | 20) & 0xFu; }
#define XB_SPIN(cond, bar) do { unsigned _sp = 0; while (cond) { __builtin_amdgcn_s_sleep(1); \
    if ((++_sp & 255u) == 0u) { if (xb_ld(&(bar)[XB_TMO])) break; if (_sp > XB_SPIN_CAP) { atomicAdd(&(bar)[XB_TMO], 1u); break; } } } } while (0)

struct XcdBarrier {
    unsigned* bar; unsigned x;
    volatile LAS unsigned* st;
};

__device__ __forceinline__ XcdBarrier xcd_barrier_post(unsigned* bar, volatile LAS unsigned* st, bool leader  ) {
    XcdBarrier b; b.bar = bar; b.x = xb_xcc_id(); b.st = st;
    if (leader) (void)xb_add(&bar[XB_XCNT(b.x)], 1u);
    return b;
}
__device__ __forceinline__ void xcd_barrier_complete(unsigned* bar, unsigned x, unsigned& nloc, unsigned& nx) {
    const unsigned G = gridDim.x * gridDim.y * gridDim.z;
    unsigned sum, cnt, mine, sp = 0u;
    for (;;) {
        sum = 0u; cnt = 0u; mine = 0u;
#pragma unroll
        for (unsigned j = 0; j < 16; ++j) { const unsigned c = xb_ld(&bar[XB_XCNT(j)]); sum += c; cnt += (c > 0u) ? 1u : 0u; mine = (j == x) ? c : mine; }
        if (sum == G) break;
        __builtin_amdgcn_s_sleep(1);
        if ((++sp & 255u) == 0u) { if (xb_ld(&bar[XB_TMO])) break; if (sp > XB_SPIN_CAP) { atomicAdd(&bar[XB_TMO], 1u); break; } }
    }
    nloc = mine > 0u ? mine : 1u; nx = cnt > 0u ? cnt : 1u;
}

__device__ __forceinline__ void xcd_barrier(const XcdBarrier& b, bool leader  ) {
    asm volatile("s_waitcnt vmcnt(0)" ::: "memory");
    __syncthreads();
    if (leader) {
        unsigned* bar = b.bar;
        __builtin_amdgcn_s_waitcnt(0);
        unsigned nloc = b.st[0], nx = b.st[1];
        if (nloc == 0u) { xcd_barrier_complete(bar, b.x, nloc, nx); b.st[0] = nloc; b.st[1] = nx; }
        const unsigned old = xb_add(&bar[XB_XSUB(b.x)], 1u);
        const unsigned gen = old / nloc;
        if (old + 1u == (gen + 1u) * nloc) {
            __builtin_amdgcn_fence(__ATOMIC_RELEASE, "agent");
            asm volatile("s_waitcnt vmcnt(0)" ::: "memory");
            const unsigned og = xb_add(&bar[XB_TOP], 1u);
            const unsigned tg = og / nx;
            if (og + 1u == (tg + 1u) * nx) xb_add(&bar[XB_TOPGEN], 1u);
            else XB_SPIN(xb_ld(&bar[XB_TOPGEN]) == tg, bar);
            __builtin_amdgcn_fence(__ATOMIC_ACQUIRE, "agent");
            xb_add(&bar[XB_XGEN(b.x)], 1u);
            asm volatile("s_waitcnt vmcnt(0)" ::: "memory");
        } else {
            XB_SPIN(xb_ld(&bar[XB_XGEN(b.x)]) == gen, bar);
            __builtin_amdgcn_fence(__ATOMIC_ACQUIRE, "agent");
            asm volatile("s_waitcnt vmcnt(0)" ::: "memory");
        }
    }
    __syncthreads();
}

constexpr int NWAVES = 8;
constexpr int BATCH = 8, SEQ = 4096, DM = 1024, FF = 2816, T = BATCH * SEQ;
constexpr float EPS = 1e-6f;
constexpr float LOG2E = 1.4426950408889634f;
constexpr float QSCALE = 0.125f * LOG2E;
constexpr float NEGL = -1.0e9f * LOG2E;
constexpr int NMAIN = 1792;
constexpr int NPLAIN = 2304;

constexpr size_t MiB = 1u << 20, KiB = 1u << 10;
constexpr size_t WS_CTL = 0, CTL_ZERO_BYTES = 64 * KiB;
constexpr size_t WS_WIN1 = 2 * MiB, WS_WOUT1 = 13 * MiB, WS_WIN2 = 19 * MiB, WS_WOUT2 = 30 * MiB, WS_WMAIN = 36 * MiB, WS_WVT = 41 * MiB, WS_WMO = 42 * MiB;
constexpr size_t WS_W1T = 44 * MiB, WS_W2T = 45 * MiB, WS_POSB = 45 * MiB + 64 * KiB, WS_RSTD = 45 * MiB + 128 * KiB, WS_SSQ1 = 46 * MiB, WS_SSQ2 = 48 * MiB, WS_GT = 50 * MiB  , WS_KC = 54 * MiB, WS_VCT = 54 * MiB + 512 * KiB;
constexpr size_t WS_A = 56 * MiB;
constexpr size_t WS_ACT = 120 * MiB;
constexpr size_t WS_QA = 120 * MiB, WS_QB = 152 * MiB, WS_KA = 184 * MiB, WS_KCR = 192 * MiB, WS_VCR = 200 * MiB, WS_KS = 208 * MiB, WS_KW = 216 * MiB, WS_VAT = 224 * MiB, WS_VST = 232 * MiB, WS_VWT = 240 * MiB;
constexpr size_t WS_MIX = 296 * MiB;
constexpr size_t WS_PROJ = 360 * MiB;
constexpr size_t WS_END = 504 * MiB;
constexpr int CW_BAR = 4096;

constexpr int RING_OFF = 0, RING_BYTES = 131072;
constexpr int LDSCTL_OFF = RING_BYTES, MISC_OFF = LDSCTL_OFF + 320;
constexpr int LDS_BYTES = 147456;

typedef unsigned short bf16;
__device__ __forceinline__ float bf2f(bf16 v) { return __uint_as_float(((unsigned)v) << 16); }
__device__ __forceinline__ float wave_sum(float v) {
#pragma unroll
    for (int o = 1; o < 64; o <<= 1) v += __shfl_xor(v, o);
    return v;
}
__device__ __forceinline__ float wave_max(float v) {
#pragma unroll
    for (int o = 1; o < 64; o <<= 1) v = fmaxf(v, __shfl_xor(v, o));
    return v;
}
__device__ __forceinline__ int t5_bucket(int n) {
    if (n < 16) return n < 0 ? 0 : n;
    const int b = 16 + (int)(__log2f((float)n * 0.0625f) * (16.0f / 3.0f));
    return b > 31 ? 31 : b;
}
struct Frame {
    LAS unsigned char* lds; volatile LAS unsigned* MISC; gu32* ctl;
    int tid, lane, wave, vcu, G;
};

__global__ void __launch_bounds__(256) nv_rmsnorm(const float* x, const float* g, bf16* out) {
    const int lane = threadIdx.x & 63, row = blockIdx.x * 4 + (threadIdx.x >> 6);
    const f32x4* xr = (const f32x4*)(x + (size_t)row * DM) + lane; const f32x4* gr = (const f32x4*)g + lane;
    f32x4 v[4]; float s = 0.f;
#pragma unroll
    for (int j = 0; j < 4; ++j) { v[j] = xr[64 * j]; s += (v[j].x * v[j].x + v[j].y * v[j].y) + (v[j].z * v[j].z + v[j].w * v[j].w); }
    const float rstd = 1.0f / sqrtf(wave_sum(s) * (1.f / DM) + EPS);
    unsigned long long* o8 = (unsigned long long*)(out + (size_t)row * DM) + lane;
#pragma unroll
    for (int j = 0; j < 4; ++j) { const f32x4 gg = gr[64 * j]; o8[64 * j] = (unsigned long long)pk2(v[j].x * rstd * gg.x, v[j].y * rstd * gg.y) | ((unsigned long long)pk2(v[j].z * rstd * gg.z, v[j].w * rstd * gg.w) << 32); }
}

struct HeadPrep {
    const bf16* proj; const float* ssq;
    const float *qna, *kna, *qnb, *knb;
    bf16 *QA, *QB, *KA, *VAT, *KCR, *VCR, *KS, *VST, *KW, *VWT; float* GT;
};
__global__ void __launch_bounds__(256) nv_headprep(HeadPrep p) {
    const int lane = threadIdx.x & 63, t = blockIdx.x * 4 + (threadIdx.x >> 6), b = t / SEQ, s = t % SEQ;
    float rs = 1.0f;
    if (p.ssq) { float q = p.ssq[(size_t)t * 16 + (lane & 15)]; q += __shfl_xor(q, 1); q += __shfl_xor(q, 2); q += __shfl_xor(q, 4); q += __shfl_xor(q, 8); rs = 1.0f / sqrtf(q * (1.f / DM) + EPS); }
    const bf16* pr = p.proj + (size_t)t * NPLAIN;
    for (int H = 0; H < 32; ++H) {
        const float v = bf2f(pr[H * 64 + lane]) * rs;
        const float* gain = nullptr; float sc = 1.0f; bf16* dst; bool tr = false; int hh, nh;
        if (H < 8) { gain = p.qna; sc = QSCALE; dst = p.QA; hh = H; nh = 8; }
        else if (H < 10) { gain = p.kna; dst = p.KA; hh = H - 8; nh = 2; }
        else if (H < 12) { dst = p.VAT; hh = H - 10; nh = 2; tr = true; }
        else if (H < 20) { gain = p.qnb; sc = QSCALE; dst = p.QB; hh = H - 12; nh = 8; }
        else { const int slot = (H - 20) >> 1; hh = (H - 20) & 1; nh = 2;
            if (slot == 0) dst = p.KCR; else if (slot == 1) dst = p.VCR; else if (slot == 2) { dst = p.KS; gain = p.knb; } else if (slot == 3) { dst = p.VST; tr = true; } else if (slot == 4) { dst = p.KW; gain = p.knb; } else { dst = p.VWT; tr = true; } }
        float y = v;
        if (gain) { const float ss = wave_sum(v * v); y = v * (1.0f / sqrtf(ss * (1.f / 64.f) + EPS)) * gain[lane] * sc; }
        if (!tr) dst[((size_t)(b * nh + hh) * SEQ + s) * 64 + lane] = (bf16)f2bf(y);
        else dst[(((size_t)(b * nh + hh) * (SEQ / 32) + (s >> 5)) * 64 + lane) * 32 + (s & 31)] = (bf16)f2bf(y);
    }
    if (lane < 24) { const float v = bf2f(pr[2048 + lane]) * rs; p.GT[(size_t)t * 32 + lane] = 1.0f / (1.0f + __expf(-v)); }
}

__global__ void __launch_bounds__(128) nv_compress(const bf16* KCR, const bf16* VCR, const float* pos, const float* w1, const float* b1, const float* w2, const float* b2, const float* knb, bf16* KC, bf16* VCT) {
    __shared__ float sh[128];
    const int tid = threadIdx.x; int idx = blockIdx.x; const int c = idx & 255; idx >>= 8; const int g = idx & 1, b = (idx >> 1) & 7, kv = idx >> 4;
    if (c == 255) { if (tid < 64) { if (kv == 0) KC[((size_t)(b * 2 + g) * 256 + c) * 64 + tid] = 0; else VCT[(((size_t)(b * 2 + g) * 8 + (c >> 5)) * 64 + tid) * 32 + (c & 31)] = 0; } return; }
    const bf16* raw = (kv == 0 ? KCR : VCR) + ((size_t)(b * 2 + g) * SEQ + 16 * c) * 64;
    float acc = b1[kv * 128 + tid];
    for (int k = 0; k < 2048; ++k) acc += (bf2f(raw[k]) + pos[kv * 2048 + k]) * w1[((size_t)kv * 2048 + k) * 128 + tid];
    sh[tid] = acc / (1.0f + __expf(-acc));
    __syncthreads();
    if (tid < 64) {
        float o = b2[kv * 64 + tid];
        for (int h = 0; h < 128; ++h) o += sh[h] * w2[((size_t)kv * 128 + h) * 64 + tid];
        if (kv == 0) { const float ss = wave_sum(o * o); const float y = o * (1.0f / sqrtf(ss * (1.f / 64.f) + EPS)) * knb[tid]; KC[((size_t)(b * 2 + g) * 256 + c) * 64 + tid] = (bf16)f2bf(y); }
        else VCT[(((size_t)(b * 2 + g) * 8 + (c >> 5)) * 64 + tid) * 32 + (c & 31)] = (bf16)f2bf(o);
    }
}

__device__ __forceinline__ float vt_at(const bf16* VT, int bg, int nblk, int key, int d) { return bf2f(VT[(((size_t)bg * nblk + (key >> 5)) * 64 + d) * 32 + (key & 31)]); }

__global__ void __launch_bounds__(256) nv_band_a(const bf16* QA, const bf16* KA, const bf16* VAT, const float* tbl, const float* sinks, bf16* mix) {
    __shared__ float sq[4][64], sl[4][128];
    const int lane = threadIdx.x & 63, w = threadIdx.x >> 6; const int s = blockIdx.x % SEQ, bg = blockIdx.x / SEQ, g = bg & 1, b = bg >> 1, head = g * 4 + w;
    sq[w][lane] = bf2f(QA[((size_t)(b * 8 + head) * SEQ + s) * 64 + lane]);
    __syncthreads();
    float lg[2];
#pragma unroll
    for (int j = 0; j < 2; ++j) { const int rel = 64 * j + lane, key = s - rel; float v = NEGL;
        if (key >= 0) { const bf16* kr = KA + ((size_t)bg * SEQ + key) * 64; float dot = 0.f; for (int d = 0; d < 64; ++d) dot += sq[w][d] * bf2f(kr[d]); v = dot + tbl[t5_bucket(rel) * 16 + head] * LOG2E; }
        lg[j] = v; }
    const float sk = sinks[head] * LOG2E;
    const float m = fmaxf(wave_max(fmaxf(lg[0], lg[1])), sk);
    const float p0 = exp2f(lg[0] - m), p1 = exp2f(lg[1] - m);
    const float sum = wave_sum(p0 + p1) + exp2f(sk - m);
    sl[w][lane] = p0; sl[w][64 + lane] = p1;
    __syncthreads();
    float o = 0.f;
    for (int rel = 0; rel < 128; ++rel) { const int key = s - rel; if (key >= 0) o += sl[w][rel] * vt_at(VAT, bg, SEQ / 32, key, lane); }
    mix[(size_t)(b * SEQ + s) * 1024 + head * 64 + lane] = (bf16)f2bf(o / sum);
}

__global__ void __launch_bounds__(256) nv_nsa(const bf16* QB, const bf16* KC, const bf16* VCT, const bf16* KS, const bf16* VST, const bf16* KW, const bf16* VWT, const float* GT, const float* tbl, bf16* mix) {
    __shared__ float sq[4][64], sP[4][256], sL[4][1024]; __shared__ unsigned long long smask;
    const int lane = threadIdx.x & 63, w = threadIdx.x >> 6; const int s = blockIdx.x % SEQ, bg = blockIdx.x / SEQ, g = bg & 1, b = bg >> 1, head = g * 4 + w, tc = 8 + head;
    const int t = b * SEQ + s;
    sq[w][lane] = bf2f(QB[((size_t)(b * 8 + head) * SEQ + s) * 64 + lane]);
    __syncthreads();
    const int ncv = s >= 31 ? ((s - 31) / 16 + 1 > 255 ? 255 : (s - 31) / 16 + 1) : 0;
    float lc[4];
#pragma unroll
    for (int j = 0; j < 4; ++j) { const int c = lane + 64 * j; float v = NEGL;
        if (c < ncv) { const bf16* kr = KC + ((size_t)bg * 256 + c) * 64; float dot = 0.f; for (int d = 0; d < 64; ++d) dot += sq[w][d] * bf2f(kr[d]); v = dot + tbl[t5_bucket(s - (16 * c + 31)) * 16 + tc] * LOG2E; }
        lc[j] = v; }
    {
        const float m = wave_max(fmaxf(fmaxf(lc[0], lc[1]), fmaxf(lc[2], lc[3])));
        float p[4]; float ps = 0.f;
#pragma unroll
        for (int j = 0; j < 4; ++j) { p[j] = (lane + 64 * j < ncv) ? exp2f(lc[j] - m) : 0.f; ps += p[j]; }
        const float inv = 1.0f / fmaxf(wave_sum(ps), 1.1754944e-38f);
#pragma unroll
        for (int j = 0; j < 4; ++j) sP[w][lane + 64 * j] = p[j] * inv;
    }
    __syncthreads();
    float o_cmp = 0.f;
    for (int c = 0; c < ncv; ++c) o_cmp += sP[w][c] * vt_at(VCT, bg, 8, c, lane);
    if (w == 0) {
        const int n = lane, cur = s >> 6; float imp = 0.f;
        for (int c = 4 * n - 1; c <= 4 * n + 3; ++c) if (c >= 0 && c < 255) imp += (sP[0][c] + sP[1][c]) + (sP[2][c] + sP[3][c]);
        const bool valid = n <= cur, forced = (n == 0) || (n == cur) || (n == cur - 1);
        const float score = valid ? imp + (forced ? 1000.0f : 0.0f) : -1.0e9f;
        int rank = 0;
        for (int mm = 0; mm < 64; ++mm) { const float sm = __shfl(score, mm); rank += (sm > score || (sm == score && mm < n)) ? 1 : 0; }
        const unsigned long long mk = __ballot(valid && rank < 16);
        if (lane == 0) smask = mk;
    }
    __syncthreads();
    const unsigned long long mask = smask;
    float o_sel = 0.f;
    {
        int cnt = 0; float mx = NEGL;
        for (int n = 0; n < 64; ++n) if ((mask >> n) & 1ull) { const int key = 64 * n + lane, rel = s - key; float v = NEGL;
            if (rel >= 0) { const bf16* kr = KS + ((size_t)bg * SEQ + key) * 64; float dot = 0.f; for (int d = 0; d < 64; ++d) dot += sq[w][d] * bf2f(kr[d]); v = dot + tbl[t5_bucket(rel) * 16 + tc] * LOG2E; }
            sL[w][cnt * 64 + lane] = v; mx = fmaxf(mx, v); ++cnt; }
        mx = wave_max(mx); float ps = 0.f;
        for (int i = 0; i < cnt; ++i) { const float p = exp2f(sL[w][i * 64 + lane] - mx); sL[w][i * 64 + lane] = p; ps += p; }
        ps = wave_sum(ps);
        __syncthreads();
        int i = 0;
        for (int n = 0; n < 64; ++n) if ((mask >> n) & 1ull) { for (int k = 0; k < 64; ++k) { const int key = 64 * n + k; if (key <= s) o_sel += sL[w][i * 64 + k] * vt_at(VST, bg, SEQ / 32, key, lane); } ++i; }
        o_sel /= ps;
        __syncthreads();
    }
    float o_win = 0.f;
    {
        float mx = NEGL;
        for (int j = 0; j < 8; ++j) { const int rel = 64 * j + lane, key = s - rel; float v = NEGL;
            if (key >= 0) { const bf16* kr = KW + ((size_t)bg * SEQ + key) * 64; float dot = 0.f; for (int d = 0; d < 64; ++d) dot += sq[w][d] * bf2f(kr[d]); v = dot + tbl[t5_bucket(rel) * 16 + tc] * LOG2E; }
            sL[w][rel] = v; mx = fmaxf(mx, v); }
        mx = wave_max(mx); float ps = 0.f;
        for (int j = 0; j < 8; ++j) { const float p = exp2f(sL[w][64 * j + lane] - mx); sL[w][64 * j + lane] = p; ps += p; }
        ps = wave_sum(ps);
        __syncthreads();
        for (int rel = 0; rel < 512; ++rel) { const int key = s - rel; if (key >= 0) o_win += sL[w][rel] * vt_at(VWT, bg, SEQ / 32, key, lane); }
        o_win /= ps;
    }
    const float g0 = GT[(size_t)t * 32 + 0 * 8 + head], g1 = GT[(size_t)t * 32 + 1 * 8 + head], g2 = GT[(size_t)t * 32 + 2 * 8 + head];
    mix[(size_t)t * 1024 + 512 + head * 64 + lane] = (bf16)f2bf(g0 * o_cmp + g1 * o_sel + g2 * o_win);
}

typedef float f32x16 __attribute__((ext_vector_type(16)));
typedef short s16x4 __attribute__((ext_vector_type(4)));
typedef unsigned u32x4v __attribute__((ext_vector_type(4)));
typedef unsigned u32x2v __attribute__((ext_vector_type(2)));
constexpr int LA = 296, OFFA = 231;
constexpr int LB = 680, OFFB = 615;
constexpr int ATT_LUTA_OFF = 0, ATT_LUTB_OFF = 8 * LA * 4, ATT_WSCR_OFF = ATT_LUTB_OFF + 8 * LB * 4, ATT_WSCR_BYTES = 4096;
static_assert(ATT_WSCR_OFF % 16 == 0 && ATT_WSCR_OFF + 8 * ATT_WSCR_BYTES <= RING_BYTES, "attention LDS map");

struct AttP { const bf16 *QA, *QB, *KA, *VAT, *KC, *VCT, *KS, *VST, *KW, *VWT; const float* GT; bf16* mix; };

__device__ __forceinline__ float xhalf_max(float v) { auto rr = __builtin_amdgcn_permlane32_swap(__float_as_uint(v), __float_as_uint(v), false, false); return fmaxf(__uint_as_float(rr[0]), __uint_as_float(rr[1])); }
__device__ __forceinline__ float xhalf_sum(float v) { auto rr = __builtin_amdgcn_permlane32_swap(__float_as_uint(v), __float_as_uint(v), false, false); return __uint_as_float(rr[0]) + __uint_as_float(rr[1]); }
__device__ __forceinline__ float quad_sum(float v) {
    v += __int_as_float(__builtin_amdgcn_mov_dpp(__float_as_int(v), 0xB1, 0xF, 0xF, true));
    v += __int_as_float(__builtin_amdgcn_mov_dpp(__float_as_int(v), 0x4E, 0xF, 0xF, true));
    return v;
}
__device__ __forceinline__ unsigned pkbf(float lo, float hi) { typedef float f2 __attribute__((ext_vector_type(2))); typedef __bf16 b2 __attribute__((ext_vector_type(2))); f2 v = {lo, hi}; b2 b = __builtin_convertvector(v, b2); return __builtin_bit_cast(unsigned, b); }

struct KFrag { bf16x8 k[4]; };
struct VFrag { bf16x8 v[2][2]; };
__device__ __forceinline__ f32x16 qk_tile(const KFrag& kf, const bf16x8 (&qf)[4], f32x16 c) {
#pragma unroll
    for (int s4 = 0; s4 < 4; ++s4) c = __builtin_amdgcn_mfma_f32_32x32x16_bf16(kf.k[s4], qf[s4], c, 0, 0, 0);
    return c;
}
#define ROFF(r) (((r) & 3) + 8 * ((r) >> 2))
__device__ __forceinline__ void store_o(bf16* rowp, const f32x16& r0, const f32x16& r1, int half) {
#pragma unroll
    for (int i = 0; i < 4; ++i) {
        u32x2v w; w.x = pkbf(r0[4 * i], r0[4 * i + 1]); w.y = pkbf(r0[4 * i + 2], r0[4 * i + 3]); *(u32x2v*)(rowp + 8 * i + 4 * half) = w;
        u32x2v z; z.x = pkbf(r1[4 * i], r1[4 * i + 1]); z.y = pkbf(r1[4 * i + 2], r1[4 * i + 3]); *(u32x2v*)(rowp + 32 + 8 * i + 4 * half) = z; }
}

__device__ __forceinline__ void store_o_rows(LAS unsigned char* scr, bf16* base  , const f32x16& r0, const f32x16& r1, int lane) {
    const int col = lane & 31, half = lane >> 5, ql = col >> 2, hd = col & 3, sx = (ql + 4 * (hd >> 1)) & 7;
    LAS unsigned char* wp = scr + ql * 512 + hd * 128 + half * 8;
#pragma unroll
    for (int i = 0; i < 4; ++i) {
        u32x2v w; w.x = pkbf(r0[4 * i], r0[4 * i + 1]); w.y = pkbf(r0[4 * i + 2], r0[4 * i + 3]); *(LAS u32x2v*)(wp + ((i ^ sx) << 4)) = w;
        u32x2v z; z.x = pkbf(r1[4 * i], r1[4 * i + 1]); z.y = pkbf(r1[4 * i + 2], r1[4 * i + 3]); *(LAS u32x2v*)(wp + (((4 + i) ^ sx) << 4)) = z; }
    const int c = lane & 31;
#pragma unroll
    for (int j = 0; j < 4; ++j) { const int row = 2 * j + (lane >> 5), pc = (c & 24) | ((c & 7) ^ ((row + 4 * (c >> 4)) & 7));
        const u32x4v v = *(const LAS u32x4v*)(scr + row * 512 + pc * 16);
        *(u32x4v*)(base + (size_t)row * 1024 + c * 8) = v; }
}

__device__ __forceinline__ void cmp_unit(Frame& F, int u, const bf16* KCR, const bf16* VCR, const bf16* W1T, const bf16* W2T, const float* posb, const float* b2, const float* knb, bf16* KC, bf16* VCT) {
    const int kv = u >> 7, bg = (u >> 3) & 15, strip = u & 7, lane = F.lane, w = F.wave, col = lane & 31, half = lane >> 5;
    const bf16* raw = (kv ? VCR : KCR) + ((size_t)bg * SEQ + 16 * (32 * strip + col)) * 64;
    const bf16* w1 = W1T + (size_t)kv * 128 * 2048;
    f32x16 acc[4];
#pragma unroll
    for (int nt = 0; nt < 4; ++nt)
#pragma unroll
        for (int r = 0; r < 16; ++r) acc[nt][r] = 0.f;
    const int kb = 256 * w;
#pragma unroll 8
    for (int s = 0; s < 16; ++s) { const int k = kb + 16 * s + 8 * half;
        const bf16x8 a = *(const bf16x8*)(raw + k);
#pragma unroll
        for (int nt = 0; nt < 4; ++nt) { const bf16x8 bb = *(const bf16x8*)(w1 + ((size_t)((16 * w + s) * 4 + nt) * 64 + lane) * 8); acc[nt] = __builtin_amdgcn_mfma_f32_32x32x16_bf16(a, bb, acc[nt], 0, 0, 0); } }
    LAS float* part = (LAS float*)(F.lds + RING_OFF);
#pragma unroll
    for (int nt = 0; nt < 4; ++nt)
#pragma unroll
        for (int r = 0; r < 16; ++r) part[w * 4096 + (ROFF(r) + 4 * half) * 128 + 32 * nt + col] = acc[nt][r];
    __syncthreads();
    float hv[8];
#pragma unroll
    for (int j = 0; j < 8; ++j) { const int e = F.tid + 512 * j; float sacc = posb[kv * 128 + (e & 127)];
#pragma unroll
        for (int ww = 0; ww < 8; ++ww) sacc += part[ww * 4096 + e];
        hv[j] = sacc * __builtin_amdgcn_rcpf(1.0f + __builtin_amdgcn_exp2f(-sacc * LOG2E)); }
    __syncthreads();
    LAS bf16* hid = (LAS bf16*)(F.lds + RING_OFF);
#pragma unroll
    for (int j = 0; j < 8; ++j) hid[F.tid + 512 * j] = (bf16)f2bf(hv[j]);
    __syncthreads();
    if (w == 0) {
        f32x16 o[2];
#pragma unroll
        for (int nt = 0; nt < 2; ++nt)
#pragma unroll
            for (int r = 0; r < 16; ++r) o[nt][r] = 0.f;
        const bf16* w2 = W2T + (size_t)kv * 64 * 128;
#pragma unroll
        for (int s = 0; s < 8; ++s) { const bf16x8 a = *(const LAS bf16x8*)(hid + col * 128 + 16 * s + 8 * half);
#pragma unroll
            for (int nt = 0; nt < 2; ++nt) { const bf16x8 bb = *(const bf16x8*)(w2 + (32 * nt + col) * 128 + 16 * s + 8 * half); o[nt] = __builtin_amdgcn_mfma_f32_32x32x16_bf16(a, bb, o[nt], 0, 0, 0); } }
        const float bi0 = b2[kv * 64 + col], bi1 = b2[kv * 64 + 32 + col];
        if (kv == 0) {
            const float k0 = knb[col], k1 = knb[32 + col];
#pragma unroll
            for (int r = 0; r < 16; ++r) { const float v0 = o[0][r] + bi0, v1 = o[1][r] + bi1; float ss = v0 * v0 + v1 * v1;
                ss += __shfl_xor(ss, 1); ss += __shfl_xor(ss, 2); ss += __shfl_xor(ss, 4); ss += __shfl_xor(ss, 8); ss += __shfl_xor(ss, 16);
                const float f = __builtin_amdgcn_rsqf(ss * (1.0f / 64.0f) + EPS); const int c = 32 * strip + ROFF(r) + 4 * half; const bool z = (c == 255);
                bf16* kp = KC + ((size_t)bg * 256 + c) * 64;
                kp[col] = z ? (bf16)0 : (bf16)f2bf(v0 * f * k0); kp[32 + col] = z ? (bf16)0 : (bf16)f2bf(v1 * f * k1); }
        } else {
#pragma unroll
            for (int nt = 0; nt < 2; ++nt) { const float bi = nt ? bi1 : bi0;
#pragma unroll
                for (int i = 0; i < 4; ++i) { const int cl = 8 * i + 4 * half; const bool zl = (32 * strip + cl + 3 == 255);
                    const int pos = 8 * (2 * (i >> 1) + half) + 4 * (i & 1);
                    u32x2v wv; wv.x = pkbf(o[nt][4 * i] + bi, o[nt][4 * i + 1] + bi); wv.y = pkbf(o[nt][4 * i + 2] + bi, zl ? 0.f : o[nt][4 * i + 3] + bi);
                    *(u32x2v*)(VCT + (((size_t)bg * 8 + strip) * 64 + 32 * nt + col) * 32 + pos) = wv; } }
        }
    }
    __syncthreads();
}

__device__ __forceinline__ void cmp_unit2(Frame& F, int u, const bf16* KCR, const bf16* VCR, const bf16* W1T, const bf16* W2T, const float* posb, const float* b2, const float* knb, bf16* KC, bf16* VCT) {
    const int kv = u >> 7, bg = (u >> 3) & 15, strip0 = u & 7, lane = F.lane, w = F.wave, col = lane & 31, half = lane >> 5;
    const bf16* raw = (kv ? VCR : KCR) + ((size_t)bg * SEQ + 16 * (32 * strip0 + col)) * 64;
    const bf16* w1 = W1T + (size_t)kv * 128 * 2048;
    f32x16 acc2[2][4];
#pragma unroll
    for (int hh = 0; hh < 2; ++hh)
#pragma unroll
    for (int nt = 0; nt < 4; ++nt)
#pragma unroll
        for (int r = 0; r < 16; ++r) acc2[hh][nt][r] = 0.f;
    const int kb = 256 * w;
#pragma unroll 4
    for (int s = 0; s < 16; ++s) { const int k = kb + 16 * s + 8 * half;
        const bf16x8 a0 = *(const bf16x8*)(raw + k), a1 = *(const bf16x8*)(raw + 32 * 16 * 64 + k);
#pragma unroll
        for (int nt = 0; nt < 4; ++nt) { const bf16x8 bb = *(const bf16x8*)(w1 + ((size_t)((16 * w + s) * 4 + nt) * 64 + lane) * 8);
            acc2[0][nt] = __builtin_amdgcn_mfma_f32_32x32x16_bf16(a0, bb, acc2[0][nt], 0, 0, 0); acc2[1][nt] = __builtin_amdgcn_mfma_f32_32x32x16_bf16(a1, bb, acc2[1][nt], 0, 0, 0); } }
#pragma unroll
    for (int hh = 0; hh < 2; ++hh) { const int strip = strip0 + hh; f32x16 (&acc)[4] = acc2[hh];
    LAS float* part = (LAS float*)(F.lds + RING_OFF);
#pragma unroll
    for (int nt = 0; nt < 4; ++nt)
#pragma unroll
        for (int r = 0; r < 16; ++r) part[w * 4096 + (ROFF(r) + 4 * half) * 128 + 32 * nt + col] = acc[nt][r];
    __syncthreads();
    float hv[8];
#pragma unroll
    for (int j = 0; j < 8; ++j) { const int e = F.tid + 512 * j; float sacc = posb[kv * 128 + (e & 127)];
#pragma unroll
        for (int ww = 0; ww < 8; ++ww) sacc += part[ww * 4096 + e];
        hv[j] = sacc * __builtin_amdgcn_rcpf(1.0f + __builtin_amdgcn_exp2f(-sacc * LOG2E)); }
    __syncthreads();
    LAS bf16* hid = (LAS bf16*)(F.lds + RING_OFF);
#pragma unroll
    for (int j = 0; j < 8; ++j) hid[F.tid + 512 * j] = (bf16)f2bf(hv[j]);
    __syncthreads();
    if (w == 0) {
        f32x16 o[2];
#pragma unroll
        for (int nt = 0; nt < 2; ++nt)
#pragma unroll
            for (int r = 0; r < 16; ++r) o[nt][r] = 0.f;
        const bf16* w2 = W2T + (size_t)kv * 64 * 128;
#pragma unroll
        for (int s = 0; s < 8; ++s) { const bf16x8 a = *(const LAS bf16x8*)(hid + col * 128 + 16 * s + 8 * half);
#pragma unroll
            for (int nt = 0; nt < 2; ++nt) { const bf16x8 bb = *(const bf16x8*)(w2 + (32 * nt + col) * 128 + 16 * s + 8 * half); o[nt] = __builtin_amdgcn_mfma_f32_32x32x16_bf16(a, bb, o[nt], 0, 0, 0); } }
        const float bi0 = b2[kv * 64 + col], bi1 = b2[kv * 64 + 32 + col];
        if (kv == 0) {
            const float k0 = knb[col], k1 = knb[32 + col];
#pragma unroll
            for (int r = 0; r < 16; ++r) { const float v0 = o[0][r] + bi0, v1 = o[1][r] + bi1; float ss = v0 * v0 + v1 * v1;
                ss += __shfl_xor(ss, 1); ss += __shfl_xor(ss, 2); ss += __shfl_xor(ss, 4); ss += __shfl_xor(ss, 8); ss += __shfl_xor(ss, 16);
                const float f = __builtin_amdgcn_rsqf(ss * (1.0f / 64.0f) + EPS); const int c = 32 * strip + ROFF(r) + 4 * half; const bool z = (c == 255);
                bf16* kp = KC + ((size_t)bg * 256 + c) * 64;
                kp[col] = z ? (bf16)0 : (bf16)f2bf(v0 * f * k0); kp[32 + col] = z ? (bf16)0 : (bf16)f2bf(v1 * f * k1); }
        } else {
#pragma unroll
            for (int nt = 0; nt < 2; ++nt) { const float bi = nt ? bi1 : bi0;
#pragma unroll
                for (int i = 0; i < 4; ++i) { const int cl = 8 * i + 4 * half; const bool zl = (32 * strip + cl + 3 == 255);
                    const int pos = 8 * (2 * (i >> 1) + half) + 4 * (i & 1);
                    u32x2v wv; wv.x = pkbf(o[nt][4 * i] + bi, o[nt][4 * i + 1] + bi); wv.y = pkbf(o[nt][4 * i + 2] + bi, zl ? 0.f : o[nt][4 * i + 3] + bi);
                    *(u32x2v*)(VCT + (((size_t)bg * 8 + strip) * 64 + 32 * nt + col) * 32 + pos) = wv; } }
        }
    }
    __syncthreads();
    }
}

constexpr int ATT2_KV_OFF = 65536;
static_assert(ATT_WSCR_OFF + 8 * ATT_WSCR_BYTES <= ATT2_KV_OFF && ATT2_KV_OFF + 65536 <= RING_BYTES, "attention-2 LDS map");
constexpr float ATT_THR = 6.0f;

__device__ __forceinline__ unsigned stage_goff(int tid) {
    const int t = tid & 255, key = 8 * (t >> 6) + ((t & 15) >> 1), c = 2 * ((t >> 4) & 3) + (t & 1);
    const int row = 16 * (t >> 6) + 8 * ((t >> 5) & 1) + ((t & 15) >> 1), p = 2 * ((t >> 4) & 1) + (t & 1);
    return __builtin_amdgcn_readfirstlane(tid) < 256 ? (unsigned)(key * 128 + c * 16) : (unsigned)(row * 64 + p * 16);
}
__device__ __forceinline__ u32x4v tile_load(const bf16* Kt, const bf16* Vt, int tid) {
    const bool isk = __builtin_amdgcn_readfirstlane(tid) < 256;
    const char* sbase = (const char*)(isk ? Kt : Vt);
    return *(const u32x4v*)(sbase + stage_goff(tid));
}
__device__ __forceinline__ unsigned stage_loff(int tid) {
    const int t = tid & 255;
    if (__builtin_amdgcn_readfirstlane(tid) < 256) { const int key = 8 * (t >> 6) + ((t & 15) >> 1), c = 2 * ((t >> 4) & 3) + (t & 1);
        return (unsigned)((c >> 1) * 1024 + key * 32 + (((c & 1) ^ ((key >> 3) & 1)) << 4)); }
    const int row = 16 * (t >> 6) + 8 * ((t >> 5) & 1) + ((t & 15) >> 1), p = 2 * ((t >> 4) & 1) + (t & 1);
    return (unsigned)(4096 + (p >> 1) * 2048 + row * 32 + (((p & 1) ^ ((row >> 3) & 1)) << 4));
}
__device__ __forceinline__ void tile_store(LAS unsigned char* buf, u32x4v v, unsigned so) { *(LAS u32x4v*)(buf + so) = v; }
__device__ __forceinline__ __amdgpu_buffer_rsrc_t stage_rsrc(const bf16* Kb, const bf16* Vb, int tid) {
    const bool isk = __builtin_amdgcn_readfirstlane(tid) < 256;
    return __builtin_amdgcn_make_buffer_rsrc((void*)(isk ? Kb : Vb), 0, 0x7FFFFFFF, 0x00020000);
}
__device__ __forceinline__ void pair_load(__amdgpu_buffer_rsrc_t rs, int kt, unsigned loff, u32x4v& a, u32x4v& b) {
    a = __builtin_amdgcn_raw_buffer_load_b128(rs, loff, kt * 4096, 0); b = __builtin_amdgcn_raw_buffer_load_b128(rs, loff, kt * 4096 + 4096, 0);
}
__device__ __forceinline__ void pair_store(LAS unsigned char* buf, const u32x4v& a, const u32x4v& b, unsigned so) { tile_store(buf, a, so); tile_store(buf + 8192, b, so); }
__device__ __forceinline__ int frag_off(int r, int half) { return r * 32 + ((half ^ ((r >> 3) & 1)) << 4); }
__device__ __forceinline__ void lds_k(KFrag& f, const LAS unsigned char* buf, int r, int half) {
    const LAS unsigned char* p = buf + frag_off(r, half);
#pragma unroll
    for (int s4 = 0; s4 < 4; ++s4) f.k[s4] = *(const LAS bf16x8*)(p + s4 * 1024);
}
__device__ __forceinline__ void lds_v(VFrag& f, const LAS unsigned char* buf, int r, int half) {
    const LAS unsigned char* p = buf + 4096 + frag_off(r, half);
#pragma unroll
    for (int dt = 0; dt < 2; ++dt)
#pragma unroll
        for (int s2 = 0; s2 < 2; ++s2) f.v[dt][s2] = *(const LAS bf16x8*)(p + s2 * 2048 + dt * 1024);
}
typedef float f32x2s __attribute__((ext_vector_type(2)));
struct Soft2 { f32x16 o0, o1, lv; float m; f32x2s lf; };
__device__ __forceinline__ void soft2_init(Soft2& st, float m0, float l0) {
#pragma unroll
    for (int r = 0; r < 16; ++r) { st.o0[r] = 0.f; st.o1[r] = 0.f; st.lv[r] = l0; }
    st.m = m0; st.lf = (f32x2s){0.f, 0.f};
}
__device__ __forceinline__ void soft2_acc(f32x16& r0, f32x16& r1, const Soft2& st, float scale) {
    const float f = scale * __builtin_amdgcn_rcpf(fmaxf(st.lv[0], 1.1754944e-38f));
#pragma unroll
    for (int r = 0; r < 16; ++r) { r0[r] += st.o0[r] * f; r1[r] += st.o1[r] * f; }
}
__device__ __forceinline__ void soft_part(Soft2& st, f32x16 s, float cadd, bf16x8& p0, bf16x8& p1) {
    const float nm = cadd - st.m;
#pragma unroll
    for (int r = 0; r < 16; ++r) s[r] += nm;
    float mx = fmaxf(fmaxf(s[0], s[1]), fmaxf(s[2], s[3]));
#pragma unroll
    for (int r = 4; r < 16; r += 4) mx = fmaxf(mx, fmaxf(fmaxf(s[r], s[r + 1]), fmaxf(s[r + 2], s[r + 3])));
    mx = xhalf_max(mx);
    if (__any(mx > ATT_THR)) {
        const float d = fmaxf(mx, 0.f), alpha = __builtin_amdgcn_exp2f(-d);
        st.m += d;
#pragma unroll
        for (int r = 0; r < 16; ++r) { st.o0[r] *= alpha; st.o1[r] *= alpha; st.lv[r] *= alpha; s[r] -= d; }
    }
#pragma unroll
    for (int r = 0; r < 16; ++r) s[r] = __builtin_amdgcn_exp2f(s[r]);
    u32x4v pw0, pw1;
    pw0.x = pkbf(s[0], s[1]); pw0.y = pkbf(s[2], s[3]); pw0.z = pkbf(s[4], s[5]); pw0.w = pkbf(s[6], s[7]);
    pw1.x = pkbf(s[8], s[9]); pw1.y = pkbf(s[10], s[11]); pw1.z = pkbf(s[12], s[13]); pw1.w = pkbf(s[14], s[15]);
    p0 = __builtin_bit_cast(bf16x8, pw0); p1 = __builtin_bit_cast(bf16x8, pw1);
}
__device__ __forceinline__ f32x16 splat16(float v);
template <bool SUMS = true>
__device__ __forceinline__ void pv_part(Soft2& st, const VFrag& vf, const bf16x8 ones, const bf16x8 p0, const bf16x8 p1) {
    st.o0 = __builtin_amdgcn_mfma_f32_32x32x16_bf16(vf.v[0][0], p0, st.o0, 0, 0, 0);
    st.o1 = __builtin_amdgcn_mfma_f32_32x32x16_bf16(vf.v[1][0], p0, st.o1, 0, 0, 0);
    if (SUMS) st.lv = __builtin_amdgcn_mfma_f32_32x32x16_bf16(ones, p0, st.lv, 0, 0, 0);
    st.o0 = __builtin_amdgcn_mfma_f32_32x32x16_bf16(vf.v[0][1], p1, st.o0, 0, 0, 0);
    st.o1 = __builtin_amdgcn_mfma_f32_32x32x16_bf16(vf.v[1][1], p1, st.o1, 0, 0, 0);
    if (SUMS) st.lv = __builtin_amdgcn_mfma_f32_32x32x16_bf16(ones, p1, st.lv, 0, 0, 0);
}
__device__ __forceinline__ void soft_pv2(Soft2& st, f32x16 s, const VFrag& vf, const bf16x8 ones, float cadd = 0.f) {
    bf16x8 p0, p1; soft_part(st, s, cadd, p0, p1); pv_part(st, vf, ones, p0, p1);
}
template <bool MASKED>
__device__ __forceinline__ void soft_fast_pv(Soft2& st, f32x16 s, const VFrag& vf, const bf16x8 ones, unsigned sel) {
#pragma unroll
    for (int r = 0; r < 16; ++r) s[r] = __builtin_amdgcn_exp2f(s[r]);
    {
        f32x2s a0 = (f32x2s){s[0], s[1]} + (f32x2s){s[2], s[3]}, a1 = (f32x2s){s[4], s[5]} + (f32x2s){s[6], s[7]}, a2 = (f32x2s){s[8], s[9]} + (f32x2s){s[10], s[11]}, a3 = (f32x2s){s[12], s[13]} + (f32x2s){s[14], s[15]};
        a0 += a1; a2 += a3; a0 += a2;
        if (MASKED) { const float bf_ = (sel == 0x07060302u) ? 1.0f : 0.0f; st.lf = a0 * (f32x2s){bf_, bf_} + st.lf; } else st.lf += a0;
    }
    u32x4v pw0, pw1;
    if (MASKED) {
        pw0.x = __builtin_amdgcn_perm(__float_as_uint(s[1]), __float_as_uint(s[0]), sel); pw0.y = __builtin_amdgcn_perm(__float_as_uint(s[3]), __float_as_uint(s[2]), sel);
        pw0.z = __builtin_amdgcn_perm(__float_as_uint(s[5]), __float_as_uint(s[4]), sel); pw0.w = __builtin_amdgcn_perm(__float_as_uint(s[7]), __float_as_uint(s[6]), sel);
        pw1.x = __builtin_amdgcn_perm(__float_as_uint(s[9]), __float_as_uint(s[8]), sel); pw1.y = __builtin_amdgcn_perm(__float_as_uint(s[11]), __float_as_uint(s[10]), sel);
        pw1.z = __builtin_amdgcn_perm(__float_as_uint(s[13]), __float_as_uint(s[12]), sel); pw1.w = __builtin_amdgcn_perm(__float_as_uint(s[15]), __float_as_uint(s[14]), sel);
    } else {
        pw0.x = pkbf(s[0], s[1]); pw0.y = pkbf(s[2], s[3]); pw0.z = pkbf(s[4], s[5]); pw0.w = pkbf(s[6], s[7]);
        pw1.x = pkbf(s[8], s[9]); pw1.y = pkbf(s[10], s[11]); pw1.z = pkbf(s[12], s[13]); pw1.w = pkbf(s[14], s[15]);
    }
    pv_part<false>(st, vf, ones, __builtin_bit_cast(bf16x8, pw0), __builtin_bit_cast(bf16x8, pw1));
}
__device__ __forceinline__ f32x16 splat16(float v) { f32x16 s;
#pragma unroll
    for (int r = 0; r < 16; ++r) s[r] = v;
    return s; }

__device__ __forceinline__ f32x16 lut16(const LAS float* lutp) { f32x16 v;
#pragma unroll
    for (int r = 0; r < 16; ++r) v[r] = lutp[ROFF(r)];
    return v; }
template <int MODE, bool FAST>
__device__ __forceinline__ void attn_stream(Soft2& st, const bf16x8 (&qf)[4], const bf16* Kb, const bf16* Vb, int kt0, int np, const LAS float* lut, int q, int s0, unsigned mlo, unsigned mhi, float c31,
                                            LAS unsigned char* kvbuf, int tid, int col, int half, const bf16x8 ones) {
    u32x4v ra, rb;
    const __amdgpu_buffer_rsrc_t rs = stage_rsrc(Kb, Vb, tid); const unsigned loff = stage_goff(tid);
    const unsigned so = stage_loff(tid);
    pair_load(rs, kt0, loff, ra, rb); pair_store(kvbuf, ra, rb, so);
    if (np > 1) { pair_load(rs, kt0 + 2, loff, ra, rb); pair_store(kvbuf + 16384, ra, rb, so); }
    if (np > 2) pair_load(rs, kt0 + 4, loff, ra, rb);
    __syncthreads();
#define ATT_LUTP(KT_) (MODE == 0 ? true : (MODE == 1 ? ((s0 - 32 * (KT_) - 31) < 128) : !((s0 - 32 * (KT_) - 31) >= 128 && (s0 + 7 - 32 * (KT_)) < 512)))
#define ATT_QK(DST_, KT_) do { if (ATT_LUTP(KT_)) DST_ = qk_tile(kf, qf, lut16(lut - (q - 32 * (KT_) - 4 * half))); else DST_ = qk_tile(kf, qf, splat16(0.f)); } while (0)
#define ATT_PROCESS(S_, KT_, VF_) do { const int kt_ = (KT_); float cadd_ = 0.f; bool bit_ = true; \
        if (MODE == 1) { const int i_ = kt_ >> 1; bit_ = (((((unsigned long long)mhi << 32) | mlo) >> i_) & 1ull) != 0ull; cadd_ = bit_ ? 0.f : NEGL; } \
        if (FAST) soft_fast_pv<MODE == 1>(st, S_, VF_, ones, bit_ ? 0x07060302u : 0x0C0C0C0Cu); else soft_pv2(st, S_, VF_, ones, cadd_); } while (0)
    const bool lead = __builtin_amdgcn_readfirstlane(tid) < 256;
    KFrag kf; lds_k(kf, kvbuf, col, half);
    f32x16 sA, sB; ATT_QK(sA, kt0);
    int bo0 = 0, bo1 = 16384, bo2 = 32768;
#define ATT_PAIR(FAR_) do { \
        const LAS unsigned char* pb = kvbuf + bo0; const LAS unsigned char* pbn = kvbuf + bo1; \
        if ((FAR_) || p + 2 < np) pair_store(kvbuf + bo2, ra, rb, so); \
        if ((FAR_) || p + 3 < np) pair_load(rs, kt0 + 2 * p + 6, loff, ra, rb); \
        {     \
            VFrag vf; lds_v(vf, pb, col, half); lds_k(kf, pb + 8192, col, half); \
            if (FAR_) sB = qk_tile(kf, qf, splat16(0.f)); else ATT_QK(sB, kt0 + 2 * p + 1); \
            __builtin_amdgcn_sched_barrier(0); \
            ATT_PROCESS(sA, kt0 + 2 * p, vf); \
        } \
        {     \
            VFrag vf; lds_v(vf, pb + 8192, col, half); \
            if (FAR_) { lds_k(kf, pbn, col, half); sA = qk_tile(kf, qf, splat16(0.f)); } \
            else if (p + 1 < np) { lds_k(kf, pbn, col, half); ATT_QK(sA, kt0 + 2 * p + 2); } \
            __builtin_amdgcn_sched_barrier(0); \
            ATT_PROCESS(sB, kt0 + 2 * p + 1, vf); \
        } \
        __syncthreads(); \
        { const int tb = bo0; bo0 = bo1; bo1 = bo2; bo2 = tb; } } while (0)
    int p = 0;
    if (FAST && MODE != 0) {
        const int ktmax = (s0 - 159) >> 5;
        int pl = 0, ph = ((ktmax - kt0 - 2) >> 1) + 1;
        if (MODE == 2) { const int ktmin = ((s0 - 505) >> 5) + 1; pl = (ktmin - kt0) >> 1; pl = pl < 0 ? 0 : pl; }
        ph = ph > np - 3 ? np - 3 : ph;
#pragma unroll 1
        for (; p < pl && p < np; ++p) ATT_PAIR(false);
#pragma unroll 1
        for (; p < ph; ++p) ATT_PAIR(true);
    }
#pragma unroll 1
    for (; p < np; ++p) ATT_PAIR(false);
#undef ATT_PAIR
    if (FAST) st.lv[0] += xhalf_sum(st.lf.x + st.lf.y);
#undef ATT_LUTP
#undef ATT_QK
#undef ATT_PROCESS
}

struct DeferW { const float *win, *wout, *gain; bf16 *WIN2, *WOUT2; bool on; };
constexpr int DW_IN = 16 * 176, DW_OUT = 44 * 32, DW_SUB = 2 * (DW_IN + DW_OUT);
struct DeferD { const float* W; int ldw, k0, c0, Kd, drow0; bf16* WT; const float* kgain; float cscale; };
__device__ __forceinline__ DeferD defer_decode(const DeferW& dw, int sid) {
    DeferD d; int item = sid >> 1; const int h = sid & 1; d.kgain = nullptr; d.cscale = 1.0f;
    if (item < DW_IN) { const int kb = item / 176, nb = item % 176, pn = nb >> 3, bj = (nb >> 2) & 1, c = 32 * (nb & 3);
        d.W = dw.win; d.ldw = 2 * FF; d.k0 = 64 * kb + 32 * h; d.c0 = (bj ? FF : 0) + 128 * pn + c; d.WT = dw.WIN2; d.Kd = DM; d.drow0 = 32 * nb; d.kgain = dw.gain; d.cscale = bj ? (1.0f / LOG2E) : LOG2E; }
    else { item -= DW_IN; const int kb = item / 32, nb = item % 32;
        d.W = dw.wout; d.ldw = DM; d.k0 = 64 * kb + 32 * h; d.c0 = 32 * nb; d.WT = dw.WOUT2; d.Kd = FF; d.drow0 = 32 * nb; }
    return d;
}
__device__ __forceinline__ void defer_load(const DeferW& dw, int sid, int lane, f32x4 (&v)[4]) {
    const DeferD d = defer_decode(dw, sid); const int c4 = 4 * (lane & 7), rr = lane >> 3;
#pragma unroll
    for (int i = 0; i < 4; ++i) v[i] = *(const GAS f32x4*)(d.W + (size_t)(d.k0 + 8 * i + rr) * d.ldw + d.c0 + c4);
}
__device__ __forceinline__ void defer_finish(const DeferW& dw, int sid, const f32x4 (&v)[4], LAS float* scr, int lane) {
    const DeferD d = defer_decode(dw, sid); const int c4 = 4 * (lane & 7), rr = lane >> 3;
#pragma unroll
    for (int i = 0; i < 4; ++i) { const int kk = 8 * i + rr; const float gk = (d.kgain ? d.kgain[d.k0 + kk] : 1.0f) * d.cscale; LAS float* p = scr + kk * 32;
        p[(c4 + 0) ^ kk] = v[i][0] * gk; p[(c4 + 1) ^ kk] = v[i][1] * gk; p[(c4 + 2) ^ kk] = v[i][2] * gk; p[(c4 + 3) ^ kk] = v[i][3] * gk; }
    LDS_WAIT(); asm volatile("" ::: "memory");
    const int c = lane & 3;
#pragma unroll
    for (int j = 0; j < 2; ++j) { const int n = (lane >> 2) + 16 * j; const LAS float* s = scr + (8 * c) * 32;
        v4u o; o.x = pk2(s[0 * 32 + (n ^ (8 * c + 0))], s[1 * 32 + (n ^ (8 * c + 1))]); o.y = pk2(s[2 * 32 + (n ^ (8 * c + 2))], s[3 * 32 + (n ^ (8 * c + 3))]);
        o.z = pk2(s[4 * 32 + (n ^ (8 * c + 4))], s[5 * 32 + (n ^ (8 * c + 5))]); o.w = pk2(s[6 * 32 + (n ^ (8 * c + 6))], s[7 * 32 + (n ^ (8 * c + 7))]);
        *(GAS v4u*)(d.WT + (size_t)(d.drow0 + n) * d.Kd + d.k0 + 8 * c) = o; }
    LDS_WAIT(); asm volatile("" ::: "memory");
}
__device__ __forceinline__ void defer_subitem(const DeferW& dw, int sid, LAS float* scr, int lane) { f32x4 v[4]; defer_load(dw, sid, lane, v); defer_finish(dw, sid, v, scr, lane); }
template <bool fast>
__device__ __forceinline__ void attn2_unit(Frame& F, const AttP& P, const float* sinks, int b, int g, int blk, const LAS float* lutA, const LAS float* lutB, LAS float* wscr, const DeferW& dw, int dsid) {
    const int w = F.wave; const int lane = hw_lane_id(); const int tid = w * 64 + lane;
    const int col = lane & 31, half = lane >> 5, ql = col >> 2, hd = col & 3, bg = b * 2 + g, sb = 64 * blk, s0 = sb + 8 * w, q = s0 + ql, head8 = g * 4 + hd, t = b * SEQ + q;
    LAS unsigned char* kvbuf = F.lds + RING_OFF + ATT2_KV_OFF;
    const int kt_top = (sb + 63) >> 5, ktw = s0 >> 5;
    Soft2 st; f32x16 r0, r1;
    const bf16x8 ones = (bf16x8){0x3F80, 0x3F80, 0x3F80, 0x3F80, 0x3F80, 0x3F80, 0x3F80, 0x3F80};
    const int ntc_u = (sb + 63 >= 31) ? ((sb + 63 - 31) >> 4) / 32 + 1 : 0;
    u32x4v ctile[8];
    { const bf16* KCb = P.KC + (size_t)bg * 256 * 64; const bf16* VCb = P.VCT + (size_t)bg * 8 * 2048;
#pragma unroll
      for (int kt = 0; kt < 8; ++kt) ctile[kt] = (kt < ntc_u) ? tile_load(KCb + kt * 2048, VCb + kt * 2048, tid) : (u32x4v){0u, 0u, 0u, 0u}; }
    bf16x8 qf[4]; { const bf16* qp = P.QB + ((size_t)(b * 8 + head8) * SEQ + q) * 64 + 8 * half;
#pragma unroll
        for (int s4 = 0; s4 < 4; ++s4) qf[s4] = *(const bf16x8*)(qp + 16 * s4); }
    const float g0 = P.GT[(size_t)t * 32 + head8], g1 = P.GT[(size_t)t * 32 + 8 + head8], g2 = P.GT[(size_t)t * 32 + 16 + head8];
    for (int rp_ = 0; rp_ < (KREP == 51 ? 2 : 1); ++rp_) {
        bf16x8 qfa[4]; { const bf16* qp = P.QA + ((size_t)(b * 8 + head8) * SEQ + q) * 64 + 8 * half;
#pragma unroll
            for (int s4 = 0; s4 < 4; ++s4) qfa[s4] = *(const bf16x8*)(qp + 16 * s4); }
        if (fast) soft2_init(st, 0.f, __builtin_amdgcn_exp2f(sinks[head8] * LOG2E)); else soft2_init(st, sinks[head8] * LOG2E, 1.0f);
        const LAS float* lut = lutA + head8 * LA + OFFA;
        const int kt0 = (sb > 127 ? sb - 127 : 0) >> 5, nt = kt_top - kt0 + 1, ktw_lo = (s0 > 127 ? s0 - 127 : 0) >> 5;
        const bf16* Kb = P.KA + (size_t)bg * SEQ * 64; const bf16* Vb = P.VAT + (size_t)bg * (SEQ / 32) * 2048;
        attn_stream<0, fast>(st, qfa, Kb, Vb, kt0, nt >> 1, lut, q, s0, 0u, 0u, 0.f, kvbuf, tid, col, half, ones);
        r0 = splat16(0.f); r1 = splat16(0.f);
        soft2_acc(r0, r1, st, 1.0f);
        store_o_rows((LAS unsigned char*)wscr, P.mix + (size_t)(b * SEQ + s0) * 1024 + g * 256, r0, r1, lane);
    }
    const LAS float* lut = lutB + head8 * LB + OFFB;
    constexpr float c31 = 0.f;
    r0 = splat16(0.f); r1 = splat16(0.f);
    LAS float* impG = wscr; LAS float* impL = wscr + 512;
    const int ntc = (s0 + 7 >= 31) ? ((s0 + 7 - 31) >> 4) / 32 + 1 : 0;
    { const unsigned so_u = stage_loff(tid);
#pragma unroll
        for (int kt = 0; kt < 8; ++kt) if (kt < ntc_u) tile_store(kvbuf + kt * 8192, ctile[kt], so_u);
        __syncthreads();
    }
    unsigned mlo = 0u, mhi = 0u;
    for (int rp_ = 0; rp_ < (KREP == 52 ? 2 : 1); ++rp_) {
    if constexpr (fast) {
        soft2_init(st, 0.f, 0.f);
        float Gs[8][4], Ls[8][4];
#pragma unroll
        for (int kt = 0; kt < 8; ++kt) {
#pragma unroll
            for (int i = 0; i < 4; ++i) { Gs[kt][i] = 0.f; Ls[kt][i] = 0.f; }
            if (kt < ntc) { const LAS unsigned char* cb = kvbuf + kt * 8192;
                KFrag kf; VFrag vf; lds_k(kf, cb, col, half); lds_v(vf, cb, col, half);
                f32x16 s = qk_tile(kf, qf, splat16(0.f));
                const bool farc = 512 * kt <= s0 - 655;
                if (!farc) { const int basec = q - 31 - 512 * kt - 64 * half;
#pragma unroll
                    for (int r = 0; r < 16; ++r) { int rc = basec - 16 * ROFF(r); rc = rc < -1 ? -1 : (rc > 511 ? 511 : rc); s[r] += lut[-rc]; } }
#pragma unroll
                for (int r = 0; r < 16; ++r) s[r] = __builtin_amdgcn_exp2f(s[r]);
#pragma unroll
                for (int i = 0; i < 4; ++i) { Gs[kt][i] = (s[4 * i] + s[4 * i + 1]) + (s[4 * i + 2] + s[4 * i + 3]); Ls[kt][i] = s[4 * i + 3]; }
                st.lf.x += (Gs[kt][0] + Gs[kt][1]) + (Gs[kt][2] + Gs[kt][3]);
                u32x4v pw0, pw1;
                pw0.x = pkbf(s[0], s[1]); pw0.y = pkbf(s[2], s[3]); pw0.z = pkbf(s[4], s[5]); pw0.w = pkbf(s[6], s[7]);
                pw1.x = pkbf(s[8], s[9]); pw1.y = pkbf(s[10], s[11]); pw1.z = pkbf(s[12], s[13]); pw1.w = pkbf(s[14], s[15]);
                pv_part<false>(st, vf, ones, __builtin_bit_cast(bf16x8, pw0), __builtin_bit_cast(bf16x8, pw1));
            }
        }
        st.lv[0] += xhalf_sum(st.lf.x + st.lf.y);
        soft2_acc(r0, r1, st, rp_ == 0 ? g0 : 0.f);
#pragma unroll
        for (int j = 0; j < 8; ++j) { impG[lane + 64 * j] = 0.f; impL[lane + 64 * j] = 0.f; }
        const float invl = __builtin_amdgcn_rcpf(fmaxf(st.lv[0], 1.1754944e-38f));
#pragma unroll
        for (int kt = 0; kt < 8; ++kt) if (kt < ntc) {
#pragma unroll
            for (int i = 0; i < 4; ++i) {
                const float G = quad_sum(Gs[kt][i] * invl), L = quad_sum(Ls[kt][i] * invl);
                const int n = 8 * kt + 2 * i + half;
                if (hd == 0) { impG[ql * 64 + n] = G; if (n < 63) impL[ql * 64 + n + 1] = L; }
            }
        }
    } else {
    soft2_init(st, 0.f, 0.f);
#pragma unroll 1
    for (int kt = 0; kt < ntc; ++kt) { const LAS unsigned char* cb = kvbuf + kt * 8192;
        KFrag kf; VFrag vf; lds_k(kf, cb, col, half); lds_v(vf, cb, col, half);
        f32x16 s = qk_tile(kf, qf, splat16(0.f));
        const bool farc = 512 * kt <= s0 - 655;
        if (!farc) { const int basec = q - 31 - 512 * kt - 64 * half;
#pragma unroll
            for (int r = 0; r < 16; ++r) { int rc = basec - 16 * ROFF(r); rc = rc < -1 ? -1 : (rc > 511 ? 511 : rc); s[r] += lut[-rc]; } }
        soft_pv2(st, s, vf, ones, farc ? c31 : 0.f);
    }
    soft2_acc(r0, r1, st, rp_ == 0 ? g0 : 0.f);
#pragma unroll
    for (int j = 0; j < 8; ++j) { impG[lane + 64 * j] = 0.f; impL[lane + 64 * j] = 0.f; }
    {
        const float nmfin = -st.m, invl = __builtin_amdgcn_rcpf(fmaxf(st.lv[0], 1.1754944e-38f));
#pragma unroll 1
        for (int kt = 0; kt < ntc; ++kt) { const LAS unsigned char* cb = kvbuf + kt * 8192;
            KFrag kf; lds_k(kf, cb, col, half);
            f32x16 s = qk_tile(kf, qf, splat16(0.f));
            const bool farc = 512 * kt <= s0 - 655;
            if (farc) { const float nmc = nmfin + c31;
#pragma unroll
                for (int r = 0; r < 16; ++r) s[r] = __builtin_amdgcn_exp2f(s[r] + nmc) * invl; }
            else { const int basec = q - 31 - 512 * kt - 64 * half;
#pragma unroll
                for (int r = 0; r < 16; ++r) { int rc = basec - 16 * ROFF(r); rc = rc < -1 ? -1 : (rc > 511 ? 511 : rc); s[r] = __builtin_amdgcn_exp2f(s[r] + lut[-rc] + nmfin) * invl; } }
#pragma unroll
            for (int i = 0; i < 4; ++i) {
                const float G = quad_sum((s[4 * i] + s[4 * i + 1]) + (s[4 * i + 2] + s[4 * i + 3])), L = quad_sum(s[4 * i + 3]);
                const int n = 8 * kt + 2 * i + half;
                if (hd == 0) { impG[ql * 64 + n] = G; if (n < 63) impL[ql * 64 + n + 1] = L; }
            }
        }
    }
    }
#pragma unroll 1
    for (int q4 = 0; q4 < 8; q4 += 4) {
        int key[4]; unsigned long long selv[4]; bool need = false;
#pragma unroll
        for (int i = 0; i < 4; ++i) { const int qq = q4 + i, qs = s0 + qq, cur = qs >> 6, n = lane;
            const float imp = impG[qq * 64 + n] + impL[qq * 64 + n];
            const bool valid = n <= cur, forced = (n == 0) || (n == cur) || (n == cur - 1);
            const float score = imp + (forced ? 1000.0f : 0.0f);
            key[i] = valid ? (__float_as_int(score) & ~63) : (int)0x80000000;
            selv[i] = __ballot(valid); need = need || (cur >= 16); }
        if (need) {
            int T[4] = {0, 0, 0, 0};
#pragma unroll 1
            for (int bitp = 30; bitp >= 6; --bitp) {
#pragma unroll
                for (int i = 0; i < 4; ++i) { const int cand = T[i] | (1 << bitp); const int cnt = __builtin_popcountll(__ballot(key[i] >= cand)); T[i] = (cnt >= 16) ? cand : T[i]; } }
#pragma unroll
            for (int i = 0; i < 4; ++i) { const int cur = (s0 + q4 + i) >> 6;
                if (cur >= 16) { const unsigned long long gt = __ballot(key[i] > T[i]), eq = __ballot(key[i] == T[i]); const int k = 16 - __builtin_popcountll(gt);
                    unsigned long long mm = eq;
#pragma unroll 1
                    for (int j = 0; j < k; ++j) mm &= mm - 1ull;
                    selv[i] = gt | (eq ^ mm); } }
        }
#pragma unroll
        for (int i = 0; i < 4; ++i) if (ql == q4 + i) { mlo = (unsigned)selv[i]; mhi = (unsigned)(selv[i] >> 32); }
    }
    }
#define R0_PARK() do { if (fast) { _Pragma("unroll") for (int k = 0; k < 4; ++k) { f32x4 v_ = {r0[4 * k], r0[4 * k + 1], r0[4 * k + 2], r0[4 * k + 3]}; *(LAS f32x4*)((LAS unsigned char*)wscr + k * 1024 + lane * 16) = v_; } } } while (0)
#define R0_FETCH() do { if (fast) { _Pragma("unroll") for (int k = 0; k < 4; ++k) { const f32x4 v_ = *(const LAS f32x4*)((LAS unsigned char*)wscr + k * 1024 + lane * 16); r0[4 * k] = v_.x; r0[4 * k + 1] = v_.y; r0[4 * k + 2] = v_.z; r0[4 * k + 3] = v_.w; } } } while (0)
    R0_PARK();
    __syncthreads();
    for (int rp_ = 0; rp_ < (KREP == 53 ? 2 : 1); ++rp_) {
        const bf16* Kb = P.KS + (size_t)bg * SEQ * 64; const bf16* Vb = P.VST + (size_t)bg * (SEQ / 32) * 2048;
        soft2_init(st, 0.f, 0.f);
        attn_stream<1, fast>(st, qf, Kb, Vb, 0, blk + 1, lut, q, s0, mlo, mhi, c31, kvbuf, tid, col, half, ones);
        R0_FETCH();
        soft2_acc(r0, r1, st, rp_ == 0 ? g1 : 0.f);
        R0_PARK();
    }
    f32x4 dwv[4];
    for (int rp_ = 0; rp_ < (KREP == 54 ? 2 : 1); ++rp_) {
        const bf16* Kb = P.KW + (size_t)bg * SEQ * 64; const bf16* Vb = P.VWT + (size_t)bg * (SEQ / 32) * 2048;
        soft2_init(st, 0.f, 0.f);
        const int kt0 = (sb > 511 ? sb - 511 : 0) >> 5, nt = kt_top - kt0 + 1, ktw_lo = (s0 > 511 ? s0 - 511 : 0) >> 5;
        attn_stream<2, fast>(st, qf, Kb, Vb, kt0, nt >> 1, lut, q, s0, 0u, 0u, c31, kvbuf, tid, col, half, ones);
        R0_FETCH();
        if (dw.on) defer_load(dw, dsid, lane, dwv);
        soft2_acc(r0, r1, st, rp_ == 0 ? g2 : 0.f);
    }
    store_o_rows((LAS unsigned char*)wscr, P.mix + (size_t)(b * SEQ + s0) * 1024 + 512 + g * 256, r0, r1, lane);
    if (dw.on) defer_finish(dw, dsid, dwv, wscr, lane);
}

__device__ __forceinline__ void attn2_phase(Frame& F, const AttP& P, const float* tbl, const float* sinks, const float* qna, const float* kna, const float* qnb, const float* knb, const DeferW dw) {
    LAS float* lutA = (LAS float*)(F.lds + RING_OFF + ATT_LUTA_OFF); LAS float* lutB = (LAS float*)(F.lds + RING_OFF + ATT_LUTB_OFF);
    for (int i = F.tid; i < 8 * LA; i += NWAVES * 64) { const int h = i / LA, rel = OFFA - i % LA; lutA[i] = (rel >= 0 && rel < 128) ? tbl[t5_bucket(rel) * 16 + h] * LOG2E : NEGL; }
    for (int i = F.tid; i < 8 * LB; i += NWAVES * 64) { const int h = i / LB, rel = OFFB - i % LB; lutB[i] = (rel >= 0 && rel < 512) ? (tbl[t5_bucket(rel) * 16 + 8 + h] - tbl[31 * 16 + 8 + h]) * LOG2E : NEGL; }
    { LAS float* gsc = (LAS float*)(F.lds + RING_OFF + ATT_WSCR_OFF);
      if (F.wave < 4) { const float* gp = F.wave == 0 ? qna : F.wave == 1 ? kna : F.wave == 2 ? qnb : knb; const float m = wave_max(fabsf(gp[F.lane])); if (F.lane == 0) gsc[F.wave] = m; }
      else if (F.wave == 4) { float m = 0.f; for (int i = F.lane; i < 256; i += 64) m = fmaxf(m, fabsf(tbl[(i >> 3) * 16 + (i & 7)]));
          m = fmaxf(m, F.lane < 8 ? fabsf(sinks[F.lane]) : 0.f); m = wave_max(m); if (F.lane == 0) gsc[4] = m * LOG2E; }
      else if (F.wave == 5) { float m = 0.f; for (int i = F.lane; i < 256; i += 64) m = fmaxf(m, fabsf(tbl[(i >> 3) * 16 + 8 + (i & 7)] - tbl[31 * 16 + 8 + (i & 7)])); m = wave_max(m); if (F.lane == 0) gsc[5] = m * LOG2E; } }
    __syncthreads();
    bool fast;
    { const LAS float* gsc = (const LAS float*)(F.lds + RING_OFF + ATT_WSCR_OFF);
      const float bA = 64.0f * gsc[0] * gsc[1] * QSCALE * 1.02f + gsc[4], bB = 64.0f * gsc[2] * gsc[3] * QSCALE * 1.02f + gsc[5];
      fast = __builtin_amdgcn_readfirstlane((int)(fmaxf(bA, bB) < 60.0f)) != 0; }
    __syncthreads();
    LAS float* wscr = (LAS float*)(F.lds + RING_OFF + ATT_WSCR_OFF + F.wave * ATT_WSCR_BYTES);
    for (int v = F.vcu; v < 256; v += F.G) {
        const int bg = v >> 4, j = v & 15, b = bg >> 1, g = bg & 1;
#pragma unroll 1
        for (int i = 0; i < 4; ++i) { const int blk = (i == 0) ? j : (i == 1) ? 31 - j : (i == 2) ? 32 + j : 63 - j; const int slot = (v * 4 + i) * 8 + F.wave;
            if (fast) attn2_unit<true>(F, P, sinks, b, g, blk, lutA, lutB, wscr, dw, slot); else attn2_unit<false>(F, P, sinks, b, g, blk, lutA, lutB, wscr, dw, slot); }
    }
    __syncthreads();
}

enum { F_NORM = 1, F_PROJ = 2, F_CMP = 4, F_ATT = 8 };
struct Args { const float* in[21]; float* out; unsigned char* ws; int ph_lo, ph_hi, flags, li, rep, pad; };

__device__ __forceinline__ void p0_item(const float* W, int ldw, int k0, int c0, int nvalid, bf16* WT, int Kd, int drow0, LAS float* scr, int lane, const float* kgain = nullptr, bool fragmajor = false, float cscale = 1.0f) {
    f32x4 v[8]; const int c4 = 4 * (lane & 7), rr = lane >> 3;
#pragma unroll
    for (int i = 0; i < 8; ++i) v[i] = (c4 < nvalid) ? *(const GAS f32x4*)(W + (size_t)(k0 + 8 * i + rr) * ldw + c0 + c4) : (f32x4){0.f, 0.f, 0.f, 0.f};
#pragma unroll
    for (int i = 0; i < 8; ++i) { const int kk = 8 * i + rr; const float gk = (kgain ? kgain[k0 + kk] : 1.0f) * cscale; LAS float* d = scr + kk * 33 + c4;
        d[0] = v[i][0] * gk; d[1] = v[i][1] * gk; d[2] = v[i][2] * gk; d[3] = v[i][3] * gk; }
    LDS_WAIT(); asm volatile("" ::: "memory");
    const int c = lane & 7;
#pragma unroll
    for (int j = 0; j < 4; ++j) { const int n = (lane >> 3) + 8 * j; const LAS float* s = scr + (8 * c) * 33 + n;
        v4u o; o.x = pk2(s[0 * 33], s[1 * 33]); o.y = pk2(s[2 * 33], s[3 * 33]); o.z = pk2(s[4 * 33], s[5 * 33]); o.w = pk2(s[6 * 33], s[7 * 33]);
        if (!fragmajor) *(GAS v4u*)(WT + (size_t)(drow0 + n) * Kd + k0 + 8 * c) = o;
        else { const int kk = k0 + 8 * c, nn = drow0 + n;
            *(GAS v4u*)(WT + ((size_t)((kk >> 4) * 4 + (nn >> 5)) * 64 + (nn & 31) + 32 * ((kk >> 3) & 1)) * 8) = o; } }
    LDS_WAIT(); asm volatile("" ::: "memory");
}
__host__ __device__ __forceinline__ int main_colbase(int H) {
    if (H < 8) return 64 * H;
    if (H < 16) return 768 + 64 * (H - 8);
    if (H < 18) return 512 + 64 * (H - 16);
    if (H < 20) return 1280 + 2 * 128 + 64 * (H - 18);
    if (H < 22) return 1280 + 4 * 128 + 64 * (H - 20);
    if (H < 24) return 1280 + 0 * 128 + 64 * (H - 22);
    if (H < 26) return 1280 + 1 * 128 + 64 * (H - 24);
    if (H == 26) return 2048;
    return -1;
}
__host__ __device__ __forceinline__ int vt_colbase(int vh) {
    if (vh < 2) return 640 + 64 * vh;
    if (vh < 4) return 1280 + 3 * 128 + 64 * (vh - 2);
    if (vh < 6) return 1280 + 5 * 128 + 64 * (vh - 4);
    return -1;
}
__device__ __forceinline__ void p0_prologue(Frame& F, const Args& a) {
    LAS float* scr = (LAS float*)(F.lds + RING_OFF + F.wave * 16384);
    const int gw = F.vcu * NWAVES + F.wave, NGW = F.G * NWAVES;
    unsigned char* ws = a.ws;
    constexpr int I_IN = 16 * 176, I_OUT = 44 * 32, I_MAIN = 16 * 56, I_PLAIN = 16 * 72, I_VT = 16 * 16, I_MO = 16 * 32, I_W1 = 2 * 32 * 4, I_W2 = 2 * 2 * 2;
    const bool defer = (F.G == 256) && ((a.flags & 15) == 15);
    const bool fproj = (a.flags & F_PROJ) != 0, fnorm = (a.flags & F_NORM) != 0;
    const int i_proj = fproj ? I_MAIN + I_VT : I_PLAIN;
    const int NITEMS = 2 * I_IN + 2 * I_OUT + i_proj + I_MO + I_W1 + I_W2;
    for (int it = gw; it < NITEMS; it += NGW) {
        int r = it;
        if (r < 2 * I_IN) { const int l = r / I_IN; if (l && defer) continue; r %= I_IN; const int kb = r / 176, nb = r % 176;
            const int pn = nb >> 3, bj = (nb >> 2) & 1, c = 32 * (nb & 3);
            p0_item(a.in[l ? 19 : 3], 2 * FF, 64 * kb, (bj ? FF : 0) + 128 * pn + c, 32, (bf16*)(ws + (l ? WS_WIN2 : WS_WIN1)), DM, 32 * nb, scr, F.lane, (l && fnorm) ? a.in[18] : nullptr, false, bj ? (1.0f / LOG2E) : LOG2E); continue; }
        r -= 2 * I_IN;
        if (r < 2 * I_OUT) { const int l = r / I_OUT; r %= I_OUT; if (l && defer && I_IN + r < 4096) continue; const int kb = r / 32, nb = r % 32;
            p0_item(a.in[l ? 20 : 4], DM, 64 * kb, 32 * nb, 32, (bf16*)(ws + (l ? WS_WOUT2 : WS_WOUT1)), FF, 32 * nb, scr, F.lane); continue; }
        r -= 2 * I_OUT;
        if (r < i_proj) {
            if (!fproj) { const int kb = r / 72, nb = r % 72; const int nv = 2072 - 32 * nb; p0_item(a.in[6], 2072, 64 * kb, nv > 0 ? 32 * nb : 0, nv > 32 ? 32 : (nv > 0 ? nv : 0), (bf16*)(ws + WS_WMAIN), DM, 32 * nb, scr, F.lane, fnorm ? a.in[5] : nullptr); continue; }
            if (r < I_MAIN) { const int kb = r / 56, nb = r % 56;
                const int pn = nb >> 3, bj = (nb >> 2) & 1, wc = nb & 3, H = 4 * pn + wc, cb = main_colbase(H);
                const int nv = cb < 0 ? 0 : (H == 26 ? (bj ? 0 : 24) : 32);
                p0_item(a.in[6], 2072, 64 * kb, cb < 0 ? 0 : cb + 32 * bj, nv, (bf16*)(ws + WS_WMAIN), DM, 32 * nb, scr, F.lane, fnorm ? a.in[5] : nullptr); continue; }
            r -= I_MAIN; { const int kb = r / 16, nb = r % 16, vh = nb >> 1, cb = vt_colbase(vh);
                p0_item(a.in[6], 2072, 64 * kb, cb < 0 ? 0 : cb + 32 * (nb & 1), cb < 0 ? 0 : 32, (bf16*)(ws + WS_WVT), DM, 32 * nb, scr, F.lane, fnorm ? a.in[5] : nullptr); continue; }
        }
        r -= i_proj;
        if (r < I_MO) { const int kb = r / 32, nb = r % 32; p0_item(a.in[7], DM, 64 * kb, 32 * nb, 32, (bf16*)(ws + WS_WMO), DM, 32 * nb, scr, F.lane); continue; }
        r -= I_MO;
        if (r < I_W1) { const int kv = r / 128; r %= 128; const int kb = r / 4, nb = r % 4; p0_item(a.in[14] + (size_t)kv * 2048 * 128, 128, 64 * kb, 32 * nb, 32, (bf16*)(ws + WS_W1T) + (size_t)kv * 128 * 2048, 2048, 32 * nb, scr, F.lane, nullptr, true); continue; }
        r -= I_W1;
        { const int kv = r / 4; r %= 4; const int kb = r / 2, nb = r % 2; p0_item(a.in[16] + (size_t)kv * 128 * 64, 64, 64 * kb, 32 * nb, 32, (bf16*)(ws + WS_W2T) + (size_t)kv * 64 * 128, 128, 32 * nb, scr, F.lane); }
    }
    if (gw < 256) { const int kv = gw >> 7, hid = gw & 127; float s = 0.f;
        for (int j = 0; j < 32; ++j) { const int k = F.lane + 64 * j; s += a.in[13][kv * 2048 + k] * a.in[14][((size_t)kv * 2048 + k) * 128 + hid]; }
        s = wave_sum(s); if (F.lane == 0) ((float*)(ws + WS_POSB))[gw] = s + a.in[15][gw]; }
    const float* g1 = a.in[2];
    for (int m0 = gw; m0 < T; m0 += 4 * NGW) {
        f32x4 v[4][4];
#pragma unroll
        for (int rI = 0; rI < 4; ++rI) { const int m = m0 + rI * NGW; const GAS f32x4* xr = (const GAS f32x4*)(a.in[0] + (size_t)(m < T ? m : m0) * DM) + F.lane;
#pragma unroll
            for (int j = 0; j < 4; ++j) v[rI][j] = __builtin_nontemporal_load(xr + 64 * j); }
#pragma unroll
        for (int rI = 0; rI < 4; ++rI) { const int m = m0 + rI * NGW; if (m >= T) break;
            float s = 0.f;
#pragma unroll
            for (int j = 0; j < 4; ++j) s += (v[rI][j].x * v[rI][j].x + v[rI][j].y * v[rI][j].y) + (v[rI][j].z * v[rI][j].z + v[rI][j].w * v[rI][j].w);
            const float rstd = 1.0f / sqrtf(wave_sum(s) * (1.f / DM) + EPS); const f32x4* gr = (const f32x4*)g1 + F.lane;
            GAS unsigned long long* o8 = (GAS unsigned long long*)((bf16*)(ws + WS_A) + (size_t)m * DM) + F.lane;
#pragma unroll
            for (int j = 0; j < 4; ++j) { const f32x4 gg = gr[64 * j]; o8[64 * j] = (unsigned long long)pk2(v[rI][j].x * rstd * gg.x, v[rI][j].y * rstd * gg.y) | ((unsigned long long)pk2(v[rI][j].z * rstd * gg.z, v[rI][j].w * rstd * gg.w) << 32); } }
    }
}

__global__ void __launch_bounds__(NWAVES * 64, 2) mk(Args args) {
    extern __shared__ __attribute__((aligned(16))) unsigned char lds[];
    Frame F;
    F.lds = (LAS unsigned char*)lds; F.MISC = (volatile LAS unsigned*)(F.lds + MISC_OFF);
    F.wave = __builtin_amdgcn_readfirstlane((int)threadIdx.x >> 6);
#define FRESH() do { F.lane = hw_lane_id(); F.tid = F.wave * 64 + F.lane; } while (0)
#define LEADER() (F.wave == 0 && hw_lane_id() == 0)
    if (args.ph_lo < 0) cooperative_groups::this_grid().sync();
    FRESH();
    F.G = gridDim.x; { const int bx = blockIdx.x; F.vcu = (F.G % 8 == 0) ? (bx % 8) * (F.G / 8) + bx / 8 : bx; }
    unsigned char* ws = args.ws; F.ctl = (gu32*)(ws + WS_CTL);
    for (int u = F.tid; u < (LDS_BYTES - LDSCTL_OFF) / 4; u += NWAVES * 64) ((LAS unsigned*)(F.lds + LDSCTL_OFF))[u] = 0u;
    __syncthreads();
    const int lo = args.ph_lo, hi = args.ph_hi, flags = args.flags;
    const bool one = (hi - lo) > 1;
    XcdBarrier bar; bar.bar = (unsigned*)(F.ctl + CW_BAR) + args.li * XCD_BAR_WORDS; bar.x = 0; bar.st = nullptr;
    if (one) bar = xcd_barrier_post((unsigned*)(F.ctl + CW_BAR) + args.li * XCD_BAR_WORDS, F.MISC + 8, LEADER());
#define IN(k) (lo <= (k) && (k) < hi)
#define REP(k) for (int rep_ = 0; rep_ < ((KREP == (k)) ? 2 : 1); ++rep_)
#define SEAM(k) do { if (IN(k) && IN((k) + 1)) { xcd_barrier(bar, LEADER()); } FRESH(); } while (0)
    bf16* const A = (bf16*)(ws + WS_A); bf16* const ACT = (bf16*)(ws + WS_ACT); bf16* const MIX = (bf16*)(ws + WS_MIX);
    float* const SSQ1 = (float*)(ws + WS_SSQ1); float* const SSQ2 = (float*)(ws + WS_SSQ2);
    const bool fnorm = (flags & F_NORM) != 0;

    if (IN(0)) REP(0) { p0_prologue(F, args); } SEAM(0);
    if (IN(1)) REP(1) {
        pg8::Gemm g{A, (const bf16*)(ws + WS_WIN1), T, 2 * FF, DM}; pg8::StaticOrder S; S.init(T, 2 * FF, F.G, (int)blockIdx.x);
        pg8::EpiSwiglu E{ACT, FF, nullptr};
        pg8::gemm_phase<pg8::EpiSwiglu, pg8::StaticOrder, true, true>(F.lds + RING_OFF, g, S, E, F.wave);
    } SEAM(1);
    if (IN(2)) REP(2) {
        pg8::Gemm g{ACT, (const bf16*)(ws + WS_WOUT1), T, DM, FF}; pg8::StaticOrder S; S.init(T, DM, F.G, (int)blockIdx.x);
        if (fnorm) { pg8::EpiResidF E{args.in[0], 0.5f, A, SSQ1};
            pg8::gemm_phase<pg8::EpiResidF, pg8::StaticOrder, true, true>(F.lds + RING_OFF, g, S, E, F.wave); }
        else { pg8::EpiResid E{args.in[0], nullptr, 0.5f, args.out, nullptr, nullptr}; pg8::gemm_phase<pg8::EpiResid, pg8::StaticOrder, true, true>(F.lds + RING_OFF, g, S, E, F.wave); }
    } SEAM(2);
    if (IN(3)) REP(3) {
        if (!(flags & F_PROJ)) {
            pg8::Gemm g{A, (const bf16*)(ws + WS_WMAIN), T, NPLAIN, DM}; pg8::StaticOrder S; S.init(T, NPLAIN, F.G, (int)blockIdx.x);
            pg8::EpiPlain E{(bf16*)(ws + WS_PROJ), NPLAIN};
            pg8::gemm_phase<pg8::EpiPlain, pg8::StaticOrder, true, true>(F.lds + RING_OFF, g, S, E, F.wave);
        } else {
            pg8::Gemm g{A, (const bf16*)(ws + WS_WMAIN), T, NMAIN, DM}; pg8::StaticOrder S; S.init(T, NMAIN, F.G, (int)blockIdx.x);
            pg8::EpiProjMain E{SSQ1, (float*)(ws + WS_RSTD), args.in[8], args.in[9], args.in[11], args.in[12],
                               (bf16*)(ws + WS_QA), (bf16*)(ws + WS_QB), (bf16*)(ws + WS_KA), (bf16*)(ws + WS_KS), (bf16*)(ws + WS_KW), (bf16*)(ws + WS_KCR), (bf16*)(ws + WS_VCR), (float*)(ws + WS_GT), QSCALE, SEQ, T};
            pg8::gemm_phase<pg8::EpiProjMain, pg8::StaticOrder, true, true>(F.lds + RING_OFF, g, S, E, F.wave);
            if (F.G == 256 && (flags & F_CMP) && blockIdx.x >= 128) {
                pg8::Gemm gt{(const bf16*)(ws + WS_WVT), A, 512, T, DM}; pg8::OneUnit S1{0, (int)blockIdx.x - 128};
                pg8::EpiProjT Et{SSQ1, (bf16*)(ws + WS_VAT), (size_t)(WS_VST - WS_VAT) / 2, SEQ};
                pg8::gemm_phase<pg8::EpiProjT, pg8::OneUnit, true, true>(F.lds + RING_OFF, gt, S1, Et, F.wave);
            }
        }
    } SEAM(3);
    if (IN(4)) REP(4) {
        const bool bal = (F.G == 256) && (flags & F_PROJ) && (flags & F_CMP);
        if (flags & F_PROJ) {
            pg8::Gemm g{(const bf16*)(ws + WS_WVT), A, 512, T, DM};
            pg8::EpiProjT E{SSQ1, (bf16*)(ws + WS_VAT), (size_t)(WS_VST - WS_VAT) / 2, SEQ};
            if (bal) { if (blockIdx.x < 128) { pg8::OneUnit S1{1, (int)blockIdx.x}; pg8::gemm_phase<pg8::EpiProjT, pg8::OneUnit, true, true, true>(F.lds + RING_OFF, g, S1, E, F.wave); } }
            else { pg8::StaticOrder S; S.init(512, T, F.G, (int)blockIdx.x); pg8::gemm_phase<pg8::EpiProjT, pg8::StaticOrder, true, true>(F.lds + RING_OFF, g, S, E, F.wave); }
        }
        if (flags & F_CMP) {
            FRESH();
            if (bal) { if (blockIdx.x >= 128)
                cmp_unit2(F, 2 * ((int)blockIdx.x - 128), (const bf16*)(ws + WS_KCR), (const bf16*)(ws + WS_VCR), (const bf16*)(ws + WS_W1T), (const bf16*)(ws + WS_W2T), (const float*)(ws + WS_POSB), args.in[17], args.in[12], (bf16*)(ws + WS_KC), (bf16*)(ws + WS_VCT)); }
            else for (int u = F.vcu; u < 256; u += F.G)
                cmp_unit(F, u, (const bf16*)(ws + WS_KCR), (const bf16*)(ws + WS_VCR), (const bf16*)(ws + WS_W1T), (const bf16*)(ws + WS_W2T), (const float*)(ws + WS_POSB), args.in[17], args.in[12], (bf16*)(ws + WS_KC), (bf16*)(ws + WS_VCT));
        }
    }
    SEAM(4);
    if (IN(5) && (flags & F_ATT)) REP(5) {
        const AttP P{(const bf16*)(ws + WS_QA), (const bf16*)(ws + WS_QB), (const bf16*)(ws + WS_KA), (const bf16*)(ws + WS_VAT), (const bf16*)(ws + WS_KC), (const bf16*)(ws + WS_VCT), (const bf16*)(ws + WS_KS), (const bf16*)(ws + WS_VST),
                     (const bf16*)(ws + WS_KW), (const bf16*)(ws + WS_VWT), (const float*)(ws + WS_GT), MIX};
        const DeferW dw{args.in[19], args.in[20], fnorm ? args.in[18] : nullptr, (bf16*)(ws + WS_WIN2), (bf16*)(ws + WS_WOUT2), (F.G == 256) && ((flags & 15) == 15)};
        attn2_phase(F, P, args.in[1], args.in[10], args.in[8], args.in[9], args.in[11], args.in[12], dw);
    }
    SEAM(5);
    if (IN(6)) {
        pg8::Gemm g{MIX, (const bf16*)(ws + WS_WMO), T, DM, DM}; pg8::StaticOrder S; S.init(T, DM, F.G, (int)blockIdx.x);
        pg8::EpiResid E{fnorm ? nullptr : args.out, fnorm ? A : nullptr, 1.0f, fnorm ? nullptr : args.out, fnorm ? A : nullptr, fnorm ? SSQ2 : nullptr};
        pg8::gemm_phase<pg8::EpiResid, pg8::StaticOrder, true, true>(F.lds + RING_OFF, g, S, E, F.wave);
    } SEAM(6);
    if (IN(7)) REP(7) {
        pg8::Gemm g{A, (const bf16*)(ws + WS_WIN2), T, 2 * FF, DM}; pg8::StaticOrder S; S.init(T, 2 * FF, F.G, (int)blockIdx.x);
        pg8::EpiSwiglu E{ACT, FF, fnorm ? SSQ2 : nullptr};
        pg8::gemm_phase<pg8::EpiSwiglu, pg8::StaticOrder, true, true>(F.lds + RING_OFF, g, S, E, F.wave);
    } SEAM(7);
    if (IN(8)) {
        pg8::Gemm g{ACT, (const bf16*)(ws + WS_WOUT2), T, DM, FF}; pg8::StaticOrder S; S.init(T, DM, F.G, (int)blockIdx.x);
        pg8::EpiResid E{fnorm ? nullptr : args.out, fnorm ? A : nullptr, 0.5f, args.out, nullptr, nullptr};
        pg8::gemm_phase<pg8::EpiResid, pg8::StaticOrder, true, true>(F.lds + RING_OFF, g, S, E, F.wave);
    }
#undef IN
#undef SEAM
}

static void launch_mk(const Args& base, int lo, int hi, int grid, hipStream_t stream) {
    static int li = 0;
    Args a = base; a.ph_lo = lo; a.ph_hi = hi; a.li = 0;
    if (hi - lo > 1) {
        a.li = (lo == 0) ? 0 : (lo < 6 ? 1 : 2);
        void* kargs[] = {&a};
        hipError_t e = hipLaunchCooperativeKernel((const void*)mk, dim3(grid), dim3(NWAVES * 64), kargs, LDS_BYTES, stream);
        if (e != hipSuccess) fprintf(stderr, "cooperative launch failed: %s (grid %d)\n", hipGetErrorString(e), grid);
    } else hipLaunchKernelGGL(mk, dim3(grid), dim3(NWAVES * 64), LDS_BYTES, stream, a);
    (void)li;
}
extern "C" void kernel_launch(void* const* d_in, const int* in_sizes, int n_in, void* d_out, int out_size, void* d_ws, size_t ws_size, hipStream_t stream) {
    static int grid = 0;
    if (grid == 0) {
        if (n_in != 21 || in_sizes[0] != T * DM || out_size != T * DM || ws_size < (KFLAGS == 15 ? WS_MIX + 64 * MiB : WS_END)) { fprintf(stderr, "kernel_launch: unexpected shapes / workspace (%d inputs, ws %zu)\n", n_in, ws_size); grid = -1; return; }
        int dev = 0, cus = 0;
        if (hipGetDevice(&dev) != hipSuccess || hipDeviceGetAttribute(&cus, hipDeviceAttributeMultiprocessorCount, dev) != hipSuccess) { grid = -1; return; }
        if (hipFuncSetAttribute((const void*)mk, hipFuncAttributeMaxDynamicSharedMemorySize, LDS_BYTES) != hipSuccess) { grid = -1; return; }
        (void)hipGetLastError();
        int per_cu = 0;
        if (hipOccupancyMaxActiveBlocksPerMultiprocessor(&per_cu, (const void*)mk, NWAVES * 64, LDS_BYTES) != hipSuccess || per_cu < 1) { fprintf(stderr, "occupancy query failed (%d)\n", per_cu); (void)hipGetLastError(); per_cu = 1; }
        grid = cus * (per_cu > 1 ? 1 : per_cu);
    }
    if (grid < 0) return;
    (void)hipMemsetAsync((char*)d_ws + WS_CTL, 0, CTL_ZERO_BYTES, stream);
    Args a{};
    for (int i = 0; i < 21; ++i) a.in[i] = (const float*)d_in[i];
    a.out = (float*)d_out; a.ws = (unsigned char*)d_ws; a.flags = KFLAGS; a.rep = KREP;
    unsigned char* ws = (unsigned char*)d_ws;
    const bool fnorm = (KFLAGS & F_NORM) != 0;
    if (KFLAGS == 15) { launch_mk(a, 0, 9, grid, stream); return; }
    if (fnorm) launch_mk(a, 0, 3, grid, stream);
    else { launch_mk(a, 0, 1, grid, stream); launch_mk(a, 1, 2, grid, stream); launch_mk(a, 2, 3, grid, stream); }
    if (!fnorm) hipLaunchKernelGGL(nv_rmsnorm, dim3(T / 4), dim3(256), 0, stream, (const float*)d_out, a.in[5], (bf16*)(ws + WS_A));
    launch_mk(a, 3, 4, grid, stream);
    if (!(KFLAGS & F_PROJ)) {
        HeadPrep hp{(const bf16*)(ws + WS_PROJ), fnorm ? (const float*)(ws + WS_SSQ1) : nullptr, a.in[8], a.in[9], a.in[11], a.in[12],
                    (bf16*)(ws + WS_QA), (bf16*)(ws + WS_QB), (bf16*)(ws + WS_KA), (bf16*)(ws + WS_VAT), (bf16*)(ws + WS_KCR), (bf16*)(ws + WS_VCR), (bf16*)(ws + WS_KS), (bf16*)(ws + WS_VST), (bf16*)(ws + WS_KW), (bf16*)(ws + WS_VWT), (float*)(ws + WS_GT)};
        hipLaunchKernelGGL(nv_headprep, dim3(T / 4), dim3(256), 0, stream, hp);
    }
    if (KFLAGS & (F_PROJ | F_CMP)) launch_mk(a, 4, 5, grid, stream);
    if (!(KFLAGS & F_CMP)) hipLaunchKernelGGL(nv_compress, dim3(2 * 8 * 2 * 256), dim3(128), 0, stream, (const bf16*)(ws + WS_KCR), (const bf16*)(ws + WS_VCR), a.in[13], a.in[14], a.in[15], a.in[16], a.in[17], a.in[12], (bf16*)(ws + WS_KC), (bf16*)(ws + WS_VCT));
    if (!(KFLAGS & F_ATT)) {
        hipLaunchKernelGGL(nv_band_a, dim3(T * 2), dim3(256), 0, stream, (const bf16*)(ws + WS_QA), (const bf16*)(ws + WS_KA), (const bf16*)(ws + WS_VAT), a.in[1], a.in[10], (bf16*)(ws + WS_MIX));
        hipLaunchKernelGGL(nv_nsa, dim3(T * 2), dim3(256), 0, stream, (const bf16*)(ws + WS_QB), (const bf16*)(ws + WS_KC), (const bf16*)(ws + WS_VCT), (const bf16*)(ws + WS_KS), (const bf16*)(ws + WS_VST), (const bf16*)(ws + WS_KW), (const bf16*)(ws + WS_VWT), (const float*)(ws + WS_GT), a.in[1], (bf16*)(ws + WS_MIX));
    } else launch_mk(a, 5, 6, grid, stream);
    if (fnorm) launch_mk(a, 6, 9, grid, stream);
    else { launch_mk(a, 6, 7, grid, stream);
        hipLaunchKernelGGL(nv_rmsnorm, dim3(T / 4), dim3(256), 0, stream, (const float*)d_out, a.in[18], (bf16*)(ws + WS_A));
        launch_mk(a, 7, 8, grid, stream); launch_mk(a, 8, 9, grid, stream); }
}
```

```cpp
#include <hip/hip_runtime.h>
#include <hip/hip_cooperative_groups.h>
#include <cstdio>
#include <cstdint>
#ifndef KFLAGS
#define KFLAGS 15
#endif
#ifndef KREP
#define KREP -1
#endif
__device__ __forceinline__ int hw_lane_id() { int l; asm volatile("v_mbcnt_lo_u32_b32 %0, -1, 0\n\tv_mbcnt_hi_u32_b32 %0, -1, %0" : "=v"(l)); return l; }
namespace pg8 {
#define PG8_LAS __attribute__((address_space(3)))
typedef unsigned short bf16_t;
typedef short bf16x8 __attribute__((ext_vector_type(8)));
typedef float f32x4 __attribute__((ext_vector_type(4)));
typedef unsigned u32x4 __attribute__((ext_vector_type(4)));
constexpr int BM = 256, BK = 64, HALF = 128, HTB = HALF * BK * 2  , STAGE_BYTES = 8 * HTB, NXCD = 8, WGM = 8;

__host__ __device__ __forceinline__ int lds_byte(int r, int c) { const int st = (r >> 4) * 2 + (c >> 5), rr = r & 15, cc = c & 31, ob = rr * 64 + cc * 2; return st * 1024 + (ob ^ (((ob >> 9) & 1) << 5)); }
__host__ __device__ __forceinline__ void stage_rc(int b, int& R, int& C) { const int st = b / 1024, sb = b % 1024, swz = sb ^ (((sb >> 9) & 1) << 5); R = (st >> 1) * 16 + swz / 64; C = (st & 1) * 32 + (swz % 64) / 2; }
__host__ __device__ __forceinline__ int perm32(int rho) { const int n = rho >> 4, i = rho & 15; return 8 * (i >> 2) + 4 * n + (i & 3); }

struct Unit { int pm, pn; };
struct Gemm { const bf16_t* A; const bf16_t* Bt; int M, N, K; };

struct StaticOrder {
    int nM, nN, nwg, G, c;
    __host__ __device__ void init(int M, int N, int G_, int c_) { nM = M / BM; nN = N / BM; nwg = nM * nN; G = G_; c = c_; }
    __host__ __device__ bool next(int i, Unit& u) const {
        const long L = (long)i * G + c; if (L >= nwg) return false;
        int wgid = (int)L; { const int q = nwg / NXCD, r = nwg % NXCD, xcd = wgid % NXCD, off = wgid / NXCD; wgid = (xcd < r ? xcd * (q + 1) : r * (q + 1) + (xcd - r) * q) + off; }
        const int nig = WGM * nN, gid = wgid / nig, fm = gid * WGM, gsz = (nM - fm) < WGM ? (nM - fm) : WGM;
        u.pm = fm + ((wgid % nig) % gsz); u.pn = (wgid % nig) / gsz; return true;
    }
    __device__ __forceinline__ void a_ready(const Unit&) const {}
    __device__ __forceinline__ void done(const Unit&) const {}
};


__device__ __forceinline__ unsigned cvt_pk_bf16(float lo, float hi) { unsigned r; asm volatile("v_cvt_pk_bf16_f32 %0, %1, %2" : "=v"(r) : "v"(lo), "v"(hi)); return r; }
typedef unsigned u32x2 __attribute__((ext_vector_type(2)));
constexpr float kLog2e = 1.4426950408889634f;
__device__ __forceinline__ float silu_f(float x) { return x * __builtin_amdgcn_rcpf(1.0f + __builtin_amdgcn_exp2f(-x * kLog2e)); }
typedef float f32x2 __attribute__((ext_vector_type(2)));
__device__ __forceinline__ f32x2 silu_mul_pk(f32x2 g, f32x2 u) {
    f32x2 e; e.x = __builtin_amdgcn_exp2f(-g.x); e.y = __builtin_amdgcn_exp2f(-g.y);
    const f32x2 d = e + 1.0f; f32x2 r; r.x = __builtin_amdgcn_rcpf(d.x); r.y = __builtin_amdgcn_rcpf(d.y);
    return (g * r) * u;
}
__device__ __forceinline__ float row_rstd(const float* ssq, int row, int fq) {
    const f32x4 p = *(const f32x4*)(ssq + (size_t)row * 16 + 4 * fq);
    float s = (p[0] + p[1]) + (p[2] + p[3]);
    s += __shfl_xor(s, 16); s += __shfl_xor(s, 32);
    return __builtin_amdgcn_rsqf(s * (1.0f / 1024.0f) + 1e-6f);
}

__device__ __forceinline__ void rows_rstd(float (&rs)[2][4], const float* ssq, int row0, int fq) {
    f32x4 p[2][4];
#pragma unroll
    for (int ai = 0; ai < 2; ++ai)
#pragma unroll
        for (int m = 0; m < 4; ++m) p[ai][m] = *(const f32x4*)(ssq + (size_t)(row0 + ai * HALF + m * 16) * 16 + 4 * fq);
#pragma unroll
    for (int ai = 0; ai < 2; ++ai)
#pragma unroll
        for (int m = 0; m < 4; ++m) { float s = (p[ai][m][0] + p[ai][m][1]) + (p[ai][m][2] + p[ai][m][3]); s += __shfl_xor(s, 16); s += __shfl_xor(s, 32); rs[ai][m] = __builtin_amdgcn_rsqf(s * (1.0f / 1024.0f) + 1e-6f); }
    asm volatile("" ::: "memory");
}

struct EpiPlain {
    static constexpr bool PERM = true, AFTER_DRAIN = false;
    bf16_t* O; int ldc;
    __device__ __forceinline__ void operator()(const f32x4 (&acc)[2][2][4][2], const Unit& u, int wr, int wc, int fr, int fq) const {
        const int row0 = u.pm * BM + wr * 64 + fr, col0 = u.pn * BM + wc * 32 + 8 * fq;
#pragma unroll
        for (int ai = 0; ai < 2; ++ai)
#pragma unroll
            for (int m = 0; m < 4; ++m) { bf16_t* rowp = O + (size_t)(row0 + ai * HALF + m * 16) * ldc + col0;
#pragma unroll
                for (int bj = 0; bj < 2; ++bj) { const f32x4 v0 = acc[ai][bj][m][0], v1 = acc[ai][bj][m][1]; u32x4 w;
                    w.x = cvt_pk_bf16(v0[0], v0[1]); w.y = cvt_pk_bf16(v0[2], v0[3]); w.z = cvt_pk_bf16(v1[0], v1[1]); w.w = cvt_pk_bf16(v1[2], v1[3]);
                    *(u32x4*)(rowp + bj * HALF) = w; } }
    }
};

struct EpiSwiglu {
    static constexpr bool PERM = true, AFTER_DRAIN = false;
    bf16_t* O; int ldo; const float* ssq;
    __device__ __forceinline__ void operator()(const f32x4 (&acc)[2][2][4][2], const Unit& u, int wr, int wc, int fr, int fq) const {
        const int row0 = u.pm * BM + wr * 64 + fr, col0 = u.pn * HALF + wc * 32 + 8 * fq;
        const __amdgpu_buffer_rsrc_t orsrc = __builtin_amdgcn_make_buffer_rsrc((void*)O, 0, 0x7FFFFFFF, 0x00020000);
        const unsigned ovoff = (unsigned)(row0 * ldo + col0) * 2u;
        float rsv[2][4];
        if (ssq) rows_rstd(rsv, ssq, row0, fq);
#pragma unroll
        for (int ai = 0; ai < 2; ++ai)
#pragma unroll
            for (int m = 0; m < 4; ++m) { const int row = row0 + ai * HALF + m * 16;
                const float rs = ssq ? rsv[ai][m] : 1.0f;
                const f32x4 g0 = acc[ai][0][m][0] * rs, g1 = acc[ai][0][m][1] * rs, u0 = acc[ai][1][m][0] * rs, u1 = acc[ai][1][m][1] * rs;
                u32x4 w;
                const f32x2 a0 = silu_mul_pk((f32x2){g0[0], g0[1]}, (f32x2){u0[0], u0[1]}), a1 = silu_mul_pk((f32x2){g0[2], g0[3]}, (f32x2){u0[2], u0[3]});
                const f32x2 a2 = silu_mul_pk((f32x2){g1[0], g1[1]}, (f32x2){u1[0], u1[1]}), a3 = silu_mul_pk((f32x2){g1[2], g1[3]}, (f32x2){u1[2], u1[3]});
                w.x = cvt_pk_bf16(a0.x, a0.y); w.y = cvt_pk_bf16(a1.x, a1.y); w.z = cvt_pk_bf16(a2.x, a2.y); w.w = cvt_pk_bf16(a3.x, a3.y);
                __builtin_amdgcn_raw_buffer_store_b128(w, orsrc, ovoff, (ai * HALF + m * 16) * ldo * 2, 0); }
    }
};

struct EpiResid {
    static constexpr bool PERM = true, AFTER_DRAIN = false;
    const float* bf; const bf16_t* bb; float alpha; float* of; bf16_t* ob; float* ssq;
    __device__ __forceinline__ void operator()(const f32x4 (&acc)[2][2][4][2], const Unit& u, int wr, int wc, int fr, int fq) const {
        const int row0 = u.pm * BM + wr * 64 + fr, col0 = u.pn * BM + wc * 32 + 8 * fq;
#pragma unroll
        for (int ai = 0; ai < 2; ++ai) {
            u32x4 pb[4][2];
            if (!bf) {
#pragma unroll
                for (int m = 0; m < 4; ++m)
#pragma unroll
                    for (int bj = 0; bj < 2; ++bj) pb[m][bj] = *(const u32x4*)(bb + (size_t)(row0 + ai * HALF + m * 16) * 1024 + col0 + bj * HALF);
            }
#pragma unroll
            for (int mp = 0; mp < 2; ++mp) {
                f32x4 pf[2][2][2];
                if (bf) {
#pragma unroll
                    for (int mm = 0; mm < 2; ++mm)
#pragma unroll
                        for (int bj = 0; bj < 2; ++bj)
#pragma unroll
                            for (int n = 0; n < 2; ++n) pf[mm][bj][n] = __builtin_nontemporal_load((const f32x4*)(bf + (size_t)(row0 + ai * HALF + (2 * mp + mm) * 16) * 1024 + col0 + bj * HALF + n * 4));
                }
#pragma unroll
                for (int mm = 0; mm < 2; ++mm) { const int m = 2 * mp + mm; const int row = row0 + ai * HALF + m * 16; const size_t off = (size_t)row * 1024 + col0; float ss = 0.f;
#pragma unroll
                    for (int bj = 0; bj < 2; ++bj) { const size_t o2 = off + bj * HALF; f32x4 o[2];
#pragma unroll
                        for (int n = 0; n < 2; ++n) { f32x4 bse;
                            if (bf) bse = pf[mm][bj][n];
                            else { const unsigned w0 = n ? pb[m][bj].z : pb[m][bj].x, w1 = n ? pb[m][bj].w : pb[m][bj].y;
                                bse[0] = __uint_as_float(w0 << 16); bse[1] = __uint_as_float(w0 & 0xffff0000u); bse[2] = __uint_as_float(w1 << 16); bse[3] = __uint_as_float(w1 & 0xffff0000u); }
                            o[n] = bse + acc[ai][bj][m][n] * alpha;
                            ss += (o[n][0] * o[n][0] + o[n][1] * o[n][1]) + (o[n][2] * o[n][2] + o[n][3] * o[n][3]); }
                        if (of) { __builtin_nontemporal_store(o[0], (f32x4*)(of + o2)); __builtin_nontemporal_store(o[1], (f32x4*)(of + o2 + 4)); }
                        if (ob) { u32x4 w; w.x = cvt_pk_bf16(o[0][0], o[0][1]); w.y = cvt_pk_bf16(o[0][2], o[0][3]); w.z = cvt_pk_bf16(o[1][0], o[1][1]); w.w = cvt_pk_bf16(o[1][2], o[1][3]); *(u32x4*)(ob + o2) = w; } }
                    if (ssq) { ss += __shfl_xor(ss, 16); ss += __shfl_xor(ss, 32); if (fq == 0) ssq[(size_t)row * 16 + u.pn * 4 + wc] = ss; } }
                asm volatile("" ::: "memory");
            }
        }
    }
};

struct EpiResidF {
    static constexpr bool PERM = true, AFTER_DRAIN = false;
    const float* bf; float alpha; bf16_t* ob; float* ssq;
    __device__ __forceinline__ void load_q(f32x4 (&pf)[2][2][2], int row0, int col0, int q) const {
#pragma unroll
        for (int mm = 0; mm < 2; ++mm)
#pragma unroll
            for (int bj = 0; bj < 2; ++bj)
#pragma unroll
                for (int n = 0; n < 2; ++n) pf[mm][bj][n] = __builtin_nontemporal_load((const f32x4*)(bf + (size_t)(row0 + (q >> 1) * HALF + (2 * (q & 1) + mm) * 16) * 1024 + col0 + bj * HALF + n * 4));
    }
    __device__ __forceinline__ void operator()(const f32x4 (&acc)[2][2][4][2], const Unit& u, int wr, int wc, int fr, int fq) const {
        const int row0 = u.pm * BM + wr * 64 + fr, col0 = u.pn * BM + wc * 32 + 8 * fq;
        f32x4 pfa[2][2][2], pfb[2][2][2];
        load_q(pfa, row0, col0, 0);
#pragma unroll
        for (int q = 0; q < 4; ++q) { const int ai = q >> 1, mp = q & 1;
            f32x4 (&cur)[2][2][2] = (q & 1) ? pfb : pfa; f32x4 (&nxt)[2][2][2] = (q & 1) ? pfa : pfb;
            if (q < 3) load_q(nxt, row0, col0, q + 1);
#pragma unroll
            for (int mm = 0; mm < 2; ++mm) { const int m = 2 * mp + mm; const int row = row0 + ai * HALF + m * 16; const size_t off = (size_t)row * 1024 + col0; float ss = 0.f;
#pragma unroll
                for (int bj = 0; bj < 2; ++bj) { const size_t o2 = off + bj * HALF; f32x4 o[2];
#pragma unroll
                    for (int n = 0; n < 2; ++n) { o[n] = cur[mm][bj][n] + acc[ai][bj][m][n] * alpha; ss += (o[n][0] * o[n][0] + o[n][1] * o[n][1]) + (o[n][2] * o[n][2] + o[n][3] * o[n][3]); }
                    u32x4 w; w.x = cvt_pk_bf16(o[0][0], o[0][1]); w.y = cvt_pk_bf16(o[0][2], o[0][3]); w.z = cvt_pk_bf16(o[1][0], o[1][1]); w.w = cvt_pk_bf16(o[1][2], o[1][3]); *(u32x4*)(ob + o2) = w; }
                ss += __shfl_xor(ss, 16); ss += __shfl_xor(ss, 32); if (fq == 0) ssq[(size_t)row * 16 + u.pn * 4 + wc] = ss; }
            asm volatile("" ::: "memory");
        }
    }
};

struct EpiProjMain {
    static constexpr bool PERM = true, AFTER_DRAIN = false;
    const float* ssq; float* rstd_out; const float *qna, *kna, *qnb, *knb;
    bf16_t *QA, *QB, *KA, *KS, *KW, *KCR, *VCR; float* GT; float qscale; int seq, ntok;
    __device__ __forceinline__ void operator()(const f32x4 (&acc)[2][2][4][2], const Unit& u, int wr, int wc, int fr, int fq) const {
        const int H = 4 * u.pn + wc, row0 = u.pm * BM + wr * 64 + fr;
        const float* gain = nullptr; bf16_t* dst = nullptr; float sc = 1.0f; int nh = 2, hh = H & 1;
        if (H < 8) { gain = qna; dst = QA; sc = qscale; nh = 8; hh = H; }
        else if (H < 16) { gain = qnb; dst = QB; sc = qscale; nh = 8; hh = H - 8; }
        else if (H < 18) { gain = kna; dst = KA; }
        else if (H < 20) { gain = knb; dst = KS; }
        else if (H < 22) { gain = knb; dst = KW; }
        else if (H < 24) { dst = KCR; }
        else if (H < 26) { dst = VCR; }
        f32x4 gv[2][2];
#pragma unroll
        for (int bj = 0; bj < 2; ++bj)
#pragma unroll
            for (int n = 0; n < 2; ++n) gv[bj][n] = gain ? *(const f32x4*)(gain + 32 * bj + 8 * fq + 4 * n) * sc : (f32x4){1.f, 1.f, 1.f, 1.f};
        float rsv[2][4]; rows_rstd(rsv, ssq, row0, fq);
#pragma unroll
        for (int ai = 0; ai < 2; ++ai)
#pragma unroll
            for (int m = 0; m < 4; ++m) { const int row = row0 + ai * HALF + m * 16;
                const float rs = rsv[ai][m];
                if (H == 27) continue;
                if (H == 26) {
                    if (fq < 3) {
#pragma unroll
                        for (int n = 0; n < 2; ++n) { f32x4 gv4; const float nrs = -rs * kLog2e;
#pragma unroll
                            for (int i = 0; i < 4; ++i) gv4[i] = __builtin_amdgcn_rcpf(1.0f + __builtin_amdgcn_exp2f(acc[ai][0][m][n][i] * nrs));
                            *(f32x4*)(GT + (size_t)row * 32 + 8 * fq + 4 * n) = gv4; }
                    }
                    continue;
                }
                float f = rs;
                if (gain) { float ss = 0.f;
#pragma unroll
                    for (int bj = 0; bj < 2; ++bj)
#pragma unroll
                        for (int n = 0; n < 2; ++n) { const f32x4 q = acc[ai][bj][m][n]; ss += (q[0] * q[0] + q[1] * q[1]) + (q[2] * q[2] + q[3] * q[3]); }
                    ss += __shfl_xor(ss, 16); ss += __shfl_xor(ss, 32); f = rs * __builtin_amdgcn_rsqf(ss * (rs * rs) * (1.0f / 64.0f) + 1e-6f); }
                const int b = row / seq, s = row % seq;
                bf16_t* rowp = dst + ((size_t)(b * nh + hh) * seq + s) * 64 + 8 * fq;
#pragma unroll
                for (int bj = 0; bj < 2; ++bj) { const f32x4 v0 = acc[ai][bj][m][0] * gv[bj][0] * f, v1 = acc[ai][bj][m][1] * gv[bj][1] * f; u32x4 w;
                    w.x = cvt_pk_bf16(v0[0], v0[1]); w.y = cvt_pk_bf16(v0[2], v0[3]); w.z = cvt_pk_bf16(v1[0], v1[1]); w.w = cvt_pk_bf16(v1[2], v1[3]);
                    *(u32x4*)(rowp + 32 * bj) = w; } }
    }
};
struct EpiProjT {
    static constexpr bool PERM = true, AFTER_DRAIN = false;
    const float* ssq; bf16_t* VT0; size_t vstride; int seq;
    __device__ __forceinline__ void operator()(const f32x4 (&acc)[2][2][4][2], const Unit& u, int wr, int wc, int fr, int fq) const {
#pragma unroll
        for (int bj = 0; bj < 2; ++bj) { const int t0 = u.pn * BM + bj * HALF + wc * 32 + 8 * fq;
            float q8[8];
#pragma unroll
            for (int i = 0; i < 8; ++i) q8[i] = ssq[(size_t)(t0 + i) * 16 + fr];
#pragma unroll
            for (int i = 0; i < 8; ++i) { float q = q8[i]; q += __shfl_xor(q, 1); q += __shfl_xor(q, 2); q += __shfl_xor(q, 4); q += __shfl_xor(q, 8); q8[i] = __builtin_amdgcn_rsqf(q * (1.0f / 1024.0f) + 1e-6f); }
            const f32x4 r0 = {q8[0], q8[1], q8[2], q8[3]}, r1 = {q8[4], q8[5], q8[6], q8[7]};
            const int b = t0 / seq, s = t0 % seq;
#pragma unroll
            for (int ai = 0; ai < 2; ++ai) { const int vh = 4 * u.pm + 2 * ai + wr; if (vh >= 6) continue;
                bf16_t* dst = VT0 + (size_t)(vh >> 1) * vstride; const int g = vh & 1;
                bf16_t* blk = dst + ((size_t)(b * 2 + g) * (seq / 32) + (s >> 5)) * 2048 + (s & 31);
#pragma unroll
                for (int m = 0; m < 4; ++m) { const int d = 16 * m + fr; const f32x4 v0 = acc[ai][bj][m][0] * r0, v1 = acc[ai][bj][m][1] * r1; u32x4 w;
                    w.x = cvt_pk_bf16(v0[0], v0[1]); w.y = cvt_pk_bf16(v0[2], v0[3]); w.z = cvt_pk_bf16(v1[0], v1[1]); w.w = cvt_pk_bf16(v1[2], v1[3]);
                    { const auto s0 = __builtin_amdgcn_permlane16_swap(w.x, w.z, false, false), s1 = __builtin_amdgcn_permlane16_swap(w.y, w.w, false, false); w.x = s0[0]; w.z = s0[1]; w.y = s1[0]; w.w = s1[1]; }
                    *(u32x4*)(blk + d * 32) = w; } } }
    }
};
struct OneUnit {
    int pm, pn;
    __device__ __forceinline__ bool next(int i, Unit& u) const { if (i) return false; u.pm = pm; u.pn = pn; return true; }
    __device__ __forceinline__ void a_ready(const Unit&) const {}
    __device__ __forceinline__ void done(const Unit&) const {}
};
template <class Epi, class Sched, bool ALIGN_EPI = false, bool SP2 = false, bool AHALF = false>
__device__ __forceinline__ void gemm_phase(PG8_LAS unsigned char* lds, const Gemm g, const Sched& S, const Epi& E, int wv  ) {
    static_assert(!AHALF || SP2, "AHALF is written for the SP2 loop");
    const int wid = wv, lane = hw_lane_id(), tid = wid * 64 + lane, wr = wid >> 2, wc = wid & 3, fr = lane & 15, fq = lane >> 4;
    const int K = g.K, nt = K / BK;
    unsigned voffA[2], voffB[2];
#pragma unroll
    for (int i = 0; i < 2; ++i) { int R, C; stage_rc(tid * 16 + i * 8192, R, C); const int Rb = Epi::PERM ? ((R & ~31) + perm32(R & 31)) : R;
        voffA[i] = (unsigned)(R * K + C) * 2u; voffB[i] = (unsigned)(Rb * K + C) * 2u; }
    const size_t kstep = (size_t)(BK * 2);
    const size_t hstep = (size_t)HALF * K * 2;
    const size_t tstep = 2 * hstep;
    const unsigned ldsw = (unsigned)wid * 1024u;
    const int aoff = lds_byte(wr * 64 + fr, fq * 8), boff = lds_byte(wc * 32 + fr, fq * 8);
#define PG8_SA(b, h) (((b) * 2 + (h)) * HTB)
#define PG8_SB(b, h) ((4 + (b) * 2 + (h)) * HTB)
#define PG8_STAGE(bufoff, gbase, voff) do { _Pragma("unroll") for (int _i = 0; _i < 2; ++_i) \
        __builtin_amdgcn_global_load_lds((const unsigned*)((const char*)(gbase) + (voff)[_i]), (PG8_LAS unsigned*)(lds + (bufoff) + ldsw + _i * 8192), 16, 0, 0); } while (0)
#define PG8_LDA(dst, b, h) do { _Pragma("unroll") for (int m = 0; m < 4; ++m) _Pragma("unroll") for (int k = 0; k < 2; ++k) dst[m][k] = *(const PG8_LAS bf16x8*)(lds + PG8_SA(b, h) + aoff + m * 2048 + k * 1024); } while (0)
#define PG8_LDB(dst, b, h) do { _Pragma("unroll") for (int n = 0; n < 2; ++n) _Pragma("unroll") for (int k = 0; k < 2; ++k) dst[n][k] = *(const PG8_LAS bf16x8*)(lds + PG8_SB(b, h) + boff + n * 2048 + k * 1024); } while (0)
#define PG8_MMA(ai, bj, At, Bt) do { __builtin_amdgcn_s_setprio(1); _Pragma("unroll") for (int m = 0; m < 4; ++m) _Pragma("unroll") for (int n = 0; n < 2; ++n) _Pragma("unroll") for (int k = 0; k < 2; ++k) \
        acc[ai][bj][m][n] = __builtin_amdgcn_mfma_f32_16x16x32_bf16(Bt[n][k], At[m][k], acc[ai][bj][m][n], 0, 0, 0); __builtin_amdgcn_s_setprio(0); } while (0)
#define PG8_WAIT_V(n) asm volatile("s_waitcnt vmcnt(" #n ")" ::: "memory")
#define PG8_WAIT_L(n) asm volatile("s_waitcnt lgkmcnt(" #n ")" ::: "memory")
#define PG8_BAR __builtin_amdgcn_s_barrier()
#define PG8_SCHED __builtin_amdgcn_sched_barrier(0)
    Unit cur, nxt; int ui = 0;
    if (!S.next(0, cur)) return;
    f32x4 acc[2][2][4][2];
#pragma unroll
    for (int a = 0; a < 2; ++a)
#pragma unroll
        for (int b = 0; b < 2; ++b)
#pragma unroll
            for (int m = 0; m < 4; ++m)
#pragma unroll
                for (int n = 0; n < 2; ++n) acc[a][b][m][n] = (f32x4){0.f, 0.f, 0.f, 0.f};
    bf16x8 At[4][2], B0[2][2], B1[2][2];
    const char* cA = (const char*)g.A + (size_t)cur.pm * tstep; const char* cB = (const char*)g.Bt + (size_t)cur.pn * tstep;
    S.a_ready(cur);
    if constexpr (SP2) {
        PG8_STAGE(PG8_SB(0, 0), cB, voffB); PG8_STAGE(PG8_SB(0, 1), cB + hstep, voffB); PG8_STAGE(PG8_SA(0, 0), cA, voffA); PG8_STAGE(PG8_SA(0, 1), cA + hstep, voffA);
        if (wr == 1) PG8_BAR;
        PG8_WAIT_V(2); PG8_BAR;
        PG8_STAGE(PG8_SB(1, 0), cB + kstep, voffB); PG8_STAGE(PG8_SA(1, 0), cA + kstep, voffA); PG8_STAGE(PG8_SB(1, 1), cB + hstep + kstep, voffB);
        PG8_WAIT_V(6); PG8_BAR;
    } else {
        PG8_STAGE(PG8_SB(0, 0), cB, voffB); PG8_STAGE(PG8_SA(0, 0), cA, voffA); PG8_STAGE(PG8_SB(0, 1), cB + hstep, voffB); PG8_STAGE(PG8_SA(0, 1), cA + hstep, voffA);
        if (wr == 1) PG8_BAR;
        PG8_WAIT_V(4); PG8_BAR;
        PG8_STAGE(PG8_SB(1, 0), cB + kstep, voffB); PG8_STAGE(PG8_SA(1, 0), cA + kstep, voffA); PG8_STAGE(PG8_SB(1, 1), cB + hstep + kstep, voffB);
        PG8_WAIT_V(6); PG8_BAR;
    }
    for (;;) {
        const bool has_next = S.next(ui + 1, nxt);
        const char* nA = has_next ? (const char*)g.A + (size_t)nxt.pm * tstep : cA; const char* nB = has_next ? (const char*)g.Bt + (size_t)nxt.pn * tstep : cB;
        for (int t = 0; t < nt; t += 2) {
            const bool last = (t == nt - 2);
            const char* a1 = cA + (size_t)(t + 1) * kstep;
            const char* a2 = last ? nA : cA + (size_t)(t + 2) * kstep; const char* b2 = last ? nB : cB + (size_t)(t + 2) * kstep;
            const char* a3 = a2 + kstep; const char* b3 = b2 + kstep;
            if (last && has_next) S.a_ready(nxt);
            if constexpr (SP2) {
            PG8_LDB(B0, 0, 0); PG8_LDB(B1, 0, 1); PG8_SCHED; PG8_LDA(At, 0, 0); PG8_STAGE(PG8_SA(1, 1), a1 + hstep, voffA);
            PG8_WAIT_V(8); PG8_WAIT_L(0); PG8_BAR; PG8_MMA(0, 0, At, B0); PG8_MMA(0, 1, At, B1); PG8_BAR; PG8_SCHED;
            if constexpr (!AHALF) PG8_LDA(At, 0, 1);
            PG8_STAGE(PG8_SB(0, 0), b2, voffB); PG8_STAGE(PG8_SB(0, 1), b2 + hstep, voffB); PG8_STAGE(PG8_SA(0, 0), a2, voffA);
            PG8_WAIT_V(8); PG8_WAIT_L(0); PG8_BAR; if constexpr (!AHALF) { PG8_MMA(1, 0, At, B0); PG8_MMA(1, 1, At, B1); } PG8_BAR; PG8_SCHED;
            PG8_LDB(B0, 1, 0); PG8_LDB(B1, 1, 1); PG8_SCHED; PG8_LDA(At, 1, 0); PG8_STAGE(PG8_SA(0, 1), a2 + hstep, voffA);
            PG8_WAIT_V(8); PG8_WAIT_L(0); PG8_BAR; PG8_MMA(0, 0, At, B0); PG8_MMA(0, 1, At, B1); PG8_BAR; PG8_SCHED;
            if constexpr (!AHALF) PG8_LDA(At, 1, 1);
            PG8_STAGE(PG8_SB(1, 0), b3, voffB); PG8_STAGE(PG8_SB(1, 1), b3 + hstep, voffB); PG8_STAGE(PG8_SA(1, 0), a3, voffA);
            PG8_WAIT_V(8); PG8_WAIT_L(0); PG8_BAR; if constexpr (!AHALF) { PG8_MMA(1, 0, At, B0); PG8_MMA(1, 1, At, B1); } PG8_BAR; PG8_SCHED;
            } else {
            PG8_LDB(B0, 0, 0); PG8_SCHED; PG8_LDA(At, 0, 0); PG8_STAGE(PG8_SA(1, 1), a1 + hstep, voffA);
            PG8_WAIT_L(8); PG8_BAR; PG8_WAIT_L(0); PG8_MMA(0, 0, At, B0); PG8_BAR; PG8_SCHED;
            PG8_LDB(B1, 0, 1); PG8_STAGE(PG8_SB(0, 0), b2, voffB);
            PG8_BAR; PG8_WAIT_L(0); PG8_MMA(0, 1, At, B1); PG8_BAR;
            PG8_LDA(At, 0, 1); PG8_STAGE(PG8_SA(0, 0), a2, voffA);
            PG8_BAR; PG8_WAIT_L(0); PG8_MMA(1, 0, At, B0); PG8_BAR; PG8_SCHED;
            PG8_STAGE(PG8_SB(0, 1), b2 + hstep, voffB);
            PG8_WAIT_V(6); PG8_BAR; PG8_MMA(1, 1, At, B1); PG8_BAR;
            PG8_LDB(B0, 1, 0); PG8_SCHED; PG8_LDA(At, 1, 0); PG8_STAGE(PG8_SA(0, 1), a2 + hstep, voffA);
            PG8_WAIT_L(8); PG8_BAR; PG8_WAIT_L(0); PG8_MMA(0, 0, At, B0); PG8_BAR; PG8_SCHED;
            PG8_LDB(B1, 1, 1); PG8_STAGE(PG8_SB(1, 0), b3, voffB);
            PG8_BAR; PG8_WAIT_L(0); PG8_MMA(0, 1, At, B1); PG8_BAR;
            PG8_LDA(At, 1, 1); PG8_STAGE(PG8_SA(1, 0), a3, voffA);
            PG8_BAR; PG8_WAIT_L(0); PG8_MMA(1, 0, At, B0); PG8_BAR; PG8_SCHED;
            PG8_STAGE(PG8_SB(1, 1), b3 + hstep, voffB);
            PG8_WAIT_V(6); PG8_BAR; PG8_MMA(1, 1, At, B1); PG8_BAR;
            }
        }
        if constexpr (ALIGN_EPI) { if (wr == 0) PG8_BAR; }
        if constexpr (!Epi::AFTER_DRAIN) { E(acc, cur, wr, wc, fr, fq); S.done(cur); }
        if (!has_next) break;
#pragma unroll
        for (int a = 0; a < 2; ++a)
#pragma unroll
            for (int b = 0; b < 2; ++b)
#pragma unroll
                for (int m = 0; m < 4; ++m)
#pragma unroll
                    for (int n = 0; n < 2; ++n) acc[a][b][m][n] = (f32x4){0.f, 0.f, 0.f, 0.f};
        cur = nxt; cA = nA; cB = nB; ++ui;
        if constexpr (ALIGN_EPI) { if (wr == 1) PG8_BAR; }
    }
    PG8_WAIT_V(0);
    if constexpr (!ALIGN_EPI) { if (wr == 0) PG8_BAR; }
    PG8_BAR;
    if constexpr (Epi::AFTER_DRAIN) { E.fused(acc, cur, wr, wc, fr, fq, lds, wid, lane); S.done(cur); }
#undef PG8_SA
#undef PG8_SB
#undef PG8_STAGE
#undef PG8_LDA
#undef PG8_LDB
#undef PG8_MMA
#undef PG8_WAIT_V
#undef PG8_WAIT_L
#undef PG8_BAR
#undef PG8_SCHED
}
}
#define GAS __attribute__((address_space(1)))
#define LAS __attribute__((address_space(3)))
typedef unsigned short bf16;
typedef unsigned v4u __attribute__((ext_vector_type(4)));
typedef float f32x4 __attribute__((ext_vector_type(4)));
typedef short bf16x8 __attribute__((ext_vector_type(8)));
typedef GAS unsigned gu32;
typedef GAS unsigned long long gu64;
#define RLX_AGENT __ATOMIC_RELAXED, __HIP_MEMORY_SCOPE_AGENT
#define LDS_WAIT() asm volatile("s_waitcnt lgkmcnt(0)" ::: "memory")
#define VM_WAIT() asm volatile("s_waitcnt vmcnt(0)" ::: "memory")
__device__ __forceinline__ unsigned long long rt() { return __builtin_amdgcn_s_memrealtime(); }
__device__ __forceinline__ unsigned f2bf(float f) { unsigned u = __builtin_bit_cast(unsigned, f); return (u + 0x7fffu + ((u >> 16) & 1u)) >> 16; }
__device__ __forceinline__ unsigned pk2(float lo, float hi) { return f2bf(lo) | (f2bf(hi) << 16); }

#define XB_TMO      128
#define XB_XCNT(j)  (256  + 64 * (j))
#define XB_XSUB(j)  (1280 + 64 * (j))
#define XB_XGEN(j)  (2304 + 64 * (j))
#define XB_TOP      3328
#define XB_TOPGEN   3392
#define XCD_BAR_WORDS 3456
#define XB_SPIN_CAP (1u << 18)

__device__ __forceinline__ unsigned xb_ld(unsigned* p)              { return __hip_atomic_load(p, __ATOMIC_RELAXED, __HIP_MEMORY_SCOPE_AGENT); }
__device__ __forceinline__ unsigned xb_add(unsigned* p, unsigned v) { return __hip_atomic_fetch_add(p, v, __ATOMIC_RELAXED, __HIP_MEMORY_SCOPE_AGENT); }
__device__ __forceinline__ unsigned xb_xcc_id() { return (unsigned)__builtin_amdgcn_s_getreg((3 << 11) | 20) & 0xFu; }
#define XB_SPIN(cond, bar) do { unsigned _sp = 0; while (cond) { __builtin_amdgcn_s_sleep(1); \
    if ((++_sp & 255u) == 0u) { if (xb_ld(&(bar)[XB_TMO])) break; if (_sp > XB_SPIN_CAP) { atomicAdd(&(bar)[XB_TMO], 1u); break; } } } } while (0)

struct XcdBarrier {
    unsigned* bar; unsigned x;
    volatile LAS unsigned* st;
};

__device__ __forceinline__ XcdBarrier xcd_barrier_post(unsigned* bar, volatile LAS unsigned* st, bool leader  ) {
    XcdBarrier b; b.bar = bar; b.x = xb_xcc_id(); b.st = st;
    if (leader) (void)xb_add(&bar[XB_XCNT(b.x)], 1u);
    return b;
}
__device__ __forceinline__ void xcd_barrier_complete(unsigned* bar, unsigned x, unsigned& nloc, unsigned& nx) {
    const unsigned G = gridDim.x * gridDim.y * gridDim.z;
    unsigned sum, cnt, mine, sp = 0u;
    for (;;) {
        sum = 0u; cnt = 0u; mine = 0u;
#pragma unroll
        for (unsigned j = 0; j < 16; ++j) { const unsigned c = xb_ld(&bar[XB_XCNT(j)]); sum += c; cnt += (c > 0u) ? 1u : 0u; mine = (j == x) ? c : mine; }
        if (sum == G) break;
        __builtin_amdgcn_s_sleep(1);
        if ((++sp & 255u) == 0u) { if (xb_ld(&bar[XB_TMO])) break; if (sp > XB_SPIN_CAP) { atomicAdd(&bar[XB_TMO], 1u); break; } }
    }
    nloc = mine > 0u ? mine : 1u; nx = cnt > 0u ? cnt : 1u;
}

__device__ __forceinline__ void xcd_barrier(const XcdBarrier& b, bool leader  ) {
    asm volatile("s_waitcnt vmcnt(0)" ::: "memory");
    __syncthreads();
    if (leader) {
        unsigned* bar = b.bar;
        __builtin_amdgcn_s_waitcnt(0);
        unsigned nloc = b.st[0], nx = b.st[1];
        if (nloc == 0u) { xcd_barrier_complete(bar, b.x, nloc, nx); b.st[0] = nloc; b.st[1] = nx; }
        const unsigned old = xb_add(&bar[XB_XSUB(b.x)], 1u);
        const unsigned gen = old / nloc;
        if (old + 1u == (gen + 1u) * nloc) {
            __builtin_amdgcn_fence(__ATOMIC_RELEASE, "agent");
            asm volatile("s_waitcnt vmcnt(0)" ::: "memory");
            const unsigned og = xb_add(&bar[XB_TOP], 1u);
            const unsigned tg = og / nx;
            if (og + 1u == (tg + 1u) * nx) xb_add(&bar[XB_TOPGEN], 1u);
            else XB_SPIN(xb_ld(&bar[XB_TOPGEN]) == tg, bar);
            __builtin_amdgcn_fence(__ATOMIC_ACQUIRE, "agent");
            xb_add(&bar[XB_XGEN(b.x)], 1u);
            asm volatile("s_waitcnt vmcnt(0)" ::: "memory");
        } else {
            XB_SPIN(xb_ld(&bar[XB_XGEN(b.x)]) == gen, bar);
            __builtin_amdgcn_fence(__ATOMIC_ACQUIRE, "agent");
            asm volatile("s_waitcnt vmcnt(0)" ::: "memory");
        }
    }
    __syncthreads();
}

constexpr int NWAVES = 8;
constexpr int BATCH = 8, SEQ = 4096, DM = 1024, FF = 2816, T = BATCH * SEQ;
constexpr float EPS = 1e-6f;
constexpr float LOG2E = 1.4426950408889634f;
constexpr float QSCALE = 0.125f * LOG2E;
constexpr float NEGL = -1.0e9f * LOG2E;
constexpr int NMAIN = 1792;
constexpr int NPLAIN = 2304;

constexpr size_t MiB = 1u << 20, KiB = 1u << 10;
constexpr size_t WS_CTL = 0, CTL_ZERO_BYTES = 64 * KiB;
constexpr size_t WS_WIN1 = 2 * MiB, WS_WOUT1 = 13 * MiB, WS_WIN2 = 19 * MiB, WS_WOUT2 = 30 * MiB, WS_WMAIN = 36 * MiB, WS_WVT = 41 * MiB, WS_WMO = 42 * MiB;
constexpr size_t WS_W1T = 44 * MiB, WS_W2T = 45 * MiB, WS_POSB = 45 * MiB + 64 * KiB, WS_RSTD = 45 * MiB + 128 * KiB, WS_SSQ1 = 46 * MiB, WS_SSQ2 = 48 * MiB, WS_GT = 50 * MiB  , WS_KC = 54 * MiB, WS_VCT = 54 * MiB + 512 * KiB;
constexpr size_t WS_A = 56 * MiB;
constexpr size_t WS_ACT = 120 * MiB;
constexpr size_t WS_QA = 120 * MiB, WS_QB = 152 * MiB, WS_KA = 184 * MiB, WS_KCR = 192 * MiB, WS_VCR = 200 * MiB, WS_KS = 208 * MiB, WS_KW = 216 * MiB, WS_VAT = 224 * MiB, WS_VST = 232 * MiB, WS_VWT = 240 * MiB;
constexpr size_t WS_MIX = 296 * MiB;
constexpr size_t WS_PROJ = 360 * MiB;
constexpr size_t WS_END = 504 * MiB;
constexpr int CW_BAR = 4096;

constexpr int RING_OFF = 0, RING_BYTES = 131072;
constexpr int LDSCTL_OFF = RING_BYTES, MISC_OFF = LDSCTL_OFF + 320;
constexpr int LDS_BYTES = 147456;

typedef unsigned short bf16;
__device__ __forceinline__ float bf2f(bf16 v) { return __uint_as_float(((unsigned)v) << 16); }
__device__ __forceinline__ float wave_sum(float v) {
#pragma unroll
    for (int o = 1; o < 64; o <<= 1) v += __shfl_xor(v, o);
    return v;
}
__device__ __forceinline__ float wave_max(float v) {
#pragma unroll
    for (int o = 1; o < 64; o <<= 1) v = fmaxf(v, __shfl_xor(v, o));
    return v;
}
__device__ __forceinline__ int t5_bucket(int n) {
    if (n < 16) return n < 0 ? 0 : n;
    const int b = 16 + (int)(__log2f((float)n * 0.0625f) * (16.0f / 3.0f));
    return b > 31 ? 31 : b;
}
struct Frame {
    LAS unsigned char* lds; volatile LAS unsigned* MISC; gu32* ctl;
    int tid, lane, wave, vcu, G;
};

__global__ void __launch_bounds__(256) nv_rmsnorm(const float* x, const float* g, bf16* out) {
    const int lane = threadIdx.x & 63, row = blockIdx.x * 4 + (threadIdx.x >> 6);
    const f32x4* xr = (const f32x4*)(x + (size_t)row * DM) + lane; const f32x4* gr = (const f32x4*)g + lane;
    f32x4 v[4]; float s = 0.f;
#pragma unroll
    for (int j = 0; j < 4; ++j) { v[j] = xr[64 * j]; s += (v[j].x * v[j].x + v[j].y * v[j].y) + (v[j].z * v[j].z + v[j].w * v[j].w); }
    const float rstd = 1.0f / sqrtf(wave_sum(s) * (1.f / DM) + EPS);
    unsigned long long* o8 = (unsigned long long*)(out + (size_t)row * DM) + lane;
#pragma unroll
    for (int j = 0; j < 4; ++j) { const f32x4 gg = gr[64 * j]; o8[64 * j] = (unsigned long long)pk2(v[j].x * rstd * gg.x, v[j].y * rstd * gg.y) | ((unsigned long long)pk2(v[j].z * rstd * gg.z, v[j].w * rstd * gg.w) << 32); }
}

struct HeadPrep {
    const bf16* proj; const float* ssq;
    const float *qna, *kna, *qnb, *knb;
    bf16 *QA, *QB, *KA, *VAT, *KCR, *VCR, *KS, *VST, *KW, *VWT; float* GT;
};
__global__ void __launch_bounds__(256) nv_headprep(HeadPrep p) {
    const int lane = threadIdx.x & 63, t = blockIdx.x * 4 + (threadIdx.x >> 6), b = t / SEQ, s = t % SEQ;
    float rs = 1.0f;
    if (p.ssq) { float q = p.ssq[(size_t)t * 16 + (lane & 15)]; q += __shfl_xor(q, 1); q += __shfl_xor(q, 2); q += __shfl_xor(q, 4); q += __shfl_xor(q, 8); rs = 1.0f / sqrtf(q * (1.f / DM) + EPS); }
    const bf16* pr = p.proj + (size_t)t * NPLAIN;
    for (int H = 0; H < 32; ++H) {
        const float v = bf2f(pr[H * 64 + lane]) * rs;
        const float* gain = nullptr; float sc = 1.0f; bf16* dst; bool tr = false; int hh, nh;
        if (H < 8) { gain = p.qna; sc = QSCALE; dst = p.QA; hh = H; nh = 8; }
        else if (H < 10) { gain = p.kna; dst = p.KA; hh = H - 8; nh = 2; }
        else if (H < 12) { dst = p.VAT; hh = H - 10; nh = 2; tr = true; }
        else if (H < 20) { gain = p.qnb; sc = QSCALE; dst = p.QB; hh = H - 12; nh = 8; }
        else { const int slot = (H - 20) >> 1; hh = (H - 20) & 1; nh = 2;
            if (slot == 0) dst = p.KCR; else if (slot == 1) dst = p.VCR; else if (slot == 2) { dst = p.KS; gain = p.knb; } else if (slot == 3) { dst = p.VST; tr = true; } else if (slot == 4) { dst = p.KW; gain = p.knb; } else { dst = p.VWT; tr = true; } }
        float y = v;
        if (gain) { const float ss = wave_sum(v * v); y = v * (1.0f / sqrtf(ss * (1.f / 64.f) + EPS)) * gain[lane] * sc; }
        if (!tr) dst[((size_t)(b * nh + hh) * SEQ + s) * 64 + lane] = (bf16)f2bf(y);
        else dst[(((size_t)(b * nh + hh) * (SEQ / 32) + (s >> 5)) * 64 + lane) * 32 + (s & 31)] = (bf16)f2bf(y);
    }
    if (lane < 24) { const float v = bf2f(pr[2048 + lane]) * rs; p.GT[(size_t)t * 32 + lane] = 1.0f / (1.0f + __expf(-v)); }
}

__global__ void __launch_bounds__(128) nv_compress(const bf16* KCR, const bf16* VCR, const float* pos, const float* w1, const float* b1, const float* w2, const float* b2, const float* knb, bf16* KC, bf16* VCT) {
    __shared__ float sh[128];
    const int tid = threadIdx.x; int idx = blockIdx.x; const int c = idx & 255; idx >>= 8; const int g = idx & 1, b = (idx >> 1) & 7, kv = idx >> 4;
    if (c == 255) { if (tid < 64) { if (kv == 0) KC[((size_t)(b * 2 + g) * 256 + c) * 64 + tid] = 0; else VCT[(((size_t)(b * 2 + g) * 8 + (c >> 5)) * 64 + tid) * 32 + (c & 31)] = 0; } return; }
    const bf16* raw = (kv == 0 ? KCR : VCR) + ((size_t)(b * 2 + g) * SEQ + 16 * c) * 64;
    float acc = b1[kv * 128 + tid];
    for (int k = 0; k < 2048; ++k) acc += (bf2f(raw[k]) + pos[kv * 2048 + k]) * w1[((size_t)kv * 2048 + k) * 128 + tid];
    sh[tid] = acc / (1.0f + __expf(-acc));
    __syncthreads();
    if (tid < 64) {
        float o = b2[kv * 64 + tid];
        for (int h = 0; h < 128; ++h) o += sh[h] * w2[((size_t)kv * 128 + h) * 64 + tid];
        if (kv == 0) { const float ss = wave_sum(o * o); const float y = o * (1.0f / sqrtf(ss * (1.f / 64.f) + EPS)) * knb[tid]; KC[((size_t)(b * 2 + g) * 256 + c) * 64 + tid] = (bf16)f2bf(y); }
        else VCT[(((size_t)(b * 2 + g) * 8 + (c >> 5)) * 64 + tid) * 32 + (c & 31)] = (bf16)f2bf(o);
    }
}

__device__ __forceinline__ float vt_at(const bf16* VT, int bg, int nblk, int key, int d) { return bf2f(VT[(((size_t)bg * nblk + (key >> 5)) * 64 + d) * 32 + (key & 31)]); }

__global__ void __launch_bounds__(256) nv_band_a(const bf16* QA, const bf16* KA, const bf16* VAT, const float* tbl, const float* sinks, bf16* mix) {
    __shared__ float sq[4][64], sl[4][128];
    const int lane = threadIdx.x & 63, w = threadIdx.x >> 6; const int s = blockIdx.x % SEQ, bg = blockIdx.x / SEQ, g = bg & 1, b = bg >> 1, head = g * 4 + w;
    sq[w][lane] = bf2f(QA[((size_t)(b * 8 + head) * SEQ + s) * 64 + lane]);
    __syncthreads();
    float lg[2];
#pragma unroll
    for (int j = 0; j < 2; ++j) { const int rel = 64 * j + lane, key = s - rel; float v = NEGL;
        if (key >= 0) { const bf16* kr = KA + ((size_t)bg * SEQ + key) * 64; float dot = 0.f; for (int d = 0; d < 64; ++d) dot += sq[w][d] * bf2f(kr[d]); v = dot + tbl[t5_bucket(rel) * 16 + head] * LOG2E; }
        lg[j] = v; }
    const float sk = sinks[head] * LOG2E;
    const float m = fmaxf(wave_max(fmaxf(lg[0], lg[1])), sk);
    const float p0 = exp2f(lg[0] - m), p1 = exp2f(lg[1] - m);
    const float sum = wave_sum(p0 + p1) + exp2f(sk - m);
    sl[w][lane] = p0; sl[w][64 + lane] = p1;
    __syncthreads();
    float o = 0.f;
    for (int rel = 0; rel < 128; ++rel) { const int key = s - rel; if (key >= 0) o += sl[w][rel] * vt_at(VAT, bg, SEQ / 32, key, lane); }
    mix[(size_t)(b * SEQ + s) * 1024 + head * 64 + lane] = (bf16)f2bf(o / sum);
}

__global__ void __launch_bounds__(256) nv_nsa(const bf16* QB, const bf16* KC, const bf16* VCT, const bf16* KS, const bf16* VST, const bf16* KW, const bf16* VWT, const float* GT, const float* tbl, bf16* mix) {
    __shared__ float sq[4][64], sP[4][256], sL[4][1024]; __shared__ unsigned long long smask;
    const int lane = threadIdx.x & 63, w = threadIdx.x >> 6; const int s = blockIdx.x % SEQ, bg = blockIdx.x / SEQ, g = bg & 1, b = bg >> 1, head = g * 4 + w, tc = 8 + head;
    const int t = b * SEQ + s;
    sq[w][lane] = bf2f(QB[((size_t)(b * 8 + head) * SEQ + s) * 64 + lane]);
    __syncthreads();
    const int ncv = s >= 31 ? ((s - 31) / 16 + 1 > 255 ? 255 : (s - 31) / 16 + 1) : 0;
    float lc[4];
#pragma unroll
    for (int j = 0; j < 4; ++j) { const int c = lane + 64 * j; float v = NEGL;
        if (c < ncv) { const bf16* kr = KC + ((size_t)bg * 256 + c) * 64; float dot = 0.f; for (int d = 0; d < 64; ++d) dot += sq[w][d] * bf2f(kr[d]); v = dot + tbl[t5_bucket(s - (16 * c + 31)) * 16 + tc] * LOG2E; }
        lc[j] = v; }
    {
        const float m = wave_max(fmaxf(fmaxf(lc[0], lc[1]), fmaxf(lc[2], lc[3])));
        float p[4]; float ps = 0.f;
#pragma unroll
        for (int j = 0; j < 4; ++j) { p[j] = (lane + 64 * j < ncv) ? exp2f(lc[j] - m) : 0.f; ps += p[j]; }
        const float inv = 1.0f / fmaxf(wave_sum(ps), 1.1754944e-38f);
#pragma unroll
        for (int j = 0; j < 4; ++j) sP[w][lane + 64 * j] = p[j] * inv;
    }
    __syncthreads();
    float o_cmp = 0.f;
    for (int c = 0; c < ncv; ++c) o_cmp += sP[w][c] * vt_at(VCT, bg, 8, c, lane);
    if (w == 0) {
        const int n = lane, cur = s >> 6; float imp = 0.f;
        for (int c = 4 * n - 1; c <= 4 * n + 3; ++c) if (c >= 0 && c < 255) imp += (sP[0][c] + sP[1][c]) + (sP[2][c] + sP[3][c]);
        const bool valid = n <= cur, forced = (n == 0) || (n == cur) || (n == cur - 1);
        const float score = valid ? imp + (forced ? 1000.0f : 0.0f) : -1.0e9f;
        int rank = 0;
        for (int mm = 0; mm < 64; ++mm) { const float sm = __shfl(score, mm); rank += (sm > score || (sm == score && mm < n)) ? 1 : 0; }
        const unsigned long long mk = __ballot(valid && rank < 16);
        if (lane == 0) smask = mk;
    }
    __syncthreads();
    const unsigned long long mask = smask;
    float o_sel = 0.f;
    {
        int cnt = 0; float mx = NEGL;
        for (int n = 0; n < 64; ++n) if ((mask >> n) & 1ull) { const int key = 64 * n + lane, rel = s - key; float v = NEGL;
            if (rel >= 0) { const bf16* kr = KS + ((size_t)bg * SEQ + key) * 64; float dot = 0.f; for (int d = 0; d < 64; ++d) dot += sq[w][d] * bf2f(kr[d]); v = dot + tbl[t5_bucket(rel) * 16 + tc] * LOG2E; }
            sL[w][cnt * 64 + lane] = v; mx = fmaxf(mx, v); ++cnt; }
        mx = wave_max(mx); float ps = 0.f;
        for (int i = 0; i < cnt; ++i) { const float p = exp2f(sL[w][i * 64 + lane] - mx); sL[w][i * 64 + lane] = p; ps += p; }
        ps = wave_sum(ps);
        __syncthreads();
        int i = 0;
        for (int n = 0; n < 64; ++n) if ((mask >> n) & 1ull) { for (int k = 0; k < 64; ++k) { const int key = 64 * n + k; if (key <= s) o_sel += sL[w][i * 64 + k] * vt_at(VST, bg, SEQ / 32, key, lane); } ++i; }
        o_sel /= ps;
        __syncthreads();
    }
    float o_win = 0.f;
    {
        float mx = NEGL;
        for (int j = 0; j < 8; ++j) { const int rel = 64 * j + lane, key = s - rel; float v = NEGL;
            if (key >= 0) { const bf16* kr = KW + ((size_t)bg * SEQ + key) * 64; float dot = 0.f; for (int d = 0; d < 64; ++d) dot += sq[w][d] * bf2f(kr[d]); v = dot + tbl[t5_bucket(rel) * 16 + tc] * LOG2E; }
            sL[w][rel] = v; mx = fmaxf(mx, v); }
        mx = wave_max(mx); float ps = 0.f;
        for (int j = 0; j < 8; ++j) { const float p = exp2f(sL[w][64 * j + lane] - mx); sL[w][64 * j + lane] = p; ps += p; }
        ps = wave_sum(ps);
        __syncthreads();
        for (int rel = 0; rel < 512; ++rel) { const int key = s - rel; if (key >= 0) o_win += sL[w][rel] * vt_at(VWT, bg, SEQ / 32, key, lane); }
        o_win /= ps;
    }
    const float g0 = GT[(size_t)t * 32 + 0 * 8 + head], g1 = GT[(size_t)t * 32 + 1 * 8 + head], g2 = GT[(size_t)t * 32 + 2 * 8 + head];
    mix[(size_t)t * 1024 + 512 + head * 64 + lane] = (bf16)f2bf(g0 * o_cmp + g1 * o_sel + g2 * o_win);
}

typedef float f32x16 __attribute__((ext_vector_type(16)));
typedef short s16x4 __attribute__((ext_vector_type(4)));
typedef unsigned u32x4v __attribute__((ext_vector_type(4)));
typedef unsigned u32x2v __attribute__((ext_vector_type(2)));
constexpr int LA = 296, OFFA = 231;
constexpr int LB = 680, OFFB = 615;
constexpr int ATT_LUTA_OFF = 0, ATT_LUTB_OFF = 8 * LA * 4, ATT_WSCR_OFF = ATT_LUTB_OFF + 8 * LB * 4, ATT_WSCR_BYTES = 4096;
static_assert(ATT_WSCR_OFF % 16 == 0 && ATT_WSCR_OFF + 8 * ATT_WSCR_BYTES <= RING_BYTES, "attention LDS map");

struct AttP { const bf16 *QA, *QB, *KA, *VAT, *KC, *VCT, *KS, *VST, *KW, *VWT; const float* GT; bf16* mix; };

__device__ __forceinline__ float xhalf_max(float v) { auto rr = __builtin_amdgcn_permlane32_swap(__float_as_uint(v), __float_as_uint(v), false, false); return fmaxf(__uint_as_float(rr[0]), __uint_as_float(rr[1])); }
__device__ __forceinline__ float xhalf_sum(float v) { auto rr = __builtin_amdgcn_permlane32_swap(__float_as_uint(v), __float_as_uint(v), false, false); return __uint_as_float(rr[0]) + __uint_as_float(rr[1]); }
__device__ __forceinline__ float quad_sum(float v) {
    v += __int_as_float(__builtin_amdgcn_mov_dpp(__float_as_int(v), 0xB1, 0xF, 0xF, true));
    v += __int_as_float(__builtin_amdgcn_mov_dpp(__float_as_int(v), 0x4E, 0xF, 0xF, true));
    return v;
}
__device__ __forceinline__ unsigned pkbf(float lo, float hi) { typedef float f2 __attribute__((ext_vector_type(2))); typedef __bf16 b2 __attribute__((ext_vector_type(2))); f2 v = {lo, hi}; b2 b = __builtin_convertvector(v, b2); return __builtin_bit_cast(unsigned, b); }

struct KFrag { bf16x8 k[4]; };
struct VFrag { bf16x8 v[2][2]; };
__device__ __forceinline__ f32x16 qk_tile(const KFrag& kf, const bf16x8 (&qf)[4], f32x16 c) {
#pragma unroll
    for (int s4 = 0; s4 < 4; ++s4) c = __builtin_amdgcn_mfma_f32_32x32x16_bf16(kf.k[s4], qf[s4], c, 0, 0, 0);
    return c;
}
#define ROFF(r) (((r) & 3) + 8 * ((r) >> 2))
__device__ __forceinline__ void store_o(bf16* rowp, const f32x16& r0, const f32x16& r1, int half) {
#pragma unroll
    for (int i = 0; i < 4; ++i) {
        u32x2v w; w.x = pkbf(r0[4 * i], r0[4 * i + 1]); w.y = pkbf(r0[4 * i + 2], r0[4 * i + 3]); *(u32x2v*)(rowp + 8 * i + 4 * half) = w;
        u32x2v z; z.x = pkbf(r1[4 * i], r1[4 * i + 1]); z.y = pkbf(r1[4 * i + 2], r1[4 * i + 3]); *(u32x2v*)(rowp + 32 + 8 * i + 4 * half) = z; }
}

__device__ __forceinline__ void store_o_rows(LAS unsigned char* scr, bf16* base  , const f32x16& r0, const f32x16& r1, int lane) {
    const int col = lane & 31, half = lane >> 5, ql = col >> 2, hd = col & 3, sx = (ql + 4 * (hd >> 1)) & 7;
    LAS unsigned char* wp = scr + ql * 512 + hd * 128 + half * 8;
#pragma unroll
    for (int i = 0; i < 4; ++i) {
        u32x2v w; w.x = pkbf(r0[4 * i], r0[4 * i + 1]); w.y = pkbf(r0[4 * i + 2], r0[4 * i + 3]); *(LAS u32x2v*)(wp + ((i ^ sx) << 4)) = w;
        u32x2v z; z.x = pkbf(r1[4 * i], r1[4 * i + 1]); z.y = pkbf(r1[4 * i + 2], r1[4 * i + 3]); *(LAS u32x2v*)(wp + (((4 + i) ^ sx) << 4)) = z; }
    const int c = lane & 31;
#pragma unroll
    for (int j = 0; j < 4; ++j) { const int row = 2 * j + (lane >> 5), pc = (c & 24) | ((c & 7) ^ ((row + 4 * (c >> 4)) & 7));
        const u32x4v v = *(const LAS u32x4v*)(scr + row * 512 + pc * 16);
        *(u32x4v*)(base + (size_t)row * 1024 + c * 8) = v; }
}

__device__ __forceinline__ void cmp_unit(Frame& F, int u, const bf16* KCR, const bf16* VCR, const bf16* W1T, const bf16* W2T, const float* posb, const float* b2, const float* knb, bf16* KC, bf16* VCT) {
    const int kv = u >> 7, bg = (u >> 3) & 15, strip = u & 7, lane = F.lane, w = F.wave, col = lane & 31, half = lane >> 5;
    const bf16* raw = (kv ? VCR : KCR) + ((size_t)bg * SEQ + 16 * (32 * strip + col)) * 64;
    const bf16* w1 = W1T + (size_t)kv * 128 * 2048;
    f32x16 acc[4];
#pragma unroll
    for (int nt = 0; nt < 4; ++nt)
#pragma unroll
        for (int r = 0; r < 16; ++r) acc[nt][r] = 0.f;
    const int kb = 256 * w;
#pragma unroll 8
    for (int s = 0; s < 16; ++s) { const int k = kb + 16 * s + 8 * half;
        const bf16x8 a = *(const bf16x8*)(raw + k);
#pragma unroll
        for (int nt = 0; nt < 4; ++nt) { const bf16x8 bb = *(const bf16x8*)(w1 + ((size_t)((16 * w + s) * 4 + nt) * 64 + lane) * 8); acc[nt] = __builtin_amdgcn_mfma_f32_32x32x16_bf16(a, bb, acc[nt], 0, 0, 0); } }
    LAS float* part = (LAS float*)(F.lds + RING_OFF);
#pragma unroll
    for (int nt = 0; nt < 4; ++nt)
#pragma unroll
        for (int r = 0; r < 16; ++r) part[w * 4096 + (ROFF(r) + 4 * half) * 128 + 32 * nt + col] = acc[nt][r];
    __syncthreads();
    float hv[8];
#pragma unroll
    for (int j = 0; j < 8; ++j) { const int e = F.tid + 512 * j; float sacc = posb[kv * 128 + (e & 127)];
#pragma unroll
        for (int ww = 0; ww < 8; ++ww) sacc += part[ww * 4096 + e];
        hv[j] = sacc * __builtin_amdgcn_rcpf(1.0f + __builtin_amdgcn_exp2f(-sacc * LOG2E)); }
    __syncthreads();
    LAS bf16* hid = (LAS bf16*)(F.lds + RING_OFF);
#pragma unroll
    for (int j = 0; j < 8; ++j) hid[F.tid + 512 * j] = (bf16)f2bf(hv[j]);
    __syncthreads();
    if (w == 0) {
        f32x16 o[2];
#pragma unroll
        for (int nt = 0; nt < 2; ++nt)
#pragma unroll
            for (int r = 0; r < 16; ++r) o[nt][r] = 0.f;
        const bf16* w2 = W2T + (size_t)kv * 64 * 128;
#pragma unroll
        for (int s = 0; s < 8; ++s) { const bf16x8 a = *(const LAS bf16x8*)(hid + col * 128 + 16 * s + 8 * half);
#pragma unroll
            for (int nt = 0; nt < 2; ++nt) { const bf16x8 bb = *(const bf16x8*)(w2 + (32 * nt + col) * 128 + 16 * s + 8 * half); o[nt] = __builtin_amdgcn_mfma_f32_32x32x16_bf16(a, bb, o[nt], 0, 0, 0); } }
        const float bi0 = b2[kv * 64 + col], bi1 = b2[kv * 64 + 32 + col];
        if (kv == 0) {
            const float k0 = knb[col], k1 = knb[32 + col];
#pragma unroll
            for (int r = 0; r < 16; ++r) { const float v0 = o[0][r] + bi0, v1 = o[1][r] + bi1; float ss = v0 * v0 + v1 * v1;
                ss += __shfl_xor(ss, 1); ss += __shfl_xor(ss, 2); ss += __shfl_xor(ss, 4); ss += __shfl_xor(ss, 8); ss += __shfl_xor(ss, 16);
                const float f = __builtin_amdgcn_rsqf(ss * (1.0f / 64.0f) + EPS); const int c = 32 * strip + ROFF(r) + 4 * half; const bool z = (c == 255);
                bf16* kp = KC + ((size_t)bg * 256 + c) * 64;
                kp[col] = z ? (bf16)0 : (bf16)f2bf(v0 * f * k0); kp[32 + col] = z ? (bf16)0 : (bf16)f2bf(v1 * f * k1); }
        } else {
#pragma unroll
            for (int nt = 0; nt < 2; ++nt) { const float bi = nt ? bi1 : bi0;
#pragma unroll
                for (int i = 0; i < 4; ++i) { const int cl = 8 * i + 4 * half; const bool zl = (32 * strip + cl + 3 == 255);
                    const int pos = 8 * (2 * (i >> 1) + half) + 4 * (i & 1);
                    u32x2v wv; wv.x = pkbf(o[nt][4 * i] + bi, o[nt][4 * i + 1] + bi); wv.y = pkbf(o[nt][4 * i + 2] + bi, zl ? 0.f : o[nt][4 * i + 3] + bi);
                    *(u32x2v*)(VCT + (((size_t)bg * 8 + strip) * 64 + 32 * nt + col) * 32 + pos) = wv; } }
        }
    }
    __syncthreads();
}

__device__ __forceinline__ void cmp_unit2(Frame& F, int u, const bf16* KCR, const bf16* VCR, const bf16* W1T, const bf16* W2T, const float* posb, const float* b2, const float* knb, bf16* KC, bf16* VCT) {
    const int kv = u >> 7, bg = (u >> 3) & 15, strip0 = u & 7, lane = F.lane, w = F.wave, col = lane & 31, half = lane >> 5;
    const bf16* raw = (kv ? VCR : KCR) + ((size_t)bg * SEQ + 16 * (32 * strip0 + col)) * 64;
    const bf16* w1 = W1T + (size_t)kv * 128 * 2048;
    const float pos0 = posb[kv * 128 + (F.tid & 127)];
    const float bi0 = b2[kv * 64 + col], bi1 = b2[kv * 64 + 32 + col], k0 = knb[col], k1 = knb[32 + col];
    f32x16 acc2[2][4];
#pragma unroll
    for (int hh = 0; hh < 2; ++hh)
#pragma unroll
    for (int nt = 0; nt < 4; ++nt)
#pragma unroll
        for (int r = 0; r < 16; ++r) acc2[hh][nt][r] = 0.f;
    const int kb = 256 * w;
#pragma unroll 8
    for (int s = 0; s < 16; ++s) { const int k = kb + 16 * s + 8 * half;
        const bf16x8 a0 = *(const bf16x8*)(raw + k), a1 = *(const bf16x8*)(raw + 32 * 16 * 64 + k);
#pragma unroll
        for (int nt = 0; nt < 4; ++nt) { const bf16x8 bb = *(const bf16x8*)(w1 + ((size_t)((16 * w + s) * 4 + nt) * 64 + lane) * 8);
            acc2[0][nt] = __builtin_amdgcn_mfma_f32_32x32x16_bf16(a0, bb, acc2[0][nt], 0, 0, 0); acc2[1][nt] = __builtin_amdgcn_mfma_f32_32x32x16_bf16(a1, bb, acc2[1][nt], 0, 0, 0); } }
    bf16x8 w2f[8][2];
    { const bf16* w2 = W2T + (size_t)kv * 64 * 128;
#pragma unroll
      for (int s = 0; s < 8; ++s)
#pragma unroll
        for (int nt = 0; nt < 2; ++nt) w2f[s][nt] = (w < 2) ? *(const bf16x8*)(w2 + (32 * nt + col) * 128 + 16 * s + 8 * half) : (bf16x8){0, 0, 0, 0, 0, 0, 0, 0}; }
    LAS float* part = (LAS float*)(F.lds + RING_OFF);
    float hv[2][8];
#pragma unroll
    for (int hh = 0; hh < 2; ++hh) {
#pragma unroll
        for (int nt = 0; nt < 4; ++nt)
#pragma unroll
            for (int r = 0; r < 16; ++r) part[w * 4096 + (ROFF(r) + 4 * half) * 128 + 32 * nt + col] = acc2[hh][nt][r];
        __syncthreads();
#pragma unroll
        for (int j = 0; j < 8; ++j) { const int e = F.tid + 512 * j; float sacc = pos0;
#pragma unroll
            for (int ww = 0; ww < 8; ++ww) sacc += part[ww * 4096 + e];
            hv[hh][j] = sacc * __builtin_amdgcn_rcpf(1.0f + __builtin_amdgcn_exp2f(-sacc * LOG2E)); }
        __syncthreads();
    }
    LAS bf16* hid = (LAS bf16*)(F.lds + RING_OFF);
#pragma unroll
    for (int hh = 0; hh < 2; ++hh)
#pragma unroll
        for (int j = 0; j < 8; ++j) hid[hh * 4096 + F.tid + 512 * j] = (bf16)f2bf(hv[hh][j]);
    __syncthreads();
    if (w < 2) { const int strip = strip0 + w; const LAS bf16* hd_ = hid + w * 4096;
        f32x16 o[2];
#pragma unroll
        for (int nt = 0; nt < 2; ++nt)
#pragma unroll
            for (int r = 0; r < 16; ++r) o[nt][r] = 0.f;
#pragma unroll
        for (int s = 0; s < 8; ++s) { const bf16x8 a = *(const LAS bf16x8*)(hd_ + col * 128 + 16 * s + 8 * half);
#pragma unroll
            for (int nt = 0; nt < 2; ++nt) o[nt] = __builtin_amdgcn_mfma_f32_32x32x16_bf16(a, w2f[s][nt], o[nt], 0, 0, 0); }
        if (kv == 0) {
#pragma unroll
            for (int r = 0; r < 16; ++r) { const float v0 = o[0][r] + bi0, v1 = o[1][r] + bi1; float ss = v0 * v0 + v1 * v1;
                ss += __shfl_xor(ss, 1); ss += __shfl_xor(ss, 2); ss += __shfl_xor(ss, 4); ss += __shfl_xor(ss, 8); ss += __shfl_xor(ss, 16);
                const float f = __builtin_amdgcn_rsqf(ss * (1.0f / 64.0f) + EPS); const int c = 32 * strip + ROFF(r) + 4 * half; const bool z = (c == 255);
                bf16* kp = KC + ((size_t)bg * 256 + c) * 64;
                kp[col] = z ? (bf16)0 : (bf16)f2bf(v0 * f * k0); kp[32 + col] = z ? (bf16)0 : (bf16)f2bf(v1 * f * k1); }
        } else {
#pragma unroll
            for (int nt = 0; nt < 2; ++nt) { const float bi = nt ? bi1 : bi0;
#pragma unroll
                for (int i = 0; i < 4; ++i) { const int cl = 8 * i + 4 * half; const bool zl = (32 * strip + cl + 3 == 255);
                    const int pos = 8 * (2 * (i >> 1) + half) + 4 * (i & 1);
                    u32x2v wv; wv.x = pkbf(o[nt][4 * i] + bi, o[nt][4 * i + 1] + bi); wv.y = pkbf(o[nt][4 * i + 2] + bi, zl ? 0.f : o[nt][4 * i + 3] + bi);
                    *(u32x2v*)(VCT + (((size_t)bg * 8 + strip) * 64 + 32 * nt + col) * 32 + pos) = wv; } }
        }
    }
    __syncthreads();
}

constexpr int ATT2_KV_OFF = 65536;
static_assert(ATT_WSCR_OFF + 8 * ATT_WSCR_BYTES <= ATT2_KV_OFF && ATT2_KV_OFF + 65536 <= RING_BYTES, "attention-2 LDS map");
constexpr float ATT_THR = 6.0f;

__device__ __forceinline__ unsigned stage_goff(int tid) {
    const int t = tid & 255, key = 8 * (t >> 6) + ((t & 15) >> 1), c = 2 * ((t >> 4) & 3) + (t & 1);
    const int row = 16 * (t >> 6) + 8 * ((t >> 5) & 1) + ((t & 15) >> 1), p = 2 * ((t >> 4) & 1) + (t & 1);
    return __builtin_amdgcn_readfirstlane(tid) < 256 ? (unsigned)(key * 128 + c * 16) : (unsigned)(row * 64 + p * 16);
}
__device__ __forceinline__ u32x4v tile_load(const bf16* Kt, const bf16* Vt, int tid) {
    const bool isk = __builtin_amdgcn_readfirstlane(tid) < 256;
    const char* sbase = (const char*)(isk ? Kt : Vt);
    return *(const u32x4v*)(sbase + stage_goff(tid));
}
__device__ __forceinline__ unsigned stage_loff(int tid) {
    const int t = tid & 255;
    if (__builtin_amdgcn_readfirstlane(tid) < 256) { const int key = 8 * (t >> 6) + ((t & 15) >> 1), c = 2 * ((t >> 4) & 3) + (t & 1);
        return (unsigned)((c >> 1) * 1024 + key * 32 + (((c & 1) ^ ((key >> 3) & 1)) << 4)); }
    const int row = 16 * (t >> 6) + 8 * ((t >> 5) & 1) + ((t & 15) >> 1), p = 2 * ((t >> 4) & 1) + (t & 1);
    return (unsigned)(4096 + (p >> 1) * 2048 + row * 32 + (((p & 1) ^ ((row >> 3) & 1)) << 4));
}
__device__ __forceinline__ void tile_store(LAS unsigned char* buf, u32x4v v, unsigned so) { *(LAS u32x4v*)(buf + so) = v; }
__device__ __forceinline__ __amdgpu_buffer_rsrc_t stage_rsrc(const bf16* Kb, const bf16* Vb, int tid) {
    const bool isk = __builtin_amdgcn_readfirstlane(tid) < 256;
    return __builtin_amdgcn_make_buffer_rsrc((void*)(isk ? Kb : Vb), 0, 0x7FFFFFFF, 0x00020000);
}
__device__ __forceinline__ void pair_load(__amdgpu_buffer_rsrc_t rs, int kt, unsigned loff, u32x4v& a, u32x4v& b) {
    a = __builtin_amdgcn_raw_buffer_load_b128(rs, loff, kt * 4096, 0); b = __builtin_amdgcn_raw_buffer_load_b128(rs, loff, kt * 4096 + 4096, 0);
}
__device__ __forceinline__ void pair_store(LAS unsigned char* buf, const u32x4v& a, const u32x4v& b, unsigned so) { tile_store(buf, a, so); tile_store(buf + 8192, b, so); }
__device__ __forceinline__ int frag_off(int r, int half) { return r * 32 + ((half ^ ((r >> 3) & 1)) << 4); }
__device__ __forceinline__ void lds_k(KFrag& f, const LAS unsigned char* buf, int r, int half) {
    const LAS unsigned char* p = buf + frag_off(r, half);
#pragma unroll
    for (int s4 = 0; s4 < 4; ++s4) f.k[s4] = *(const LAS bf16x8*)(p + s4 * 1024);
}
__device__ __forceinline__ void lds_v(VFrag& f, const LAS unsigned char* buf, int r, int half) {
    const LAS unsigned char* p = buf + 4096 + frag_off(r, half);
#pragma unroll
    for (int dt = 0; dt < 2; ++dt)
#pragma unroll
        for (int s2 = 0; s2 < 2; ++s2) f.v[dt][s2] = *(const LAS bf16x8*)(p + s2 * 2048 + dt * 1024);
}
typedef float f32x2s __attribute__((ext_vector_type(2)));
struct Soft2 { f32x16 o0, o1, lv; float m; f32x2s lf; };
__device__ __forceinline__ void soft2_init(Soft2& st, float m0, float l0) {
#pragma unroll
    for (int r = 0; r < 16; ++r) { st.o0[r] = 0.f; st.o1[r] = 0.f; st.lv[r] = l0; }
    st.m = m0; st.lf = (f32x2s){0.f, 0.f};
}
__device__ __forceinline__ void soft2_acc(f32x16& r0, f32x16& r1, const Soft2& st, float scale) {
    const float f = scale * __builtin_amdgcn_rcpf(fmaxf(st.lv[0], 1.1754944e-38f));
#pragma unroll
    for (int r = 0; r < 16; ++r) { r0[r] += st.o0[r] * f; r1[r] += st.o1[r] * f; }
}
__device__ __forceinline__ void soft_part(Soft2& st, f32x16 s, float cadd, bf16x8& p0, bf16x8& p1) {
    const float nm = cadd - st.m;
#pragma unroll
    for (int r = 0; r < 16; ++r) s[r] += nm;
    float mx = fmaxf(fmaxf(s[0], s[1]), fmaxf(s[2], s[3]));
#pragma unroll
    for (int r = 4; r < 16; r += 4) mx = fmaxf(mx, fmaxf(fmaxf(s[r], s[r + 1]), fmaxf(s[r + 2], s[r + 3])));
    mx = xhalf_max(mx);
    if (__any(mx > ATT_THR)) {
        const float d = fmaxf(mx, 0.f), alpha = __builtin_amdgcn_exp2f(-d);
        st.m += d;
#pragma unroll
        for (int r = 0; r < 16; ++r) { st.o0[r] *= alpha; st.o1[r] *= alpha; st.lv[r] *= alpha; s[r] -= d; }
    }
#pragma unroll
    for (int r = 0; r < 16; ++r) s[r] = __builtin_amdgcn_exp2f(s[r]);
    u32x4v pw0, pw1;
    pw0.x = pkbf(s[0], s[1]); pw0.y = pkbf(s[2], s[3]); pw0.z = pkbf(s[4], s[5]); pw0.w = pkbf(s[6], s[7]);
    pw1.x = pkbf(s[8], s[9]); pw1.y = pkbf(s[10], s[11]); pw1.z = pkbf(s[12], s[13]); pw1.w = pkbf(s[14], s[15]);
    p0 = __builtin_bit_cast(bf16x8, pw0); p1 = __builtin_bit_cast(bf16x8, pw1);
}
__device__ __forceinline__ f32x16 splat16(float v);
template <bool SUMS = true>
__device__ __forceinline__ void pv_part(Soft2& st, const VFrag& vf, const bf16x8 ones, const bf16x8 p0, const bf16x8 p1) {
    st.o0 = __builtin_amdgcn_mfma_f32_32x32x16_bf16(vf.v[0][0], p0, st.o0, 0, 0, 0);
    st.o1 = __builtin_amdgcn_mfma_f32_32x32x16_bf16(vf.v[1][0], p0, st.o1, 0, 0, 0);
    if (SUMS) st.lv = __builtin_amdgcn_mfma_f32_32x32x16_bf16(ones, p0, st.lv, 0, 0, 0);
    st.o0 = __builtin_amdgcn_mfma_f32_32x32x16_bf16(vf.v[0][1], p1, st.o0, 0, 0, 0);
    st.o1 = __builtin_amdgcn_mfma_f32_32x32x16_bf16(vf.v[1][1], p1, st.o1, 0, 0, 0);
    if (SUMS) st.lv = __builtin_amdgcn_mfma_f32_32x32x16_bf16(ones, p1, st.lv, 0, 0, 0);
}
__device__ __forceinline__ void soft_pv2(Soft2& st, f32x16 s, const VFrag& vf, const bf16x8 ones, float cadd = 0.f) {
    bf16x8 p0, p1; soft_part(st, s, cadd, p0, p1); pv_part(st, vf, ones, p0, p1);
}
template <bool MASKED>
__device__ __forceinline__ void soft_fast_pv(Soft2& st, f32x16 s, const VFrag& vf, const bf16x8 ones, unsigned sel) {
#pragma unroll
    for (int r = 0; r < 16; ++r) s[r] = __builtin_amdgcn_exp2f(s[r]);
    {
        f32x2s a0 = (f32x2s){s[0], s[1]} + (f32x2s){s[2], s[3]}, a1 = (f32x2s){s[4], s[5]} + (f32x2s){s[6], s[7]}, a2 = (f32x2s){s[8], s[9]} + (f32x2s){s[10], s[11]}, a3 = (f32x2s){s[12], s[13]} + (f32x2s){s[14], s[15]};
        a0 += a1; a2 += a3; a0 += a2;
        if (MASKED) { const float bf_ = (sel == 0x07060302u) ? 1.0f : 0.0f; st.lf = a0 * (f32x2s){bf_, bf_} + st.lf; } else st.lf += a0;
    }
    u32x4v pw0, pw1;
    if (MASKED) {
        pw0.x = __builtin_amdgcn_perm(__float_as_uint(s[1]), __float_as_uint(s[0]), sel); pw0.y = __builtin_amdgcn_perm(__float_as_uint(s[3]), __float_as_uint(s[2]), sel);
        pw0.z = __builtin_amdgcn_perm(__float_as_uint(s[5]), __float_as_uint(s[4]), sel); pw0.w = __builtin_amdgcn_perm(__float_as_uint(s[7]), __float_as_uint(s[6]), sel);
        pw1.x = __builtin_amdgcn_perm(__float_as_uint(s[9]), __float_as_uint(s[8]), sel); pw1.y = __builtin_amdgcn_perm(__float_as_uint(s[11]), __float_as_uint(s[10]), sel);
        pw1.z = __builtin_amdgcn_perm(__float_as_uint(s[13]), __float_as_uint(s[12]), sel); pw1.w = __builtin_amdgcn_perm(__float_as_uint(s[15]), __float_as_uint(s[14]), sel);
    } else {
        pw0.x = pkbf(s[0], s[1]); pw0.y = pkbf(s[2], s[3]); pw0.z = pkbf(s[4], s[5]); pw0.w = pkbf(s[6], s[7]);
        pw1.x = pkbf(s[8], s[9]); pw1.y = pkbf(s[10], s[11]); pw1.z = pkbf(s[12], s[13]); pw1.w = pkbf(s[14], s[15]);
    }
    pv_part<false>(st, vf, ones, __builtin_bit_cast(bf16x8, pw0), __builtin_bit_cast(bf16x8, pw1));
}
__device__ __forceinline__ f32x16 splat16(float v) { f32x16 s;
#pragma unroll
    for (int r = 0; r < 16; ++r) s[r] = v;
    return s; }

__device__ __forceinline__ f32x16 lut16(const LAS float* lutp) { f32x16 v;
#pragma unroll
    for (int r = 0; r < 16; ++r) v[r] = lutp[ROFF(r)];
    return v; }
template <int MODE, bool FAST>
__device__ __forceinline__ void attn_stream(Soft2& st, const bf16x8 (&qf)[4], const bf16* Kb, const bf16* Vb, int kt0, int np, const LAS float* lut, int q, int s0, unsigned mlo, unsigned mhi, float c31,
                                            LAS unsigned char* kvbuf, int tid, int col, int half, const bf16x8 ones) {
    u32x4v ra, rb;
    const __amdgpu_buffer_rsrc_t rs = stage_rsrc(Kb, Vb, tid); const unsigned loff = stage_goff(tid);
    const unsigned so = stage_loff(tid);
    pair_load(rs, kt0, loff, ra, rb); pair_store(kvbuf, ra, rb, so);
    if (np > 1) { pair_load(rs, kt0 + 2, loff, ra, rb); pair_store(kvbuf + 16384, ra, rb, so); }
    if (np > 2) pair_load(rs, kt0 + 4, loff, ra, rb);
    __syncthreads();
#define ATT_LUTP(KT_) (MODE == 0 ? true : (MODE == 1 ? ((s0 - 32 * (KT_) - 31) < 128) : !((s0 - 32 * (KT_) - 31) >= 128 && (s0 + 7 - 32 * (KT_)) < 512)))
#define ATT_QK(DST_, KT_) do { if (ATT_LUTP(KT_)) DST_ = qk_tile(kf, qf, lut16(lut - (q - 32 * (KT_) - 4 * half))); else DST_ = qk_tile(kf, qf, splat16(0.f)); } while (0)
#define ATT_PROCESS(S_, KT_, VF_) do { const int kt_ = (KT_); float cadd_ = 0.f; bool bit_ = true; \
        if (MODE == 1) { const int i_ = kt_ >> 1; bit_ = (((((unsigned long long)mhi << 32) | mlo) >> i_) & 1ull) != 0ull; cadd_ = bit_ ? 0.f : NEGL; } \
        if (FAST) soft_fast_pv<MODE == 1>(st, S_, VF_, ones, bit_ ? 0x07060302u : 0x0C0C0C0Cu); else soft_pv2(st, S_, VF_, ones, cadd_); } while (0)
    const bool lead = __builtin_amdgcn_readfirstlane(tid) < 256;
    KFrag kf; lds_k(kf, kvbuf, col, half);
    f32x16 sA, sB; ATT_QK(sA, kt0);
    int bo0 = 0, bo1 = 16384, bo2 = 32768;
#define ATT_PAIR(FAR_) do { \
        const LAS unsigned char* pb = kvbuf + bo0; const LAS unsigned char* pbn = kvbuf + bo1; \
        if ((FAR_) || p + 2 < np) pair_store(kvbuf + bo2, ra, rb, so); \
        if ((FAR_) || p + 3 < np) pair_load(rs, kt0 + 2 * p + 6, loff, ra, rb); \
        {     \
            VFrag vf; lds_v(vf, pb, col, half); lds_k(kf, pb + 8192, col, half); \
            if (FAR_) sB = qk_tile(kf, qf, splat16(0.f)); else ATT_QK(sB, kt0 + 2 * p + 1); \
            __builtin_amdgcn_sched_barrier(0); \
            ATT_PROCESS(sA, kt0 + 2 * p, vf); \
        } \
        {     \
            VFrag vf; lds_v(vf, pb + 8192, col, half); \
            if (FAR_) { lds_k(kf, pbn, col, half); sA = qk_tile(kf, qf, splat16(0.f)); } \
            else if (p + 1 < np) { lds_k(kf, pbn, col, half); ATT_QK(sA, kt0 + 2 * p + 2); } \
            __builtin_amdgcn_sched_barrier(0); \
            ATT_PROCESS(sB, kt0 + 2 * p + 1, vf); \
        } \
        __syncthreads(); \
        { const int tb = bo0; bo0 = bo1; bo1 = bo2; bo2 = tb; } } while (0)
    int p = 0;
    if (FAST && MODE != 0) {
        const int ktmax = (s0 - 159) >> 5;
        int pl = 0, ph = ((ktmax - kt0 - 2) >> 1) + 1;
        if (MODE == 2) { const int ktmin = ((s0 - 505) >> 5) + 1; pl = (ktmin - kt0) >> 1; pl = pl < 0 ? 0 : pl; }
        ph = ph > np - 3 ? np - 3 : ph;
#pragma unroll 1
        for (; p < pl && p < np; ++p) ATT_PAIR(false);
#pragma unroll 1
        for (; p < ph; ++p) ATT_PAIR(true);
    }
#pragma unroll 1
    for (; p < np; ++p) ATT_PAIR(false);
#undef ATT_PAIR
    if (FAST) st.lv[0] += xhalf_sum(st.lf.x + st.lf.y);
#undef ATT_LUTP
#undef ATT_QK
#undef ATT_PROCESS
}

struct DeferW { const float *win, *wout, *gain; bf16 *WIN2, *WOUT2; bool on; };
constexpr int DW_IN = 16 * 176, DW_OUT = 44 * 32, DW_SUB = 2 * (DW_IN + DW_OUT);
struct DeferD { const float* W; int ldw, k0, c0, Kd, drow0; bf16* WT; const float* kgain; float cscale; };
__device__ __forceinline__ DeferD defer_decode(const DeferW& dw, int sid) {
    DeferD d; int item = sid >> 1; const int h = sid & 1; d.kgain = nullptr; d.cscale = 1.0f;
    if (item < DW_IN) { const int kb = item / 176, nb = item % 176, pn = nb >> 3, bj = (nb >> 2) & 1, c = 32 * (nb & 3);
        d.W = dw.win; d.ldw = 2 * FF; d.k0 = 64 * kb + 32 * h; d.c0 = (bj ? FF : 0) + 128 * pn + c; d.WT = dw.WIN2; d.Kd = DM; d.drow0 = 32 * nb; d.kgain = dw.gain; d.cscale = bj ? (1.0f / LOG2E) : LOG2E; }
    else { item -= DW_IN; const int kb = item / 32, nb = item % 32;
        d.W = dw.wout; d.ldw = DM; d.k0 = 64 * kb + 32 * h; d.c0 = 32 * nb; d.WT = dw.WOUT2; d.Kd = FF; d.drow0 = 32 * nb; }
    return d;
}
__device__ __forceinline__ void defer_load(const DeferW& dw, int sid, int lane, f32x4 (&v)[4]) {
    const DeferD d = defer_decode(dw, sid); const int c4 = 4 * (lane & 7), rr = lane >> 3;
#pragma unroll
    for (int i = 0; i < 4; ++i) v[i] = *(const GAS f32x4*)(d.W + (size_t)(d.k0 + 8 * i + rr) * d.ldw + d.c0 + c4);
}
__device__ __forceinline__ void defer_finish(const DeferW& dw, int sid, const f32x4 (&v)[4], LAS float* scr, int lane) {
    const DeferD d = defer_decode(dw, sid); const int c4 = 4 * (lane & 7), rr = lane >> 3;
#pragma unroll
    for (int i = 0; i < 4; ++i) { const int kk = 8 * i + rr; const float gk = (d.kgain ? d.kgain[d.k0 + kk] : 1.0f) * d.cscale; LAS float* p = scr + kk * 32;
        p[(c4 + 0) ^ kk] = v[i][0] * gk; p[(c4 + 1) ^ kk] = v[i][1] * gk; p[(c4 + 2) ^ kk] = v[i][2] * gk; p[(c4 + 3) ^ kk] = v[i][3] * gk; }
    LDS_WAIT(); asm volatile("" ::: "memory");
    const int c = lane & 3;
#pragma unroll
    for (int j = 0; j < 2; ++j) { const int n = (lane >> 2) + 16 * j; const LAS float* s = scr + (8 * c) * 32;
        v4u o; o.x = pk2(s[0 * 32 + (n ^ (8 * c + 0))], s[1 * 32 + (n ^ (8 * c + 1))]); o.y = pk2(s[2 * 32 + (n ^ (8 * c + 2))], s[3 * 32 + (n ^ (8 * c + 3))]);
        o.z = pk2(s[4 * 32 + (n ^ (8 * c + 4))], s[5 * 32 + (n ^ (8 * c + 5))]); o.w = pk2(s[6 * 32 + (n ^ (8 * c + 6))], s[7 * 32 + (n ^ (8 * c + 7))]);
        *(GAS v4u*)(d.WT + (size_t)(d.drow0 + n) * d.Kd + d.k0 + 8 * c) = o; }
    LDS_WAIT(); asm volatile("" ::: "memory");
}
__device__ __forceinline__ void defer_subitem(const DeferW& dw, int sid, LAS float* scr, int lane) { f32x4 v[4]; defer_load(dw, sid, lane, v); defer_finish(dw, sid, v, scr, lane); }
template <bool fast>
__device__ __forceinline__ void attn2_unit(Frame& F, const AttP& P, const float* sinks, int b, int g, int blk, const LAS float* lutA, const LAS float* lutB, LAS float* wscr, const DeferW& dw, int dsid) {
    const int w = F.wave; const int lane = hw_lane_id(); const int tid = w * 64 + lane;
    const int col = lane & 31, half = lane >> 5, ql = col >> 2, hd = col & 3, bg = b * 2 + g, sb = 64 * blk, s0 = sb + 8 * w, q = s0 + ql, head8 = g * 4 + hd, t = b * SEQ + q;
    LAS unsigned char* kvbuf = F.lds + RING_OFF + ATT2_KV_OFF;
    const int kt_top = (sb + 63) >> 5, ktw = s0 >> 5;
    Soft2 st; f32x16 r0, r1;
    const bf16x8 ones = (bf16x8){0x3F80, 0x3F80, 0x3F80, 0x3F80, 0x3F80, 0x3F80, 0x3F80, 0x3F80};
    const int ntc_u = (sb + 63 >= 31) ? ((sb + 63 - 31) >> 4) / 32 + 1 : 0;
    u32x4v ctile[8];
    { const bf16* KCb = P.KC + (size_t)bg * 256 * 64; const bf16* VCb = P.VCT + (size_t)bg * 8 * 2048;
#pragma unroll
      for (int kt = 0; kt < 8; ++kt) ctile[kt] = (kt < ntc_u) ? tile_load(KCb + kt * 2048, VCb + kt * 2048, tid) : (u32x4v){0u, 0u, 0u, 0u}; }
    bf16x8 qf[4]; { const bf16* qp = P.QB + ((size_t)(b * 8 + head8) * SEQ + q) * 64 + 8 * half;
#pragma unroll
        for (int s4 = 0; s4 < 4; ++s4) qf[s4] = *(const bf16x8*)(qp + 16 * s4); }
    const float g0 = P.GT[(size_t)t * 32 + head8], g1 = P.GT[(size_t)t * 32 + 8 + head8], g2 = P.GT[(size_t)t * 32 + 16 + head8];
    for (int rp_ = 0; rp_ < (KREP == 51 ? 2 : 1); ++rp_) {
        bf16x8 qfa[4]; { const bf16* qp = P.QA + ((size_t)(b * 8 + head8) * SEQ + q) * 64 + 8 * half;
#pragma unroll
            for (int s4 = 0; s4 < 4; ++s4) qfa[s4] = *(const bf16x8*)(qp + 16 * s4); }
        if (fast) soft2_init(st, 0.f, __builtin_amdgcn_exp2f(sinks[head8] * LOG2E)); else soft2_init(st, sinks[head8] * LOG2E, 1.0f);
        const LAS float* lut = lutA + head8 * LA + OFFA;
        const int kt0 = (sb > 127 ? sb - 127 : 0) >> 5, nt = kt_top - kt0 + 1, ktw_lo = (s0 > 127 ? s0 - 127 : 0) >> 5;
        const bf16* Kb = P.KA + (size_t)bg * SEQ * 64; const bf16* Vb = P.VAT + (size_t)bg * (SEQ / 32) * 2048;
        attn_stream<0, fast>(st, qfa, Kb, Vb, kt0, nt >> 1, lut, q, s0, 0u, 0u, 0.f, kvbuf, tid, col, half, ones);
        r0 = splat16(0.f); r1 = splat16(0.f);
        soft2_acc(r0, r1, st, 1.0f);
        store_o_rows((LAS unsigned char*)wscr, P.mix + (size_t)(b * SEQ + s0) * 1024 + g * 256, r0, r1, lane);
    }
    const LAS float* lut = lutB + head8 * LB + OFFB;
    constexpr float c31 = 0.f;
    r0 = splat16(0.f); r1 = splat16(0.f);
    LAS float* impG = wscr; LAS float* impL = wscr + 512;
    const int ntc = (s0 + 7 >= 31) ? ((s0 + 7 - 31) >> 4) / 32 + 1 : 0;
    { const unsigned so_u = stage_loff(tid);
#pragma unroll
        for (int kt = 0; kt < 8; ++kt) if (kt < ntc_u) tile_store(kvbuf + kt * 8192, ctile[kt], so_u);
        __syncthreads();
    }
    unsigned mlo = 0u, mhi = 0u;
    for (int rp_ = 0; rp_ < (KREP == 52 ? 2 : 1); ++rp_) {
    if constexpr (fast) {
        soft2_init(st, 0.f, 0.f);
        float Gs[8][4], Ls[8][4];
#pragma unroll
        for (int kt = 0; kt < 8; ++kt) {
#pragma unroll
            for (int i = 0; i < 4; ++i) { Gs[kt][i] = 0.f; Ls[kt][i] = 0.f; }
            if (kt < ntc) { const LAS unsigned char* cb = kvbuf + kt * 8192;
                KFrag kf; VFrag vf; lds_k(kf, cb, col, half); lds_v(vf, cb, col, half);
                f32x16 s = qk_tile(kf, qf, splat16(0.f));
                const bool farc = 512 * kt <= s0 - 655;
                if (!farc) { const int basec = q - 31 - 512 * kt - 64 * half;
#pragma unroll
                    for (int r = 0; r < 16; ++r) { int rc = basec - 16 * ROFF(r); rc = rc < -1 ? -1 : (rc > 511 ? 511 : rc); s[r] += lut[-rc]; } }
#pragma unroll
                for (int r = 0; r < 16; ++r) s[r] = __builtin_amdgcn_exp2f(s[r]);
#pragma unroll
                for (int i = 0; i < 4; ++i) { Gs[kt][i] = (s[4 * i] + s[4 * i + 1]) + (s[4 * i + 2] + s[4 * i + 3]); Ls[kt][i] = s[4 * i + 3]; }
                st.lf.x += (Gs[kt][0] + Gs[kt][1]) + (Gs[kt][2] + Gs[kt][3]);
                u32x4v pw0, pw1;
                pw0.x = pkbf(s[0], s[1]); pw0.y = pkbf(s[2], s[3]); pw0.z = pkbf(s[4], s[5]); pw0.w = pkbf(s[6], s[7]);
                pw1.x = pkbf(s[8], s[9]); pw1.y = pkbf(s[10], s[11]); pw1.z = pkbf(s[12], s[13]); pw1.w = pkbf(s[14], s[15]);
                pv_part<false>(st, vf, ones, __builtin_bit_cast(bf16x8, pw0), __builtin_bit_cast(bf16x8, pw1));
            }
        }
        st.lv[0] += xhalf_sum(st.lf.x + st.lf.y);
        soft2_acc(r0, r1, st, rp_ == 0 ? g0 : 0.f);
#pragma unroll
        for (int j = 0; j < 8; ++j) { impG[lane + 64 * j] = 0.f; impL[lane + 64 * j] = 0.f; }
        const float invl = __builtin_amdgcn_rcpf(fmaxf(st.lv[0], 1.1754944e-38f));
#pragma unroll
        for (int kt = 0; kt < 8; ++kt) if (kt < ntc) {
#pragma unroll
            for (int i = 0; i < 4; ++i) {
                const float G = quad_sum(Gs[kt][i] * invl), L = quad_sum(Ls[kt][i] * invl);
                const int n = 8 * kt + 2 * i + half;
                if (hd == 0) { impG[ql * 64 + n] = G; if (n < 63) impL[ql * 64 + n + 1] = L; }
            }
        }
    } else {
    soft2_init(st, 0.f, 0.f);
#pragma unroll 1
    for (int kt = 0; kt < ntc; ++kt) { const LAS unsigned char* cb = kvbuf + kt * 8192;
        KFrag kf; VFrag vf; lds_k(kf, cb, col, half); lds_v(vf, cb, col, half);
        f32x16 s = qk_tile(kf, qf, splat16(0.f));
        const bool farc = 512 * kt <= s0 - 655;
        if (!farc) { const int basec = q - 31 - 512 * kt - 64 * half;
#pragma unroll
            for (int r = 0; r < 16; ++r) { int rc = basec - 16 * ROFF(r); rc = rc < -1 ? -1 : (rc > 511 ? 511 : rc); s[r] += lut[-rc]; } }
        soft_pv2(st, s, vf, ones, farc ? c31 : 0.f);
    }
    soft2_acc(r0, r1, st, rp_ == 0 ? g0 : 0.f);
#pragma unroll
    for (int j = 0; j < 8; ++j) { impG[lane + 64 * j] = 0.f; impL[lane + 64 * j] = 0.f; }
    {
        const float nmfin = -st.m, invl = __builtin_amdgcn_rcpf(fmaxf(st.lv[0], 1.1754944e-38f));
#pragma unroll 1
        for (int kt = 0; kt < ntc; ++kt) { const LAS unsigned char* cb = kvbuf + kt * 8192;
            KFrag kf; lds_k(kf, cb, col, half);
            f32x16 s = qk_tile(kf, qf, splat16(0.f));
            const bool farc = 512 * kt <= s0 - 655;
            if (farc) { const float nmc = nmfin + c31;
#pragma unroll
                for (int r = 0; r < 16; ++r) s[r] = __builtin_amdgcn_exp2f(s[r] + nmc) * invl; }
            else { const int basec = q - 31 - 512 * kt - 64 * half;
#pragma unroll
                for (int r = 0; r < 16; ++r) { int rc = basec - 16 * ROFF(r); rc = rc < -1 ? -1 : (rc > 511 ? 511 : rc); s[r] = __builtin_amdgcn_exp2f(s[r] + lut[-rc] + nmfin) * invl; } }
#pragma unroll
            for (int i = 0; i < 4; ++i) {
                const float G = quad_sum((s[4 * i] + s[4 * i + 1]) + (s[4 * i + 2] + s[4 * i + 3])), L = quad_sum(s[4 * i + 3]);
                const int n = 8 * kt + 2 * i + half;
                if (hd == 0) { impG[ql * 64 + n] = G; if (n < 63) impL[ql * 64 + n + 1] = L; }
            }
        }
    }
    }
#pragma unroll 1
    for (int q4 = 0; q4 < 8; q4 += 4) {
        int key[4]; unsigned long long selv[4]; bool need = false;
#pragma unroll
        for (int i = 0; i < 4; ++i) { const int qq = q4 + i, qs = s0 + qq, cur = qs >> 6, n = lane;
            const float imp = impG[qq * 64 + n] + impL[qq * 64 + n];
            const bool valid = n <= cur, forced = (n == 0) || (n == cur) || (n == cur - 1);
            const float score = imp + (forced ? 1000.0f : 0.0f);
            key[i] = valid ? (__float_as_int(score) & ~63) : (int)0x80000000;
            selv[i] = __ballot(valid); need = need || (cur >= 16); }
        if (need) {
            int T[4] = {0, 0, 0, 0};
#pragma unroll 1
            for (int bitp = 30; bitp >= 6; --bitp) {
#pragma unroll
                for (int i = 0; i < 4; ++i) { const int cand = T[i] | (1 << bitp); const int cnt = __builtin_popcountll(__ballot(key[i] >= cand)); T[i] = (cnt >= 16) ? cand : T[i]; } }
#pragma unroll
            for (int i = 0; i < 4; ++i) { const int cur = (s0 + q4 + i) >> 6;
                if (cur >= 16) { const unsigned long long gt = __ballot(key[i] > T[i]), eq = __ballot(key[i] == T[i]); const int k = 16 - __builtin_popcountll(gt);
                    unsigned long long mm = eq;
#pragma unroll 1
                    for (int j = 0; j < k; ++j) mm &= mm - 1ull;
                    selv[i] = gt | (eq ^ mm); } }
        }
#pragma unroll
        for (int i = 0; i < 4; ++i) if (ql == q4 + i) { mlo = (unsigned)selv[i]; mhi = (unsigned)(selv[i] >> 32); }
    }
    }
#define R0_PARK() do { if (fast) { _Pragma("unroll") for (int k = 0; k < 4; ++k) { f32x4 v_ = {r0[4 * k], r0[4 * k + 1], r0[4 * k + 2], r0[4 * k + 3]}; *(LAS f32x4*)((LAS unsigned char*)wscr + k * 1024 + lane * 16) = v_; } } } while (0)
#define R0_FETCH() do { if (fast) { _Pragma("unroll") for (int k = 0; k < 4; ++k) { const f32x4 v_ = *(const LAS f32x4*)((LAS unsigned char*)wscr + k * 1024 + lane * 16); r0[4 * k] = v_.x; r0[4 * k + 1] = v_.y; r0[4 * k + 2] = v_.z; r0[4 * k + 3] = v_.w; } } } while (0)
    R0_PARK();
    __syncthreads();
    for (int rp_ = 0; rp_ < (KREP == 53 ? 2 : 1); ++rp_) {
        const bf16* Kb = P.KS + (size_t)bg * SEQ * 64; const bf16* Vb = P.VST + (size_t)bg * (SEQ / 32) * 2048;
        soft2_init(st, 0.f, 0.f);
        attn_stream<1, fast>(st, qf, Kb, Vb, 0, blk + 1, lut, q, s0, mlo, mhi, c31, kvbuf, tid, col, half, ones);
        R0_FETCH();
        soft2_acc(r0, r1, st, rp_ == 0 ? g1 : 0.f);
        R0_PARK();
    }
    f32x4 dwv[4];
    for (int rp_ = 0; rp_ < (KREP == 54 ? 2 : 1); ++rp_) {
        const bf16* Kb = P.KW + (size_t)bg * SEQ * 64; const bf16* Vb = P.VWT + (size_t)bg * (SEQ / 32) * 2048;
        soft2_init(st, 0.f, 0.f);
        const int kt0 = (sb > 511 ? sb - 511 : 0) >> 5, nt = kt_top - kt0 + 1, ktw_lo = (s0 > 511 ? s0 - 511 : 0) >> 5;
        attn_stream<2, fast>(st, qf, Kb, Vb, kt0, nt >> 1, lut, q, s0, 0u, 0u, c31, kvbuf, tid, col, half, ones);
        R0_FETCH();
        if (dw.on) defer_load(dw, dsid, lane, dwv);
        soft2_acc(r0, r1, st, rp_ == 0 ? g2 : 0.f);
    }
    store_o_rows((LAS unsigned char*)wscr, P.mix + (size_t)(b * SEQ + s0) * 1024 + 512 + g * 256, r0, r1, lane);
    if (dw.on) defer_finish(dw, dsid, dwv, wscr, lane);
}

__device__ __forceinline__ void attn2_phase(Frame& F, const AttP& P, const float* tbl, const float* sinks, const float* qna, const float* kna, const float* qnb, const float* knb, const DeferW dw) {
    LAS float* lutA = (LAS float*)(F.lds + RING_OFF + ATT_LUTA_OFF); LAS float* lutB = (LAS float*)(F.lds + RING_OFF + ATT_LUTB_OFF);
    for (int i = F.tid; i < 8 * LA; i += NWAVES * 64) { const int h = i / LA, rel = OFFA - i % LA; lutA[i] = (rel >= 0 && rel < 128) ? tbl[t5_bucket(rel) * 16 + h] * LOG2E : NEGL; }
    for (int i = F.tid; i < 8 * LB; i += NWAVES * 64) { const int h = i / LB, rel = OFFB - i % LB; lutB[i] = (rel >= 0 && rel < 512) ? (tbl[t5_bucket(rel) * 16 + 8 + h] - tbl[31 * 16 + 8 + h]) * LOG2E : NEGL; }
    { LAS float* gsc = (LAS float*)(F.lds + RING_OFF + ATT_WSCR_OFF);
      if (F.wave < 4) { const float* gp = F.wave == 0 ? qna : F.wave == 1 ? kna : F.wave == 2 ? qnb : knb; const float m = wave_max(fabsf(gp[F.lane])); if (F.lane == 0) gsc[F.wave] = m; }
      else if (F.wave == 4) { float m = 0.f; for (int i = F.lane; i < 256; i += 64) m = fmaxf(m, fabsf(tbl[(i >> 3) * 16 + (i & 7)]));
          m = fmaxf(m, F.lane < 8 ? fabsf(sinks[F.lane]) : 0.f); m = wave_max(m); if (F.lane == 0) gsc[4] = m * LOG2E; }
      else if (F.wave == 5) { float m = 0.f; for (int i = F.lane; i < 256; i += 64) m = fmaxf(m, fabsf(tbl[(i >> 3) * 16 + 8 + (i & 7)] - tbl[31 * 16 + 8 + (i & 7)])); m = wave_max(m); if (F.lane == 0) gsc[5] = m * LOG2E; } }
    __syncthreads();
    bool fast;
    { const LAS float* gsc = (const LAS float*)(F.lds + RING_OFF + ATT_WSCR_OFF);
      const float bA = 64.0f * gsc[0] * gsc[1] * QSCALE * 1.02f + gsc[4], bB = 64.0f * gsc[2] * gsc[3] * QSCALE * 1.02f + gsc[5];
      fast = __builtin_amdgcn_readfirstlane((int)(fmaxf(bA, bB) < 60.0f)) != 0; }
    __syncthreads();
    LAS float* wscr = (LAS float*)(F.lds + RING_OFF + ATT_WSCR_OFF + F.wave * ATT_WSCR_BYTES);
    for (int v = F.vcu; v < 256; v += F.G) {
        const int bg = v >> 4, j = v & 15, b = bg >> 1, g = bg & 1;
#pragma unroll 1
        for (int i = 0; i < 4; ++i) { const int blk = (i == 0) ? j : (i == 1) ? 31 - j : (i == 2) ? 32 + j : 63 - j; const int slot = (v * 4 + i) * 8 + F.wave;
            if (fast) attn2_unit<true>(F, P, sinks, b, g, blk, lutA, lutB, wscr, dw, slot); else attn2_unit<false>(F, P, sinks, b, g, blk, lutA, lutB, wscr, dw, slot); }
    }
    __syncthreads();
}

enum { F_NORM = 1, F_PROJ = 2, F_CMP = 4, F_ATT = 8 };
struct Args { const float* in[21]; float* out; unsigned char* ws; int ph_lo, ph_hi, flags, li, rep, pad; };

__device__ __forceinline__ void p0_item(const float* W, int ldw, int k0, int c0, int nvalid, bf16* WT, int Kd, int drow0, LAS float* scr, int lane, const float* kgain = nullptr, bool fragmajor = false, float cscale = 1.0f) {
    f32x4 v[8]; const int c4 = 4 * (lane & 7), rr = lane >> 3;
#pragma unroll
    for (int i = 0; i < 8; ++i) v[i] = (c4 < nvalid) ? *(const GAS f32x4*)(W + (size_t)(k0 + 8 * i + rr) * ldw + c0 + c4) : (f32x4){0.f, 0.f, 0.f, 0.f};
#pragma unroll
    for (int i = 0; i < 8; ++i) { const int kk = 8 * i + rr; const float gk = (kgain ? kgain[k0 + kk] : 1.0f) * cscale; LAS float* d = scr + kk * 33 + c4;
        d[0] = v[i][0] * gk; d[1] = v[i][1] * gk; d[2] = v[i][2] * gk; d[3] = v[i][3] * gk; }
    LDS_WAIT(); asm volatile("" ::: "memory");
    const int c = lane & 7;
#pragma unroll
    for (int j = 0; j < 4; ++j) { const int n = (lane >> 3) + 8 * j; const LAS float* s = scr + (8 * c) * 33 + n;
        v4u o; o.x = pk2(s[0 * 33], s[1 * 33]); o.y = pk2(s[2 * 33], s[3 * 33]); o.z = pk2(s[4 * 33], s[5 * 33]); o.w = pk2(s[6 * 33], s[7 * 33]);
        if (!fragmajor) *(GAS v4u*)(WT + (size_t)(drow0 + n) * Kd + k0 + 8 * c) = o;
        else { const int kk = k0 + 8 * c, nn = drow0 + n;
            *(GAS v4u*)(WT + ((size_t)((kk >> 4) * 4 + (nn >> 5)) * 64 + (nn & 31) + 32 * ((kk >> 3) & 1)) * 8) = o; } }
    LDS_WAIT(); asm volatile("" ::: "memory");
}
__host__ __device__ __forceinline__ int main_colbase(int H) {
    if (H < 8) return 64 * H;
    if (H < 16) return 768 + 64 * (H - 8);
    if (H < 18) return 512 + 64 * (H - 16);
    if (H < 20) return 1280 + 2 * 128 + 64 * (H - 18);
    if (H < 22) return 1280 + 4 * 128 + 64 * (H - 20);
    if (H < 24) return 1280 + 0 * 128 + 64 * (H - 22);
    if (H < 26) return 1280 + 1 * 128 + 64 * (H - 24);
    if (H == 26) return 2048;
    return -1;
}
__host__ __device__ __forceinline__ int vt_colbase(int vh) {
    if (vh < 2) return 640 + 64 * vh;
    if (vh < 4) return 1280 + 3 * 128 + 64 * (vh - 2);
    if (vh < 6) return 1280 + 5 * 128 + 64 * (vh - 4);
    return -1;
}
__device__ __forceinline__ void p0_prologue(Frame& F, const Args& a) {
    LAS float* scr = (LAS float*)(F.lds + RING_OFF + F.wave * 16384);
    const int gw = F.vcu * NWAVES + F.wave, NGW = F.G * NWAVES;
    unsigned char* ws = a.ws;
    constexpr int I_IN = 16 * 176, I_OUT = 44 * 32, I_MAIN = 16 * 56, I_PLAIN = 16 * 72, I_VT = 16 * 16, I_MO = 16 * 32, I_W1 = 2 * 32 * 4, I_W2 = 2 * 2 * 2;
    const bool defer = (F.G == 256) && ((a.flags & 15) == 15);
    const bool fproj = (a.flags & F_PROJ) != 0, fnorm = (a.flags & F_NORM) != 0;
    const int i_proj = fproj ? I_MAIN + I_VT : I_PLAIN;
    const int NITEMS = 2 * I_IN + 2 * I_OUT + i_proj + I_MO + I_W1 + I_W2;
    for (int it = gw; it < NITEMS; it += NGW) {
        int r = it;
        if (r < 2 * I_IN) { const int l = r / I_IN; if (l && defer) continue; r %= I_IN; const int kb = r / 176, nb = r % 176;
            const int pn = nb >> 3, bj = (nb >> 2) & 1, c = 32 * (nb & 3);
            p0_item(a.in[l ? 19 : 3], 2 * FF, 64 * kb, (bj ? FF : 0) + 128 * pn + c, 32, (bf16*)(ws + (l ? WS_WIN2 : WS_WIN1)), DM, 32 * nb, scr, F.lane, (l && fnorm) ? a.in[18] : nullptr, false, bj ? (1.0f / LOG2E) : LOG2E); continue; }
        r -= 2 * I_IN;
        if (r < 2 * I_OUT) { const int l = r / I_OUT; r %= I_OUT; if (l && defer && I_IN + r < 4096) continue; const int kb = r / 32, nb = r % 32;
            p0_item(a.in[l ? 20 : 4], DM, 64 * kb, 32 * nb, 32, (bf16*)(ws + (l ? WS_WOUT2 : WS_WOUT1)), FF, 32 * nb, scr, F.lane); continue; }
        r -= 2 * I_OUT;
        if (r < i_proj) {
            if (!fproj) { const int kb = r / 72, nb = r % 72; const int nv = 2072 - 32 * nb; p0_item(a.in[6], 2072, 64 * kb, nv > 0 ? 32 * nb : 0, nv > 32 ? 32 : (nv > 0 ? nv : 0), (bf16*)(ws + WS_WMAIN), DM, 32 * nb, scr, F.lane, fnorm ? a.in[5] : nullptr); continue; }
            if (r < I_MAIN) { const int kb = r / 56, nb = r % 56;
                const int pn = nb >> 3, bj = (nb >> 2) & 1, wc = nb & 3, H = 4 * pn + wc, cb = main_colbase(H);
                const int nv = cb < 0 ? 0 : (H == 26 ? (bj ? 0 : 24) : 32);
                p0_item(a.in[6], 2072, 64 * kb, cb < 0 ? 0 : cb + 32 * bj, nv, (bf16*)(ws + WS_WMAIN), DM, 32 * nb, scr, F.lane, fnorm ? a.in[5] : nullptr); continue; }
            r -= I_MAIN; { const int kb = r / 16, nb = r % 16, vh = nb >> 1, cb = vt_colbase(vh);
                p0_item(a.in[6], 2072, 64 * kb, cb < 0 ? 0 : cb + 32 * (nb & 1), cb < 0 ? 0 : 32, (bf16*)(ws + WS_WVT), DM, 32 * nb, scr, F.lane, fnorm ? a.in[5] : nullptr); continue; }
        }
        r -= i_proj;
        if (r < I_MO) { const int kb = r / 32, nb = r % 32; p0_item(a.in[7], DM, 64 * kb, 32 * nb, 32, (bf16*)(ws + WS_WMO), DM, 32 * nb, scr, F.lane); continue; }
        r -= I_MO;
        if (r < I_W1) { const int kv = r / 128; r %= 128; const int kb = r / 4, nb = r % 4; p0_item(a.in[14] + (size_t)kv * 2048 * 128, 128, 64 * kb, 32 * nb, 32, (bf16*)(ws + WS_W1T) + (size_t)kv * 128 * 2048, 2048, 32 * nb, scr, F.lane, nullptr, true); continue; }
        r -= I_W1;
        { const int kv = r / 4; r %= 4; const int kb = r / 2, nb = r % 2; p0_item(a.in[16] + (size_t)kv * 128 * 64, 64, 64 * kb, 32 * nb, 32, (bf16*)(ws + WS_W2T) + (size_t)kv * 64 * 128, 128, 32 * nb, scr, F.lane); }
    }
    if (gw < 256) { const int kv = gw >> 7, hid = gw & 127; float s = 0.f;
        for (int j = 0; j < 32; ++j) { const int k = F.lane + 64 * j; s += a.in[13][kv * 2048 + k] * a.in[14][((size_t)kv * 2048 + k) * 128 + hid]; }
        s = wave_sum(s); if (F.lane == 0) ((float*)(ws + WS_POSB))[gw] = s + a.in[15][gw]; }
    const float* g1 = a.in[2];
    for (int m0 = gw; m0 < T; m0 += 4 * NGW) {
        f32x4 v[4][4];
#pragma unroll
        for (int rI = 0; rI < 4; ++rI) { const int m = m0 + rI * NGW; const GAS f32x4* xr = (const GAS f32x4*)(a.in[0] + (size_t)(m < T ? m : m0) * DM) + F.lane;
#pragma unroll
            for (int j = 0; j < 4; ++j) v[rI][j] = __builtin_nontemporal_load(xr + 64 * j); }
#pragma unroll
        for (int rI = 0; rI < 4; ++rI) { const int m = m0 + rI * NGW; if (m >= T) break;
            float s = 0.f;
#pragma unroll
            for (int j = 0; j < 4; ++j) s += (v[rI][j].x * v[rI][j].x + v[rI][j].y * v[rI][j].y) + (v[rI][j].z * v[rI][j].z + v[rI][j].w * v[rI][j].w);
            const float rstd = 1.0f / sqrtf(wave_sum(s) * (1.f / DM) + EPS); const f32x4* gr = (const f32x4*)g1 + F.lane;
            GAS unsigned long long* o8 = (GAS unsigned long long*)((bf16*)(ws + WS_A) + (size_t)m * DM) + F.lane;
#pragma unroll
            for (int j = 0; j < 4; ++j) { const f32x4 gg = gr[64 * j]; o8[64 * j] = (unsigned long long)pk2(v[rI][j].x * rstd * gg.x, v[rI][j].y * rstd * gg.y) | ((unsigned long long)pk2(v[rI][j].z * rstd * gg.z, v[rI][j].w * rstd * gg.w) << 32); } }
    }
}

__global__ void __launch_bounds__(NWAVES * 64, 2) mk(Args args) {
    extern __shared__ __attribute__((aligned(16))) unsigned char lds[];
    Frame F;
    F.lds = (LAS unsigned char*)lds; F.MISC = (volatile LAS unsigned*)(F.lds + MISC_OFF);
    F.wave = __builtin_amdgcn_readfirstlane((int)threadIdx.x >> 6);
#define FRESH() do { F.lane = hw_lane_id(); F.tid = F.wave * 64 + F.lane; } while (0)
#define LEADER() (F.wave == 0 && hw_lane_id() == 0)
    if (args.ph_lo < 0) cooperative_groups::this_grid().sync();
    FRESH();
    F.G = gridDim.x; { const int bx = blockIdx.x; F.vcu = (F.G % 8 == 0) ? (bx % 8) * (F.G / 8) + bx / 8 : bx; }
    unsigned char* ws = args.ws; F.ctl = (gu32*)(ws + WS_CTL);
    for (int u = F.tid; u < (LDS_BYTES - LDSCTL_OFF) / 4; u += NWAVES * 64) ((LAS unsigned*)(F.lds + LDSCTL_OFF))[u] = 0u;
    __syncthreads();
    const int lo = args.ph_lo, hi = args.ph_hi, flags = args.flags;
    const bool one = (hi - lo) > 1;
    XcdBarrier bar; bar.bar = (unsigned*)(F.ctl + CW_BAR) + args.li * XCD_BAR_WORDS; bar.x = 0; bar.st = nullptr;
    if (one) bar = xcd_barrier_post((unsigned*)(F.ctl + CW_BAR) + args.li * XCD_BAR_WORDS, F.MISC + 8, LEADER());
#define IN(k) (lo <= (k) && (k) < hi)
#define REP(k) for (int rep_ = 0; rep_ < ((KREP == (k)) ? 2 : 1); ++rep_)
#define SEAM(k) do { if (IN(k) && IN((k) + 1)) { xcd_barrier(bar, LEADER()); } FRESH(); } while (0)
    bf16* const A = (bf16*)(ws + WS_A); bf16* const ACT = (bf16*)(ws + WS_ACT); bf16* const MIX = (bf16*)(ws + WS_MIX);
    float* const SSQ1 = (float*)(ws + WS_SSQ1); float* const SSQ2 = (float*)(ws + WS_SSQ2);
    const bool fnorm = (flags & F_NORM) != 0;

    if (IN(0)) REP(0) { p0_prologue(F, args); } SEAM(0);
    if (IN(1)) REP(1) {
        pg8::Gemm g{A, (const bf16*)(ws + WS_WIN1), T, 2 * FF, DM}; pg8::StaticOrder S; S.init(T, 2 * FF, F.G, (int)blockIdx.x);
        pg8::EpiSwiglu E{ACT, FF, nullptr};
        pg8::gemm_phase<pg8::EpiSwiglu, pg8::StaticOrder, true, true>(F.lds + RING_OFF, g, S, E, F.wave);
    } SEAM(1);
    if (IN(2)) REP(2) {
        pg8::Gemm g{ACT, (const bf16*)(ws + WS_WOUT1), T, DM, FF}; pg8::StaticOrder S; S.init(T, DM, F.G, (int)blockIdx.x);
        if (fnorm) { pg8::EpiResidF E{args.in[0], 0.5f, A, SSQ1};
            pg8::gemm_phase<pg8::EpiResidF, pg8::StaticOrder, true, true>(F.lds + RING_OFF, g, S, E, F.wave); }
        else { pg8::EpiResid E{args.in[0], nullptr, 0.5f, args.out, nullptr, nullptr}; pg8::gemm_phase<pg8::EpiResid, pg8::StaticOrder, true, true>(F.lds + RING_OFF, g, S, E, F.wave); }
    } SEAM(2);
    if (IN(3)) REP(3) {
        if (!(flags & F_PROJ)) {
            pg8::Gemm g{A, (const bf16*)(ws + WS_WMAIN), T, NPLAIN, DM}; pg8::StaticOrder S; S.init(T, NPLAIN, F.G, (int)blockIdx.x);
            pg8::EpiPlain E{(bf16*)(ws + WS_PROJ), NPLAIN};
            pg8::gemm_phase<pg8::EpiPlain, pg8::StaticOrder, true, true>(F.lds + RING_OFF, g, S, E, F.wave);
        } else {
            pg8::Gemm g{A, (const bf16*)(ws + WS_WMAIN), T, NMAIN, DM}; pg8::StaticOrder S; S.init(T, NMAIN, F.G, (int)blockIdx.x);
            pg8::EpiProjMain E{SSQ1, (float*)(ws + WS_RSTD), args.in[8], args.in[9], args.in[11], args.in[12],
                               (bf16*)(ws + WS_QA), (bf16*)(ws + WS_QB), (bf16*)(ws + WS_KA), (bf16*)(ws + WS_KS), (bf16*)(ws + WS_KW), (bf16*)(ws + WS_KCR), (bf16*)(ws + WS_VCR), (float*)(ws + WS_GT), QSCALE, SEQ, T};
            pg8::gemm_phase<pg8::EpiProjMain, pg8::StaticOrder, true, true>(F.lds + RING_OFF, g, S, E, F.wave);
            if (F.G == 256 && (flags & F_CMP) && blockIdx.x >= 128) {
                pg8::Gemm gt{(const bf16*)(ws + WS_WVT), A, 512, T, DM}; pg8::OneUnit S1{0, (int)blockIdx.x - 128};
                pg8::EpiProjT Et{SSQ1, (bf16*)(ws + WS_VAT), (size_t)(WS_VST - WS_VAT) / 2, SEQ};
                pg8::gemm_phase<pg8::EpiProjT, pg8::OneUnit, true, true>(F.lds + RING_OFF, gt, S1, Et, F.wave);
            }
        }
    } SEAM(3);
    if (IN(4)) REP(4) {
        const bool bal = (F.G == 256) && (flags & F_PROJ) && (flags & F_CMP);
        if (flags & F_PROJ) {
            pg8::Gemm g{(const bf16*)(ws + WS_WVT), A, 512, T, DM};
            pg8::EpiProjT E{SSQ1, (bf16*)(ws + WS_VAT), (size_t)(WS_VST - WS_VAT) / 2, SEQ};
            if (bal) { if (blockIdx.x < 128) { pg8::OneUnit S1{1, (int)blockIdx.x}; pg8::gemm_phase<pg8::EpiProjT, pg8::OneUnit, true, true, true>(F.lds + RING_OFF, g, S1, E, F.wave); } }
            else { pg8::StaticOrder S; S.init(512, T, F.G, (int)blockIdx.x); pg8::gemm_phase<pg8::EpiProjT, pg8::StaticOrder, true, true>(F.lds + RING_OFF, g, S, E, F.wave); }
        }
        if (flags & F_CMP) {
            FRESH();
            if (bal) { if (blockIdx.x >= 128)
                cmp_unit2(F, 2 * ((int)blockIdx.x - 128), (const bf16*)(ws + WS_KCR), (const bf16*)(ws + WS_VCR), (const bf16*)(ws + WS_W1T), (const bf16*)(ws + WS_W2T), (const float*)(ws + WS_POSB), args.in[17], args.in[12], (bf16*)(ws + WS_KC), (bf16*)(ws + WS_VCT)); }
            else for (int u = F.vcu; u < 256; u += F.G)
                cmp_unit(F, u, (const bf16*)(ws + WS_KCR), (const bf16*)(ws + WS_VCR), (const bf16*)(ws + WS_W1T), (const bf16*)(ws + WS_W2T), (const float*)(ws + WS_POSB), args.in[17], args.in[12], (bf16*)(ws + WS_KC), (bf16*)(ws + WS_VCT));
        }
    }
    SEAM(4);
    if (IN(5) && (flags & F_ATT)) REP(5) {
        const AttP P{(const bf16*)(ws + WS_QA), (const bf16*)(ws + WS_QB), (const bf16*)(ws + WS_KA), (const bf16*)(ws + WS_VAT), (const bf16*)(ws + WS_KC), (const bf16*)(ws + WS_VCT), (const bf16*)(ws + WS_KS), (const bf16*)(ws + WS_VST),
                     (const bf16*)(ws + WS_KW), (const bf16*)(ws + WS_VWT), (const float*)(ws + WS_GT), MIX};
        const DeferW dw{args.in[19], args.in[20], fnorm ? args.in[18] : nullptr, (bf16*)(ws + WS_WIN2), (bf16*)(ws + WS_WOUT2), (F.G == 256) && ((flags & 15) == 15)};
        attn2_phase(F, P, args.in[1], args.in[10], args.in[8], args.in[9], args.in[11], args.in[12], dw);
    }
    SEAM(5);
    if (IN(6)) {
        pg8::Gemm g{MIX, (const bf16*)(ws + WS_WMO), T, DM, DM}; pg8::StaticOrder S; S.init(T, DM, F.G, (int)blockIdx.x);
        pg8::EpiResid E{fnorm ? nullptr : args.out, fnorm ? A : nullptr, 1.0f, fnorm ? nullptr : args.out, fnorm ? A : nullptr, fnorm ? SSQ2 : nullptr};
        pg8::gemm_phase<pg8::EpiResid, pg8::StaticOrder, true, true>(F.lds + RING_OFF, g, S, E, F.wave);
    } SEAM(6);
    if (IN(7)) REP(7) {
        pg8::Gemm g{A, (const bf16*)(ws + WS_WIN2), T, 2 * FF, DM}; pg8::StaticOrder S; S.init(T, 2 * FF, F.G, (int)blockIdx.x);
        pg8::EpiSwiglu E{ACT, FF, fnorm ? SSQ2 : nullptr};
        pg8::gemm_phase<pg8::EpiSwiglu, pg8::StaticOrder, true, true>(F.lds + RING_OFF, g, S, E, F.wave);
    } SEAM(7);
    if (IN(8)) {
        pg8::Gemm g{ACT, (const bf16*)(ws + WS_WOUT2), T, DM, FF}; pg8::StaticOrder S; S.init(T, DM, F.G, (int)blockIdx.x);
        pg8::EpiResid E{fnorm ? nullptr : args.out, fnorm ? A : nullptr, 0.5f, args.out, nullptr, nullptr};
        pg8::gemm_phase<pg8::EpiResid, pg8::StaticOrder, true, true>(F.lds + RING_OFF, g, S, E, F.wave);
    }
#undef IN
#undef SEAM
}

static void launch_mk(const Args& base, int lo, int hi, int grid, hipStream_t stream) {
    static int li = 0;
    Args a = base; a.ph_lo = lo; a.ph_hi = hi; a.li = 0;
    if (hi - lo > 1) {
        a.li = (lo == 0) ? 0 : (lo < 6 ? 1 : 2);
        void* kargs[] = {&a};
        hipError_t e = hipLaunchCooperativeKernel((const void*)mk, dim3(grid), dim3(NWAVES * 64), kargs, LDS_BYTES, stream);
        if (e != hipSuccess) fprintf(stderr, "cooperative launch failed: %s (grid %d)\n", hipGetErrorString(e), grid);
    } else hipLaunchKernelGGL(mk, dim3(grid), dim3(NWAVES * 64), LDS_BYTES, stream, a);
    (void)li;
}
extern "C" void kernel_launch(void* const* d_in, const int* in_sizes, int n_in, void* d_out, int out_size, void* d_ws, size_t ws_size, hipStream_t stream) {
    static int grid = 0;
    if (grid == 0) {
        if (n_in != 21 || in_sizes[0] != T * DM || out_size != T * DM || ws_size < (KFLAGS == 15 ? WS_MIX + 64 * MiB : WS_END)) { fprintf(stderr, "kernel_launch: unexpected shapes / workspace (%d inputs, ws %zu)\n", n_in, ws_size); grid = -1; return; }
        int dev = 0, cus = 0;
        if (hipGetDevice(&dev) != hipSuccess || hipDeviceGetAttribute(&cus, hipDeviceAttributeMultiprocessorCount, dev) != hipSuccess) { grid = -1; return; }
        if (hipFuncSetAttribute((const void*)mk, hipFuncAttributeMaxDynamicSharedMemorySize, LDS_BYTES) != hipSuccess) { grid = -1; return; }
        (void)hipGetLastError();
        int per_cu = 0;
        if (hipOccupancyMaxActiveBlocksPerMultiprocessor(&per_cu, (const void*)mk, NWAVES * 64, LDS_BYTES) != hipSuccess || per_cu < 1) { fprintf(stderr, "occupancy query failed (%d)\n", per_cu); (void)hipGetLastError(); per_cu = 1; }
        grid = cus * (per_cu > 1 ? 1 : per_cu);
    }
    if (grid < 0) return;
    (void)hipMemsetAsync((char*)d_ws + WS_CTL, 0, CTL_ZERO_BYTES, stream);
    Args a{};
    for (int i = 0; i < 21; ++i) a.in[i] = (const float*)d_in[i];
    a.out = (float*)d_out; a.ws = (unsigned char*)d_ws; a.flags = KFLAGS; a.rep = KREP;
    unsigned char* ws = (unsigned char*)d_ws;
    const bool fnorm = (KFLAGS & F_NORM) != 0;
    if (KFLAGS == 15) { launch_mk(a, 0, 9, grid, stream); return; }
    if (fnorm) launch_mk(a, 0, 3, grid, stream);
    else { launch_mk(a, 0, 1, grid, stream); launch_mk(a, 1, 2, grid, stream); launch_mk(a, 2, 3, grid, stream); }
    if (!fnorm) hipLaunchKernelGGL(nv_rmsnorm, dim3(T / 4), dim3(256), 0, stream, (const float*)d_out, a.in[5], (bf16*)(ws + WS_A));
    launch_mk(a, 3, 4, grid, stream);
    if (!(KFLAGS & F_PROJ)) {
        HeadPrep hp{(const bf16*)(ws + WS_PROJ), fnorm ? (const float*)(ws + WS_SSQ1) : nullptr, a.in[8], a.in[9], a.in[11], a.in[12],
                    (bf16*)(ws + WS_QA), (bf16*)(ws + WS_QB), (bf16*)(ws + WS_KA), (bf16*)(ws + WS_VAT), (bf16*)(ws + WS_KCR), (bf16*)(ws + WS_VCR), (bf16*)(ws + WS_KS), (bf16*)(ws + WS_VST), (bf16*)(ws + WS_KW), (bf16*)(ws + WS_VWT), (float*)(ws + WS_GT)};
        hipLaunchKernelGGL(nv_headprep, dim3(T / 4), dim3(256), 0, stream, hp);
    }
    if (KFLAGS & (F_PROJ | F_CMP)) launch_mk(a, 4, 5, grid, stream);
    if (!(KFLAGS & F_CMP)) hipLaunchKernelGGL(nv_compress, dim3(2 * 8 * 2 * 256), dim3(128), 0, stream, (const bf16*)(ws + WS_KCR), (const bf16*)(ws + WS_VCR), a.in[13], a.in[14], a.in[15], a.in[16], a.in[17], a.in[12], (bf16*)(ws + WS_KC), (bf16*)(ws + WS_VCT));
    if (!(KFLAGS & F_ATT)) {
        hipLaunchKernelGGL(nv_band_a, dim3(T * 2), dim3(256), 0, stream, (const bf16*)(ws + WS_QA), (const bf16*)(ws + WS_KA), (const bf16*)(ws + WS_VAT), a.in[1], a.in[10], (bf16*)(ws + WS_MIX));
        hipLaunchKernelGGL(nv_nsa, dim3(T * 2), dim3(256), 0, stream, (const bf16*)(ws + WS_QB), (const bf16*)(ws + WS_KC), (const bf16*)(ws + WS_VCT), (const bf16*)(ws + WS_KS), (const bf16*)(ws + WS_VST), (const bf16*)(ws + WS_KW), (const bf16*)(ws + WS_VWT), (const float*)(ws + WS_GT), a.in[1], (bf16*)(ws + WS_MIX));
    } else launch_mk(a, 5, 6, grid, stream);
    if (fnorm) launch_mk(a, 6, 9, grid, stream);
    else { launch_mk(a, 6, 7, grid, stream);
        hipLaunchKernelGGL(nv_rmsnorm, dim3(T / 4), dim3(256), 0, stream, (const float*)d_out, a.in[18], (bf16*)(ws + WS_A));
        launch_mk(a, 7, 8, grid, stream); launch_mk(a, 8, 9, grid, stream); }
}
```
